# Optimizing an MI355X kernel written in HIP

```python
import math
import jax, jax.numpy as jnp
from jax import lax
import numpy as np

D_MODEL = 2048
BATCH = 1
SEQ = 8192
DEPTH = 2

CHUNK = 64
Q_BLOCK = 128
ROPE_THETA = 500000.0
NORM_EPS = 1e-6
LN_EPS = 1e-5
NEG_INF = -1e30
N_BRANCH = 4

MLA_HEADS = 8
MLA_Q_LORA = 512
MLA_KV_LORA = 256
MLA_NOPE = 64
MLA_ROPE = 32
MLA_V = 64
MLA_SCALE = (MLA_NOPE + MLA_ROPE) ** -0.5
MLA_WIDTH = MLA_HEADS * MLA_V

SC_WIDTH = 512
SC_KERNEL = 3

DIFF_HEADS = 4
DIFF_HEAD_DIM = 64
DIFF_ROT = DIFF_HEAD_DIM // 4
DIFF_SCALE = DIFF_HEAD_DIM ** -0.5
DIFF_WIDTH = DIFF_HEADS * 2 * DIFF_HEAD_DIM

CONF_WIDTH = 512
CONF_KERNEL = 31

PEER_HEADS = 8
PEER_N_KEYS = 128
PEER_N_EXPERTS = PEER_N_KEYS * PEER_N_KEYS
PEER_KEY_DIM = 128
PEER_HALF = PEER_KEY_DIM // 2
PEER_TOPK = 16
PEER_BLOCK = 128

IN_SIZES = (MLA_Q_LORA, MLA_KV_LORA, MLA_ROPE, 3 * SC_WIDTH, DIFF_WIDTH, DIFF_WIDTH, DIFF_WIDTH, 2 * CONF_WIDTH, N_BRANCH * D_MODEL)
IN_COLS = sum(IN_SIZES)
IN_OFFSETS = tuple(int(v) for v in np.cumsum(IN_SIZES)[:-1])

kernel_name = 'hybrid_gated_mla_conv_diff_peer'


def rms_norm(x, g, eps=NORM_EPS):
    xf = x.astype(jnp.float32)
    y = xf * lax.rsqrt(jnp.mean(xf * xf, axis=-1, keepdims=True) + eps)
    return (y * g.astype(jnp.float32)).astype(x.dtype)


def layer_norm(x, g, b, eps=LN_EPS):
    xf = x.astype(jnp.float32)
    mu = jnp.mean(xf, axis=-1, keepdims=True)
    var = jnp.mean(jnp.square(xf - mu), axis=-1, keepdims=True)
    y = (xf - mu) * lax.rsqrt(var + eps)
    return (y * g.astype(jnp.float32) + b.astype(jnp.float32)).astype(x.dtype)


def rope_tables(positions, dim):
    inv_freq = ROPE_THETA ** (-jnp.arange(0, dim, 2, dtype=jnp.float32) / dim)
    ang = positions.astype(jnp.float32)[..., None] * inv_freq
    return jnp.cos(ang), jnp.sin(ang)


def apply_rope(x, cos, sin):
    xf = x.astype(jnp.float32)
    x1, x2 = jnp.split(xf, 2, axis=-1)
    return jnp.concatenate([x1 * cos - x2 * sin, x2 * cos + x1 * sin], axis=-1).astype(x.dtype)


def partial_rope(x, cos, sin):
    return jnp.concatenate([apply_rope(x[..., :DIFF_ROT], cos, sin), x[..., DIFF_ROT:]], axis=-1)


def causal_depthwise_conv(x, w):
    k = w.shape[0]
    return lax.conv_general_dilated(x, w[:, None, :], window_strides=(1,), padding=[(k - 1, 0)],
                                    dimension_numbers=('NWC', 'WIO', 'NWC'),
                                    feature_group_count=x.shape[-1])


def block_causal_mask(blk, seq):
    q_pos = blk * Q_BLOCK + jnp.arange(Q_BLOCK)
    k_pos = jnp.arange(seq)
    return k_pos[None, :] < ((q_pos // CHUNK) + 1)[:, None] * CHUNK


def to_query_blocks(t):
    b, s = t.shape[0], t.shape[1]
    return jnp.moveaxis(t.reshape((b, s // Q_BLOCK, Q_BLOCK) + t.shape[2:]), 1, 0)


def from_query_blocks(t):
    t = jnp.moveaxis(t, 0, 1)
    return t.reshape((t.shape[0], t.shape[1] * t.shape[2]) + t.shape[3:])


def mla_attention(q_nope, q_rope, k_nope, k_rope, v):
    seq = k_nope.shape[1]

    def one(args):
        qn, qr, blk = args
        s = jnp.einsum('bqhd,bkhd->bhqk', qn, k_nope) + jnp.einsum('bqhr,bkr->bhqk', qr, k_rope)
        s = s.astype(jnp.float32) * MLA_SCALE
        p = jax.nn.softmax(jnp.where(block_causal_mask(blk, seq), s, NEG_INF), axis=-1)
        return jnp.einsum('bhqk,bkhd->bqhd', p.astype(v.dtype), v)

    out = lax.map(one, (to_query_blocks(q_nope), to_query_blocks(q_rope), jnp.arange(seq // Q_BLOCK)))
    return from_query_blocks(out)


def diff_attention(q1, q2, k1, k2, v, lam):
    seq = k1.shape[1]

    def one(args):
        qa, qb, blk = args
        mask = block_causal_mask(blk, seq)
        s1 = jnp.einsum('bqhd,bkhd->bhqk', qa, k1).astype(jnp.float32) * DIFF_SCALE
        s2 = jnp.einsum('bqhd,bkhd->bhqk', qb, k2).astype(jnp.float32) * DIFF_SCALE
        p = jax.nn.softmax(jnp.where(mask, s1, NEG_INF), axis=-1) - lam * jax.nn.softmax(jnp.where(mask, s2, NEG_INF), axis=-1)
        return jnp.einsum('bhqk,bkhd->bqhd', p.astype(v.dtype), v)

    out = lax.map(one, (to_query_blocks(q1), to_query_blocks(q2), jnp.arange(seq // Q_BLOCK)))
    return from_query_blocks(out)


def mla_branch(cq, ckv, kr, q_norm_g, w_uq, kv_norm_g, w_ukv, cos, sin):
    b, s = cq.shape[0], cq.shape[1]
    q = (rms_norm(cq, q_norm_g) @ w_uq).reshape(b, s, MLA_HEADS, MLA_NOPE + MLA_ROPE)
    q_nope = q[..., :MLA_NOPE]
    q_rope = apply_rope(q[..., MLA_NOPE:], cos[:, :, None, :], sin[:, :, None, :])
    kv = (rms_norm(ckv, kv_norm_g) @ w_ukv).reshape(b, s, MLA_HEADS, MLA_NOPE + MLA_V)
    k_nope, v = kv[..., :MLA_NOPE], kv[..., MLA_NOPE:]
    k_rope = apply_rope(kr, cos, sin)
    return mla_attention(q_nope, q_rope, k_nope, k_rope, v).reshape(b, s, MLA_WIDTH)


def short_conv_branch(sc_in, conv_w):
    bg, cg, xv = jnp.split(sc_in, 3, axis=-1)
    return bg * causal_depthwise_conv(cg * xv, conv_w)


def diff_branch(dq, dk, dv, lam_vecs, norm_g, lam_init, cos, sin):
    b, s = dq.shape[0], dq.shape[1]
    c5, s5 = cos[:, :, None, None, :], sin[:, :, None, None, :]
    q = partial_rope(dq.reshape(b, s, DIFF_HEADS, 2, DIFF_HEAD_DIM), c5, s5)
    k = partial_rope(dk.reshape(b, s, DIFF_HEADS, 2, DIFF_HEAD_DIM), c5, s5)
    v = dv.reshape(b, s, DIFF_HEADS, 2 * DIFF_HEAD_DIM)
    lv = lam_vecs.astype(jnp.float32)
    lam = jnp.exp(jnp.sum(lv[0] * lv[1])) - jnp.exp(jnp.sum(lv[2] * lv[3])) + lam_init
    o = diff_attention(q[..., 0, :], q[..., 1, :], k[..., 0, :], k[..., 1, :], v, lam)
    o = rms_norm(o, norm_g) * (1.0 - lam_init)
    return o.reshape(b, s, DIFF_WIDTH)


def conformer_branch(conf_in, dw_w, dw_b, ln_g, ln_b):
    a, gt = jnp.split(conf_in, 2, axis=-1)
    u = a * jax.nn.sigmoid(gt)
    u = causal_depthwise_conv(u, dw_w) + dw_b
    return jax.nn.silu(layer_norm(u, ln_g, ln_b))


def peer_ffn(h, w_q, sub_keys, u_tab, v_tab):
    b, s, d = h.shape
    q = (h @ w_q).reshape(b, s, PEER_HEADS, 2, PEER_HALF)
    s1 = jnp.einsum('bshd,nd->bshn', q[..., 0, :], sub_keys[0]).astype(jnp.float32)
    s2 = jnp.einsum('bshd,nd->bshn', q[..., 1, :], sub_keys[1]).astype(jnp.float32)
    t1, i1 = lax.top_k(s1, PEER_TOPK)
    t2, i2 = lax.top_k(s2, PEER_TOPK)
    cand = (t1[..., :, None] + t2[..., None, :]).reshape(b, s, PEER_HEADS, PEER_TOPK * PEER_TOPK)
    cand_idx = (i1[..., :, None] * PEER_N_KEYS + i2[..., None, :]).reshape(b, s, PEER_HEADS, PEER_TOPK * PEER_TOPK)
    best, pos = lax.top_k(cand, PEER_TOPK)
    idx = jnp.take_along_axis(cand_idx, pos, axis=-1)
    gate = jax.nn.softmax(best, axis=-1)
    n_blk = (b * s) // PEER_BLOCK
    hb = h.reshape(n_blk, PEER_BLOCK, d)
    ib = idx.reshape(n_blk, PEER_BLOCK, PEER_HEADS, PEER_TOPK)
    gb = gate.reshape(n_blk, PEER_BLOCK, PEER_HEADS, PEER_TOPK)

    def one(args):
        ht, it, gt = args
        a = jnp.einsum('thkd,td->thk', u_tab[it], ht)
        wgt = (jax.nn.gelu(a.astype(jnp.float32), approximate=False) * gt).astype(ht.dtype)
        return jnp.einsum('thk,thkd->td', wgt, v_tab[it])

    return lax.map(one, (hb, ib, gb)).reshape(b, s, d)


def setup_inputs(seed: int = 0) -> dict:
    key = jax.random.key(seed)
    ks = iter(jax.random.split(key, 40))

    def w(shape, fan_in):
        return jax.random.normal(next(ks), shape, jnp.float32) * (fan_in ** -0.5)

    def gain(shape):
        return 1.0 + 0.02 * jax.random.normal(next(ks), shape, jnp.float32)

    def small(shape, scale):
        return scale * jax.random.normal(next(ks), shape, jnp.float32)

    x = jax.random.normal(next(ks), (BATCH, SEQ, D_MODEL), jnp.float32)
    offset = jax.random.randint(next(ks), (BATCH, 1), 0, 4096, dtype=jnp.int32)
    positions = (offset + jnp.arange(SEQ, dtype=jnp.int32)[None, :]).astype(jnp.int32)
    L = DEPTH
    return {
        'x': x,
        'positions': positions,
        'mix_norm_g': gain((L, D_MODEL)),
        'w_in': w((L, D_MODEL, IN_COLS), D_MODEL),
        'gate_b': small((L, N_BRANCH, D_MODEL), 0.1),
        'mla_q_norm_g': gain((L, MLA_Q_LORA)),
        'mla_w_uq': w((L, MLA_Q_LORA, MLA_HEADS * (MLA_NOPE + MLA_ROPE)), MLA_Q_LORA),
        'mla_kv_norm_g': gain((L, MLA_KV_LORA)),
        'mla_w_ukv': w((L, MLA_KV_LORA, MLA_HEADS * (MLA_NOPE + MLA_V)), MLA_KV_LORA),
        'mla_w_out': w((L, MLA_WIDTH, D_MODEL), MLA_WIDTH),
        'sc_conv_w': w((L, SC_KERNEL, SC_WIDTH), SC_KERNEL),
        'sc_w_out': w((L, SC_WIDTH, D_MODEL), SC_WIDTH),
        'diff_lambda': small((L, 4, DIFF_HEAD_DIM), 0.1),
        'diff_norm_g': gain((L, 2 * DIFF_HEAD_DIM)),
        'diff_w_out': w((L, DIFF_WIDTH, D_MODEL), DIFF_WIDTH),
        'conf_dw_w': w((L, CONF_KERNEL, CONF_WIDTH), CONF_KERNEL),
        'conf_dw_b': small((L, CONF_WIDTH), 0.02),
        'conf_ln_g': gain((L, CONF_WIDTH)),
        'conf_ln_b': small((L, CONF_WIDTH), 0.02),
        'conf_w_out': w((L, CONF_WIDTH, D_MODEL), CONF_WIDTH),
        'w_o': w((L, D_MODEL, D_MODEL), D_MODEL),
        'ffn_norm_g': gain((L, D_MODEL)),
        'peer_w_q': w((L, D_MODEL, PEER_HEADS * PEER_KEY_DIM), D_MODEL),
        'peer_sub_keys': w((L, 2, PEER_N_KEYS, PEER_HALF), PEER_HALF),
        'peer_u': w((L, PEER_N_EXPERTS, D_MODEL), D_MODEL),
        'peer_v': w((L, PEER_N_EXPERTS, D_MODEL), PEER_HEADS),
        'final_norm_g': gain((D_MODEL,)),
    }


def reference(x, positions, mix_norm_g, w_in, gate_b, mla_q_norm_g, mla_w_uq, mla_kv_norm_g, mla_w_ukv,
              mla_w_out, sc_conv_w, sc_w_out, diff_lambda, diff_norm_g, diff_w_out, conf_dw_w, conf_dw_b,
              conf_ln_g, conf_ln_b, conf_w_out, w_o, ffn_norm_g, peer_w_q, peer_sub_keys, peer_u, peer_v,
              final_norm_g):
    b, s, d = x.shape
    cos_mla, sin_mla = rope_tables(positions, MLA_ROPE)
    cos_diff, sin_diff = rope_tables(positions, DIFF_ROT)
    for i in range(DEPTH):
        lam_init = 0.8 - 0.6 * math.exp(-0.3 * i)
        h = rms_norm(x, mix_norm_g[i])
        z = h @ w_in[i]
        cq, ckv, kr, sc_in, dq, dk, dv, conf_in, gate_logits = jnp.split(z, IN_OFFSETS, axis=-1)
        y_mla = mla_branch(cq, ckv, kr, mla_q_norm_g[i], mla_w_uq[i], mla_kv_norm_g[i], mla_w_ukv[i],
                           cos_mla, sin_mla) @ mla_w_out[i]
        y_sc = short_conv_branch(sc_in, sc_conv_w[i]) @ sc_w_out[i]
        y_diff = diff_branch(dq, dk, dv, diff_lambda[i], diff_norm_g[i], lam_init, cos_diff, sin_diff) @ diff_w_out[i]
        y_conf = conformer_branch(conf_in, conf_dw_w[i], conf_dw_b[i], conf_ln_g[i], conf_ln_b[i]) @ conf_w_out[i]
        g = jax.nn.sigmoid(gate_logits.reshape(b, s, N_BRANCH, d) + gate_b[i])
        merged = g[..., 0, :] * y_mla + g[..., 1, :] * y_sc + g[..., 2, :] * y_diff + g[..., 3, :] * y_conf
        x = x + merged @ w_o[i]
        x = x + peer_ffn(rms_norm(x, ffn_norm_g[i]), peer_w_q[i], peer_sub_keys[i], peer_u[i], peer_v[i])
    return rms_norm(x, final_norm_g)
```

```cpp
#include <hip/hip_runtime.h>
#include <cstdio>
#include <cstdint>
__device__ __forceinline__ int otid() { int t = (int)threadIdx.x; asm volatile("" : "+v"(t)); return t; }
__device__ __forceinline__ unsigned char* ows(unsigned char* p) { asm volatile("" : "+s"(p)); return p; }
namespace pg8 {
#define PG8_LAS __attribute__((address_space(3)))
typedef unsigned short bf16_t;
typedef short bf16x8 __attribute__((ext_vector_type(8)));
typedef float f32x4 __attribute__((ext_vector_type(4)));
typedef unsigned u32x4 __attribute__((ext_vector_type(4)));
constexpr int BM = 256, BK = 64, HALF = 128, HTB = HALF * BK * 2  , STAGE_BYTES = 8 * HTB, NXCD = 8, WGM = 8;

__host__ __device__ __forceinline__ int lds_byte(int r, int c) { const int st = (r >> 4) * 2 + (c >> 5), rr = r & 15, cc = c & 31, ob = rr * 64 + cc * 2; return st * 1024 + (ob ^ (((ob >> 9) & 1) << 5)); }
__host__ __device__ __forceinline__ void stage_rc(int b, int& R, int& C) { const int st = b / 1024, sb = b % 1024, swz = sb ^ (((sb >> 9) & 1) << 5); R = (st >> 1) * 16 + swz / 64; C = (st & 1) * 32 + (swz % 64) / 2; }
__host__ __device__ __forceinline__ int perm32(int rho) { const int n = rho >> 4, i = rho & 15; return 8 * (i >> 2) + 4 * n + (i & 3); }

struct Unit { int pm, pn, ka; };
struct Gemm { const bf16_t* A; const bf16_t* Bt; int M, N, K, lda, ldb; };

struct StaticOrder {
    int nM, nN, nwg, G, c;
    __host__ __device__ void init(int M, int N, int G_, int c_) { nM = M / BM; nN = N / BM; nwg = nM * nN; G = G_; c = c_; }
    __host__ __device__ bool next(int i, Unit& u) const {
        const long L = (long)i * G + c; if (L >= nwg) return false;
        int wgid = (int)L; { const int q = nwg / NXCD, r = nwg % NXCD, xcd = wgid % NXCD, off = wgid / NXCD; wgid = (xcd < r ? xcd * (q + 1) : r * (q + 1) + (xcd - r) * q) + off; }
        const int nig = WGM * nN, gid = wgid / nig, fm = gid * WGM, gsz = (nM - fm) < WGM ? (nM - fm) : WGM;
        u.pm = fm + ((wgid % nig) % gsz); u.pn = (wgid % nig) / gsz; u.ka = 0; return true;
    }
    __device__ __forceinline__ void a_ready(const Unit&) const {}
    __device__ __forceinline__ void done(const Unit&) const {}
};

__device__ __forceinline__ unsigned cvt_pk_bf16(float lo, float hi) { unsigned r; asm volatile("v_cvt_pk_bf16_f32 %0, %1, %2" : "=v"(r) : "v"(lo), "v"(hi)); return r; }
typedef float f32x2 __attribute__((ext_vector_type(2)));

template <class Epi, class Sched, bool ALIGN_EPI = false, bool SP2 = false>
__device__ __forceinline__ void gemm_phase(PG8_LAS unsigned char* lds, const Gemm g, const Sched& S, const Epi& E) {
    const int tid = otid(), wid = __builtin_amdgcn_readfirstlane(tid >> 6), lane = tid & 63, wr = wid >> 2, wc = wid & 3, fr = lane & 15, fq = lane >> 4;
    const int K = g.K, nt = K / BK;
    unsigned voffA[2], voffB[2];
#pragma unroll
    for (int i = 0; i < 2; ++i) { int R, C; stage_rc(tid * 16 + i * 8192, R, C); const int Rb = Epi::PERM ? ((R & ~31) + perm32(R & 31)) : R;
        voffA[i] = (unsigned)(R * g.lda + C) * 2u; voffB[i] = (unsigned)(Rb * g.ldb + C) * 2u; }
    const size_t kstep = (size_t)(BK * 2);
    const size_t hstepA = (size_t)HALF * g.lda * 2, hstepB = (size_t)HALF * g.ldb * 2;
    const size_t tstepA = 2 * hstepA, tstepB = 2 * hstepB;
    const unsigned ldsw = (unsigned)wid * 1024u;
    const int aoff = lds_byte(wr * 64 + fr, fq * 8), boff = lds_byte(wc * 32 + fr, fq * 8);
#define PG8_SA(b, h) (((b) * 2 + (h)) * HTB)
#define PG8_SB(b, h) ((4 + (b) * 2 + (h)) * HTB)
#define PG8_STAGE(bufoff, gbase, voff) do { _Pragma("unroll") for (int _i = 0; _i < 2; ++_i) \
        __builtin_amdgcn_global_load_lds((const unsigned*)((const char*)(gbase) + (voff)[_i]), (PG8_LAS unsigned*)(lds + (bufoff) + ldsw + _i * 8192), 16, 0, 0); } while (0)
#define PG8_LDA(dst, b, h) do { _Pragma("unroll") for (int m = 0; m < 4; ++m) _Pragma("unroll") for (int k = 0; k < 2; ++k) dst[m][k] = *(const PG8_LAS bf16x8*)(lds + PG8_SA(b, h) + aoff + m * 2048 + k * 1024); } while (0)
#define PG8_LDB(dst, b, h) do { _Pragma("unroll") for (int n = 0; n < 2; ++n) _Pragma("unroll") for (int k = 0; k < 2; ++k) dst[n][k] = *(const PG8_LAS bf16x8*)(lds + PG8_SB(b, h) + boff + n * 2048 + k * 1024); } while (0)
#define PG8_MMA(ai, bj, At, Bt) do { __builtin_amdgcn_s_setprio(1); _Pragma("unroll") for (int m = 0; m < 4; ++m) _Pragma("unroll") for (int n = 0; n < 2; ++n) _Pragma("unroll") for (int k = 0; k < 2; ++k) \
        acc[ai][bj][m][n] = __builtin_amdgcn_mfma_f32_16x16x32_bf16(Bt[n][k], At[m][k], acc[ai][bj][m][n], 0, 0, 0); __builtin_amdgcn_s_setprio(0); } while (0)
#define PG8_WAIT_V(n) asm volatile("s_waitcnt vmcnt(" #n ")" ::: "memory")
#define PG8_WAIT_L(n) asm volatile("s_waitcnt lgkmcnt(" #n ")" ::: "memory")
#define PG8_BAR __builtin_amdgcn_s_barrier()
#define PG8_SCHED __builtin_amdgcn_sched_barrier(0)
    Unit cur, nxt; int ui = 0;
    if (!S.next(0, cur)) return;
    f32x4 acc[2][2][4][2];
#pragma unroll
    for (int a = 0; a < 2; ++a)
#pragma unroll
        for (int b = 0; b < 2; ++b)
#pragma unroll
            for (int m = 0; m < 4; ++m)
#pragma unroll
                for (int n = 0; n < 2; ++n) acc[a][b][m][n] = (f32x4){0.f, 0.f, 0.f, 0.f};
    bf16x8 At[4][2], B0[2][2], B1[2][2];
    const char* cA = (const char*)g.A + (size_t)cur.pm * tstepA + (size_t)cur.ka * 2; const char* cB = (const char*)g.Bt + (size_t)cur.pn * tstepB;
    S.a_ready(cur);
    if constexpr (SP2) {
        PG8_STAGE(PG8_SB(0, 0), cB, voffB); PG8_STAGE(PG8_SB(0, 1), cB + hstepB, voffB); PG8_STAGE(PG8_SA(0, 0), cA, voffA); PG8_STAGE(PG8_SA(0, 1), cA + hstepA, voffA);
        if (wr == 1) PG8_BAR;
        PG8_WAIT_V(2); PG8_BAR;
        PG8_STAGE(PG8_SB(1, 0), cB + kstep, voffB); PG8_STAGE(PG8_SA(1, 0), cA + kstep, voffA); PG8_STAGE(PG8_SB(1, 1), cB + hstepB + kstep, voffB);
        PG8_WAIT_V(6); PG8_BAR;
    } else {
        PG8_STAGE(PG8_SB(0, 0), cB, voffB); PG8_STAGE(PG8_SA(0, 0), cA, voffA); PG8_STAGE(PG8_SB(0, 1), cB + hstepB, voffB); PG8_STAGE(PG8_SA(0, 1), cA + hstepA, voffA);
        if (wr == 1) PG8_BAR;
        PG8_WAIT_V(4); PG8_BAR;
        PG8_STAGE(PG8_SB(1, 0), cB + kstep, voffB); PG8_STAGE(PG8_SA(1, 0), cA + kstep, voffA); PG8_STAGE(PG8_SB(1, 1), cB + hstepB + kstep, voffB);
        PG8_WAIT_V(6); PG8_BAR;
    }
    for (;;) {
        const bool has_next = S.next(ui + 1, nxt);
        const char* nA = has_next ? (const char*)g.A + (size_t)nxt.pm * tstepA + (size_t)nxt.ka * 2 : cA; const char* nB = has_next ? (const char*)g.Bt + (size_t)nxt.pn * tstepB : cB;
        for (int t = 0; t < nt; t += 2) {
            const bool last = (t == nt - 2);
            const char* a1 = cA + (size_t)(t + 1) * kstep;
            const char* a2 = last ? nA : cA + (size_t)(t + 2) * kstep; const char* b2 = last ? nB : cB + (size_t)(t + 2) * kstep;
            const char* a3 = a2 + kstep; const char* b3 = b2 + kstep;
            if (last && has_next) S.a_ready(nxt);
            if constexpr (SP2) {
            PG8_LDB(B0, 0, 0); PG8_LDB(B1, 0, 1); PG8_SCHED; PG8_LDA(At, 0, 0); PG8_STAGE(PG8_SA(1, 1), a1 + hstepA, voffA);
            PG8_WAIT_V(8); PG8_WAIT_L(0); PG8_BAR; PG8_MMA(0, 0, At, B0); PG8_MMA(0, 1, At, B1); PG8_BAR; PG8_SCHED;
            PG8_LDA(At, 0, 1); PG8_STAGE(PG8_SB(0, 0), b2, voffB); PG8_STAGE(PG8_SB(0, 1), b2 + hstepB, voffB); PG8_STAGE(PG8_SA(0, 0), a2, voffA);
            PG8_WAIT_V(8); PG8_WAIT_L(0); PG8_BAR; PG8_MMA(1, 0, At, B0); PG8_MMA(1, 1, At, B1); PG8_BAR; PG8_SCHED;
            PG8_LDB(B0, 1, 0); PG8_LDB(B1, 1, 1); PG8_SCHED; PG8_LDA(At, 1, 0); PG8_STAGE(PG8_SA(0, 1), a2 + hstepA, voffA);
            PG8_WAIT_V(8); PG8_WAIT_L(0); PG8_BAR; PG8_MMA(0, 0, At, B0); PG8_MMA(0, 1, At, B1); PG8_BAR; PG8_SCHED;
            PG8_LDA(At, 1, 1); PG8_STAGE(PG8_SB(1, 0), b3, voffB); PG8_STAGE(PG8_SB(1, 1), b3 + hstepB, voffB); PG8_STAGE(PG8_SA(1, 0), a3, voffA);
            PG8_WAIT_V(8); PG8_WAIT_L(0); PG8_BAR; PG8_MMA(1, 0, At, B0); PG8_MMA(1, 1, At, B1); PG8_BAR; PG8_SCHED;
            } else {
            PG8_LDB(B0, 0, 0); PG8_SCHED; PG8_LDA(At, 0, 0); PG8_STAGE(PG8_SA(1, 1), a1 + hstepA, voffA);
            PG8_WAIT_L(8); PG8_BAR; PG8_WAIT_L(0); PG8_MMA(0, 0, At, B0); PG8_BAR; PG8_SCHED;
            PG8_LDB(B1, 0, 1); PG8_STAGE(PG8_SB(0, 0), b2, voffB);
            PG8_BAR; PG8_WAIT_L(0); PG8_MMA(0, 1, At, B1); PG8_BAR;
            PG8_LDA(At, 0, 1); PG8_STAGE(PG8_SA(0, 0), a2, voffA);
            PG8_BAR; PG8_WAIT_L(0); PG8_MMA(1, 0, At, B0); PG8_BAR; PG8_SCHED;
            PG8_STAGE(PG8_SB(0, 1), b2 + hstepB, voffB);
            PG8_WAIT_V(6); PG8_BAR; PG8_MMA(1, 1, At, B1); PG8_BAR;
            PG8_LDB(B0, 1, 0); PG8_SCHED; PG8_LDA(At, 1, 0); PG8_STAGE(PG8_SA(0, 1), a2 + hstepA, voffA);
            PG8_WAIT_L(8); PG8_BAR; PG8_WAIT_L(0); PG8_MMA(0, 0, At, B0); PG8_BAR; PG8_SCHED;
            PG8_LDB(B1, 1, 1); PG8_STAGE(PG8_SB(1, 0), b3, voffB);
            PG8_BAR; PG8_WAIT_L(0); PG8_MMA(0, 1, At, B1); PG8_BAR;
            PG8_LDA(At, 1, 1); PG8_STAGE(PG8_SA(1, 0), a3, voffA);
            PG8_BAR; PG8_WAIT_L(0); PG8_MMA(1, 0, At, B0); PG8_BAR; PG8_SCHED;
            PG8_STAGE(PG8_SB(1, 1), b3 + hstepB, voffB);
            PG8_WAIT_V(6); PG8_BAR; PG8_MMA(1, 1, At, B1); PG8_BAR;
            }
        }
        if constexpr (ALIGN_EPI) { if (wr == 0) PG8_BAR; }
        if constexpr (!Epi::AFTER_DRAIN) { E(acc, cur, wr, wc, fr, fq); S.done(cur); }
        if (!has_next) break;
#pragma unroll
        for (int a = 0; a < 2; ++a)
#pragma unroll
            for (int b = 0; b < 2; ++b)
#pragma unroll
                for (int m = 0; m < 4; ++m)
#pragma unroll
                    for (int n = 0; n < 2; ++n) acc[a][b][m][n] = (f32x4){0.f, 0.f, 0.f, 0.f};
        cur = nxt; cA = nA; cB = nB; ++ui;
        if constexpr (ALIGN_EPI) { if (wr == 1) PG8_BAR; }
    }
    PG8_WAIT_V(0);
    if constexpr (!ALIGN_EPI) { if (wr == 0) PG8_BAR; }
    PG8_BAR;
    if constexpr (Epi::AFTER_DRAIN) { E.fused(acc, cur, wr, wc, fr, fq, lds, wid, lane); S.done(cur); }
#undef PG8_SA
#undef PG8_SB
#undef PG8_STAGE
#undef PG8_LDA
#undef PG8_LDB
#undef PG8_MMA
#undef PG8_WAIT_V
#undef PG8_WAIT_L
#undef PG8_BAR
#undef PG8_SCHED
}
}

#define GAS __attribute__((address_space(1)))
#define LAS __attribute__((address_space(3)))
typedef unsigned short bf16;
typedef unsigned v4u __attribute__((ext_vector_type(4)));
typedef float f32x4 __attribute__((ext_vector_type(4)));
typedef short bf16x8 __attribute__((ext_vector_type(8)));
typedef GAS unsigned gu32;
typedef GAS unsigned long long gu64;
#define RLX_AGENT __ATOMIC_RELAXED, __HIP_MEMORY_SCOPE_AGENT
#define LDS_WAIT() asm volatile("s_waitcnt lgkmcnt(0)" ::: "memory")
#define VM_WAIT() asm volatile("s_waitcnt vmcnt(0)" ::: "memory")
__device__ __forceinline__ unsigned long long rt() { return __builtin_amdgcn_s_memrealtime(); }
__device__ __forceinline__ unsigned f2bf(float f) { unsigned u = __builtin_bit_cast(unsigned, f); return (u + 0x7fffu + ((u >> 16) & 1u)) >> 16; }
__device__ __forceinline__ unsigned pk2(float lo, float hi) { return f2bf(lo) | (f2bf(hi) << 16); }

#define XB_TMO      128
#define XB_XCNT(j)  (256  + 64 * (j))
#define XB_XSUB(j)  (1280 + 64 * (j))
#define XB_XGEN(j)  (2304 + 64 * (j))
#define XB_TOP      3328
#define XB_TOPGEN   3392
#define XCD_BAR_WORDS 3456
#define XB_SPIN_CAP (1u << 18)

__device__ __forceinline__ unsigned xb_ld(unsigned* p)              { return __hip_atomic_load(p, __ATOMIC_RELAXED, __HIP_MEMORY_SCOPE_AGENT); }
__device__ __forceinline__ unsigned xb_add(unsigned* p, unsigned v) { return __hip_atomic_fetch_add(p, v, __ATOMIC_RELAXED, __HIP_MEMORY_SCOPE_AGENT); }
__device__ __forceinline__ unsigned xb_xcc_id() { return (unsigned)__builtin_amdgcn_s_getreg((3 << 11) | 20) & 0xFu; }
#define XB_SPIN(cond, bar) do { unsigned _sp = 0; while (cond) { __builtin_amdgcn_s_sleep(1); \
    if ((++_sp & 255u) == 0u) { if (xb_ld(&(bar)[XB_TMO])) break; if (_sp > XB_SPIN_CAP) { atomicAdd(&(bar)[XB_TMO], 1u); break; } } } } while (0)

struct XcdBarrier {
    unsigned* bar; unsigned x;
    volatile LAS unsigned* st;
};

__device__ __forceinline__ XcdBarrier xcd_barrier_post(unsigned* bar, volatile LAS unsigned* st) {
    XcdBarrier b; b.bar = bar; b.x = xb_xcc_id(); b.st = st;
    if (threadIdx.x == 0) (void)xb_add(&bar[XB_XCNT(b.x)], 1u);
    return b;
}
__device__ __forceinline__ void xcd_barrier_complete(unsigned* bar, unsigned x, unsigned& nloc, unsigned& nx) {
    const unsigned G = gridDim.x * gridDim.y * gridDim.z;
    unsigned sum, cnt, mine, sp = 0u;
    for (;;) {
        sum = 0u; cnt = 0u; mine = 0u;
#pragma unroll
        for (unsigned j = 0; j < 16; ++j) { const unsigned c = xb_ld(&bar[XB_XCNT(j)]); sum += c; cnt += (c > 0u) ? 1u : 0u; mine = (j == x) ? c : mine; }
        if (sum == G) break;
        __builtin_amdgcn_s_sleep(1);
        if ((++sp & 255u) == 0u) { if (xb_ld(&bar[XB_TMO])) break; if (sp > XB_SPIN_CAP) { atomicAdd(&bar[XB_TMO], 1u); break; } }
    }
    nloc = mine > 0u ? mine : 1u; nx = cnt > 0u ? cnt : 1u;
}

__device__ __forceinline__ void xcd_barrier(const XcdBarrier& b) {
    asm volatile("s_waitcnt vmcnt(0)" ::: "memory");
    __syncthreads();
    if (threadIdx.x == 0) {
        unsigned* bar = b.bar;
        __builtin_amdgcn_s_waitcnt(0);
        unsigned nloc = b.st[0], nx = b.st[1];
        if (nloc == 0u) { xcd_barrier_complete(bar, b.x, nloc, nx); b.st[0] = nloc; b.st[1] = nx; }
        const unsigned old = xb_add(&bar[XB_XSUB(b.x)], 1u);
        const unsigned gen = old / nloc;
        if (old + 1u == (gen + 1u) * nloc) {
            __builtin_amdgcn_fence(__ATOMIC_RELEASE, "agent");
            asm volatile("s_waitcnt vmcnt(0)" ::: "memory");
            const unsigned og = xb_add(&bar[XB_TOP], 1u);
            const unsigned tg = og / nx;
            if (og + 1u == (tg + 1u) * nx) xb_add(&bar[XB_TOPGEN], 1u);
            else XB_SPIN(xb_ld(&bar[XB_TOPGEN]) == tg, bar);
            __builtin_amdgcn_fence(__ATOMIC_ACQUIRE, "agent");
            xb_add(&bar[XB_XGEN(b.x)], 1u);
            asm volatile("s_waitcnt vmcnt(0)" ::: "memory");
        } else {
            XB_SPIN(xb_ld(&bar[XB_XGEN(b.x)]) == gen, bar);
            __builtin_amdgcn_fence(__ATOMIC_ACQUIRE, "agent");
            asm volatile("s_waitcnt vmcnt(0)" ::: "memory");
        }
    }
    __syncthreads();
}


constexpr int NWAVES = 8, NTHREADS = 512;
constexpr int SEQ = 8192, DMODEL = 2048, NLAYER = 2;
constexpr int INC = 13088;
constexpr int ZC = 13312;
constexpr int ZC_CQ = 0, ZC_CKV = 512, ZC_BG = 768, ZC_CG = 1280, ZC_XV = 1792, ZC_DQ = 2304, ZC_DK = 2816, ZC_DV = 3328, ZC_CA = 3840, ZC_CGT = 4352, ZC_KR = 4864, ZC_GATE = 5120;
constexpr int QMC = 768, KVC = 1024;
constexpr float LOG2E = 1.4426950408889634f;
constexpr float C2_MLA = 0.10206207261596577f * LOG2E;
constexpr float C2_DIFF = 0.125f * LOG2E;
constexpr float NORM_EPS = 1e-6f, LN_EPS = 1e-5f;
constexpr int PEER_NE = 16384;

constexpr size_t MiB = 1u << 20;
constexpr size_t WS_CTL = 0, CTL_ZERO_BYTES = 1 * MiB;
constexpr size_t WS_COSM = 1 * MiB, WS_SINM = WS_COSM + 512 * 1024, WS_COSD = 2 * MiB, WS_SIND = WS_COSD + 256 * 1024, WS_RSTD = 3 * MiB;
constexpr size_t WS_WIN = 4 * MiB;
constexpr size_t WS_WUQ = 56 * MiB;
constexpr size_t WS_WUKV = 57 * MiB;
constexpr size_t WS_WOUT = 58 * MiB;
constexpr size_t WS_WO = 66 * MiB;
constexpr size_t WS_WQ = 74 * MiB;
constexpr size_t WS_UBF = 80 * MiB;
constexpr size_t WS_VBF = 144 * MiB;
constexpr size_t WS_H = 208 * MiB;
constexpr size_t WS_H2 = 240 * MiB;
constexpr size_t WS_Z = 272 * MiB;
constexpr size_t WS_QM = 480 * MiB;
constexpr size_t WS_KVM = 492 * MiB;
constexpr size_t WS_ACT = 508 * MiB;
constexpr size_t WS_DO = 540 * MiB;
constexpr size_t WS_MERGED = 556 * MiB;
constexpr size_t WS_XA = 588 * MiB;
constexpr size_t WS_PQ = 652 * MiB;
constexpr size_t WS_IDX = 684 * MiB;
constexpr size_t WS_GATE = 688 * MiB;
constexpr size_t WS_END = 692 * MiB;
constexpr int CW_BAR = 4096;
constexpr int CW_QATT = 16384;

constexpr int RING_BYTES = 131072;
constexpr int LDSCTL_OFF = RING_BYTES, MISC_OFF = LDSCTL_OFF + 320;
constexpr int LDS_PART_OFF = LDSCTL_OFF + 1024;
constexpr int LDS_BYTES = 147456;

struct Frame {
    LAS unsigned char* lds;
    volatile LAS unsigned* MISC;
    gu32* ctl;
    int G;
    unsigned char* ws_base;
};
#define PHASE_IDS() const int tid = otid(), lane = tid & 63, wave = __builtin_amdgcn_readfirstlane(tid >> 6); (void)lane; (void)wave; unsigned char* const ws = ows(F.ws_base); (void)ws

template <int CTRL> __device__ __forceinline__ float dpp_f(float v) { return __builtin_bit_cast(float, __builtin_amdgcn_update_dpp(0, __builtin_bit_cast(int, v), CTRL, 0xF, 0xF, false)); }
__device__ __forceinline__ float rl(float v, int l) { return __builtin_bit_cast(float, __builtin_amdgcn_readlane(__builtin_bit_cast(int, v), l)); }
__device__ __forceinline__ float wave_sum(float v) {
    v += dpp_f<0xB1>(v); v += dpp_f<0x4E>(v); v += dpp_f<0x141>(v); v += dpp_f<0x140>(v);
    return (rl(v, 0) + rl(v, 16)) + (rl(v, 32) + rl(v, 48));
}
__device__ __forceinline__ float wave_max(float v) {
    v = fmaxf(v, dpp_f<0xB1>(v)); v = fmaxf(v, dpp_f<0x4E>(v)); v = fmaxf(v, dpp_f<0x141>(v)); v = fmaxf(v, dpp_f<0x140>(v));
    return fmaxf(fmaxf(rl(v, 0), rl(v, 16)), fmaxf(rl(v, 32), rl(v, 48)));
}
__device__ __forceinline__ float row16_sum(float v) { v += dpp_f<0xB1>(v); v += dpp_f<0x4E>(v); v += dpp_f<0x141>(v); v += dpp_f<0x140>(v); return v; }
__device__ __forceinline__ float bf_lo(unsigned w) { return __builtin_bit_cast(float, w << 16); }
__device__ __forceinline__ float bf_hi(unsigned w) { return __builtin_bit_cast(float, w & 0xffff0000u); }
__device__ __forceinline__ float bf2f(bf16 b) { return __builtin_bit_cast(float, (unsigned)b << 16); }
__device__ __forceinline__ float sigmoidf_(float x) { return 1.f / (1.f + __expf(-x)); }
typedef __bf16 bf16x2_t __attribute__((ext_vector_type(2)));
__device__ __forceinline__ float dot2_bf16(unsigned w, unsigned x, float acc) { return __builtin_amdgcn_fdot2_f32_bf16(__builtin_bit_cast(bf16x2_t, w), __builtin_bit_cast(bf16x2_t, x), acc, false); }

__device__ __forceinline__ int colmap(int mode, int c) {
    if (mode == 0) return c;
    if (mode == 1) {
        if (c < 768) return c;
        if (c < 2304) return 800 + (c - 768);
        if (c < 3328) { const int seg = c >= 2816, o = c - (seg ? 2816 : 2304), d = o & 63, dd = d < 16 ? ((d >> 1) + 8 * (d & 1)) : d; return (seg ? 2848 : 2336) + (o & ~63) + dd; }
        if (c < 3840) return 3360 + (c - 3328);
        if (c < 4864) return 3872 + (c - 3840);
        if (c < 4896) { const int d = c - 4864; return 768 + (d >> 1) + 16 * (d & 1); }
        if (c < 5120) return -1;
        return 4896 + (c - 5120);
    }
    { const int hd = c / 96, d = c % 96; if (d < 64) return c; const int e = d - 64; return hd * 96 + 64 + (e >> 1) + 16 * (e & 1); }
}
__device__ __forceinline__ void tr_item(const float* W, int ldw, const float* gk, bf16* WT, int ldt, int nblk, int item, int mode, LAS float* scr, int lane) {
    const int kb = item / nblk, nb = item % nblk, k0 = 64 * kb, n0 = 32 * nb;
    const int sc = colmap(mode, n0 + (lane & 31));
#pragma unroll 8
    for (int i = 0; i < 32; ++i) { const int kk = 2 * i + (lane >> 5); float v = 0.f; if (sc >= 0) { v = W[(size_t)(k0 + kk) * ldw + sc]; if (gk) v *= gk[k0 + kk]; } scr[kk * 33 + (lane & 31)] = v; }
    LDS_WAIT(); asm volatile("" ::: "memory");
    const int c = lane & 7;
#pragma unroll
    for (int j = 0; j < 4; ++j) { const int n = (lane >> 3) + 8 * j; const LAS float* s = scr + (8 * c) * 33 + n;
        v4u o; o.x = pk2(s[0 * 33], s[1 * 33]); o.y = pk2(s[2 * 33], s[3 * 33]); o.z = pk2(s[4 * 33], s[5 * 33]); o.w = pk2(s[6 * 33], s[7 * 33]);
        *(GAS v4u*)(WT + (size_t)(n0 + n) * ldt + k0 + 8 * c) = o; }
    LDS_WAIT(); asm volatile("" ::: "memory");
}
__device__ __forceinline__ void rms_row_to_bf16(const float* xrow, const float* g, bf16* orow, int lane) {
    const GAS f32x4* xr = (const GAS f32x4*)xrow + lane; const GAS f32x4* gr = (const GAS f32x4*)g + lane;
    f32x4 v[8]; float s = 0.f;
#pragma unroll
    for (int j = 0; j < 8; ++j) { v[j] = xr[64 * j]; s += (v[j].x * v[j].x + v[j].y * v[j].y) + (v[j].z * v[j].z + v[j].w * v[j].w); }
    const float rstd = 1.f / sqrtf(wave_sum(s) * (1.f / DMODEL) + NORM_EPS);
    GAS unsigned long long* o8 = (GAS unsigned long long*)orow + lane;
#pragma unroll
    for (int j = 0; j < 8; ++j) { const f32x4 gg = gr[64 * j]; o8[64 * j] = (unsigned long long)pk2(v[j].x * rstd * gg.x, v[j].y * rstd * gg.y) | ((unsigned long long)pk2(v[j].z * rstd * gg.z, v[j].w * rstd * gg.w) << 32); }
}
#define CAS __attribute__((address_space(4)))
__device__ __forceinline__ const float* inp(int i) { unsigned off = (unsigned)i * 8u; asm volatile("" : "+s"(off)); const CAS char* kp = (const CAS char*)__builtin_amdgcn_kernarg_segment_ptr(); return *(const float* const CAS*)(kp + off); }
struct LayerW {
    const float *mix_g, *w_in, *gate_b, *q_g, *w_uq, *kv_g, *w_ukv, *mla_wo, *sc_w, *sc_wo, *lam, *diff_g, *diff_wo, *cf_w, *cf_b, *cf_g, *cf_bb, *cf_wo, *w_o, *ffn_g, *w_q, *subk, *pu, *pv;
};
__device__ __forceinline__ void p0_prologue(Frame& F, int layer) {
    PHASE_IDS();
    LAS float* scr = (LAS float*)(F.lds + wave * 16384);
    const int gw = blockIdx.x * NWAVES + wave, NGW = F.G * NWAVES;
    constexpr int I_IN = 32 * (ZC / 32), I_UQ = 8 * 24, I_UKV = 4 * 32, I_OUT = 8 * 64, I_O = 32 * 64, I_Q = 32 * 32;
    constexpr int NITEMS = I_IN + I_UQ + I_UKV + 4 * I_OUT + I_O + I_Q;
    for (int it = gw; it < NITEMS; it += NGW) {
        int r = it, ldw, ldt, nblk, mode = 0; const float* src; const float* gk = nullptr; bf16* dst;
        if (r < I_IN) { src = inp(3) + (size_t)layer * 2048 * INC; ldw = INC; dst = (bf16*)(ws + WS_WIN); ldt = 2048; nblk = ZC / 32; mode = 1; }
        else if ((r -= I_IN) < I_UQ) { src = inp(6) + (size_t)layer * 512 * 768; gk = inp(5) + (size_t)layer * 512; ldw = 768; dst = (bf16*)(ws + WS_WUQ); ldt = 512; nblk = 24; mode = 2; }
        else if ((r -= I_UQ) < I_UKV) { src = inp(8) + (size_t)layer * 256 * 1024; gk = inp(7) + (size_t)layer * 256; ldw = 1024; dst = (bf16*)(ws + WS_WUQ) + (size_t)768 * 512; ldt = 512; nblk = 32; }
        else if ((r -= I_UKV) < 4 * I_OUT) { const int br = r / I_OUT; r -= br * I_OUT; src = inp(br == 0 ? 9 : br == 1 ? 11 : br == 2 ? 14 : 19) + (size_t)layer * 512 * 2048; ldw = 2048; dst = (bf16*)(ws + WS_WOUT) + (size_t)br * 2048 * 512; ldt = 512; nblk = 64; }
        else if ((r -= 4 * I_OUT) < I_O) { src = inp(20) + (size_t)layer * 2048 * 2048; ldw = 2048; dst = (bf16*)(ws + WS_WO); ldt = 2048; nblk = 64; }
        else { r -= I_O; src = inp(22) + (size_t)layer * 2048 * 1024; ldw = 1024; dst = (bf16*)(ws + WS_WQ); ldt = 2048; nblk = 32; }
        tr_item(src, ldw, gk, dst, ldt, nblk, r, mode, scr, lane);
    }
    for (int i = blockIdx.x * NTHREADS + tid; i < 1024 * 32; i += F.G * NTHREADS) { const int n = i >> 5, ch = i & 31; *(GAS v4u*)((bf16*)(ws + WS_WUQ) + (size_t)(768 + n) * 512 + 256 + 8 * ch) = (v4u){0u, 0u, 0u, 0u}; }
    { const size_t nchunk = (size_t)PEER_NE * DMODEL / 8;
      for (int t = 0; t < 2; ++t) { const GAS f32x4* src = (const GAS f32x4*)(inp(t ? 25 : 24) + (size_t)layer * PEER_NE * 2048); GAS v4u* dst = (GAS v4u*)(ws + (t ? WS_VBF : WS_UBF));
        for (size_t i = (size_t)gw * 64 + lane; i < nchunk; i += (size_t)NGW * 64) { const f32x4 a = src[2 * i], b = src[2 * i + 1]; v4u o; o.x = pk2(a.x, a.y); o.y = pk2(a.z, a.w); o.z = pk2(b.x, b.y); o.w = pk2(b.z, b.w); dst[i] = o; } } }
    if (layer == 0) {
        const int* positions = (const int*)inp(1);
        float* cosm = (float*)(ws + WS_COSM); float* sinm = (float*)(ws + WS_SINM); float* cosd = (float*)(ws + WS_COSD); float* sind = (float*)(ws + WS_SIND);
        for (int i = blockIdx.x * NTHREADS + tid; i < SEQ * 24; i += F.G * NTHREADS) {
            const int s = i / 24, j = i % 24; const float pos = (float)positions[s];
            const float ex = j < 16 ? (float)j * (1.f / 16.f) : (float)(j - 16) * (1.f / 8.f);
            const float inv = exp2f(-ex * 18.931568569324174f);
            const float ang = pos * inv;
            double rev = (double)ang * 0.15915494309189535; rev -= floor(rev);
            const float fr = (float)rev; const float cv = __builtin_amdgcn_cosf(fr), sv = __builtin_amdgcn_sinf(fr);
            if (j < 16) { cosm[s * 16 + j] = cv; sinm[s * 16 + j] = sv; } else { cosd[s * 8 + (j - 16)] = cv; sind[s * 8 + (j - 16)] = sv; }
        }
        { const float* x = inp(0); const float* mg = inp(2);
          for (int m = gw; m < SEQ; m += NGW) rms_row_to_bf16(x + (size_t)m * DMODEL, mg, (bf16*)(ws + WS_H) + (size_t)m * DMODEL, lane); }
    }
}

namespace pg8 {
template <class Fn> __device__ __forceinline__ void walk8(const f32x4 (&acc)[2][2][4][2], int pm, int pn, int wr, int wc, int fr, int fq, Fn f) {
    const int row0 = pm * BM + wr * 64 + fr, col0 = pn * BM + wc * 32 + 8 * fq;
#pragma unroll
    for (int ai = 0; ai < 2; ++ai)
#pragma unroll
        for (int m = 0; m < 4; ++m)
#pragma unroll
            for (int bj = 0; bj < 2; ++bj) f(row0 + ai * HALF + m * 16, col0 + bj * HALF, acc[ai][bj][m][0], acc[ai][bj][m][1]);
}
__device__ __forceinline__ u32x4 pack8(f32x4 v0, f32x4 v1) { u32x4 w; w.x = cvt_pk_bf16(v0[0], v0[1]); w.y = cvt_pk_bf16(v0[2], v0[3]); w.z = cvt_pk_bf16(v1[0], v1[1]); w.w = cvt_pk_bf16(v1[2], v1[3]); return w; }
__device__ __forceinline__ void rope4(f32x4& v0, f32x4& v1, const float* cs, const float* sn) {
    const f32x4 c = *(const f32x4*)cs, s = *(const f32x4*)sn;
    const float a0 = v0[0], b0 = v0[1], a1 = v0[2], b1 = v0[3], a2 = v1[0], b2 = v1[1], a3 = v1[2], b3 = v1[3];
    v0[0] = a0 * c[0] - b0 * s[0]; v0[1] = b0 * c[0] + a0 * s[0]; v0[2] = a1 * c[1] - b1 * s[1]; v0[3] = b1 * c[1] + a1 * s[1];
    v1[0] = a2 * c[2] - b2 * s[2]; v1[1] = b2 * c[2] + a2 * s[2]; v1[2] = a3 * c[3] - b3 * s[3]; v1[3] = b3 * c[3] + a3 * s[3];
}
struct EpiZ {
    static constexpr bool PERM = true, AFTER_DRAIN = false;
    bf16_t* Z; const float *cosm, *sinm, *cosd, *sind;
    __device__ __forceinline__ void operator()(const f32x4 (&acc)[2][2][4][2], const Unit& u, int wr, int wc, int fr, int fq) const {
        const bool special = (u.pn >= 9 && u.pn <= 12) || u.pn == 19;
        walk8(acc, u.pm, u.pn, wr, wc, fr, fq, [&](int row, int col, f32x4 v0, f32x4 v1) {
            if (special) {
                if (col < ZC_DV) { const int d = col & 63; if (d < 16) rope4(v0, v1, cosd + row * 8 + (d >> 1), sind + row * 8 + (d >> 1)); if (col < ZC_DK) { v0 = v0 * C2_DIFF; v1 = v1 * C2_DIFF; } }
                else if (col < ZC_KR + 32) { const int d = col - ZC_KR; rope4(v0, v1, cosm + row * 16 + (d >> 1), sinm + row * 16 + (d >> 1)); }
            }
            *(u32x4*)(Z + (size_t)row * ZC + col) = pack8(v0, v1); });
    }
};
struct QKVOrder {
    StaticOrder S0;
    __device__ __forceinline__ bool next(int i, Unit& u) const { if (!S0.next(i, u)) return false; u.ka = u.pn >= 3 ? ZC_CKV : ZC_CQ; return true; }
    __device__ __forceinline__ void a_ready(const Unit&) const {}
    __device__ __forceinline__ void done(const Unit&) const {}
};
struct EpiQKV {
    static constexpr bool PERM = true, AFTER_DRAIN = false;
    bf16_t* QMo; bf16_t* KVo; const float* rstd; const float *cosm, *sinm;
    __device__ __forceinline__ void operator()(const f32x4 (&acc)[2][2][4][2], const Unit& u, int wr, int wc, int fr, int fq) const {
        const bool isq = u.pn < 3;
        walk8(acc, u.pm, u.pn, wr, wc, fr, fq, [&](int row, int col, f32x4 v0, f32x4 v1) {
            if (isq) {
                const float sc = rstd[row * 2] * C2_MLA; v0 = v0 * sc; v1 = v1 * sc;
                const int d = col % 96; if (d >= 64) rope4(v0, v1, cosm + row * 16 + ((d - 64) >> 1), sinm + row * 16 + ((d - 64) >> 1));
                *(u32x4*)(QMo + (size_t)row * QMC + col) = pack8(v0, v1);
            } else {
                const float sc = rstd[row * 2 + 1]; v0 = v0 * sc; v1 = v1 * sc;
                *(u32x4*)(KVo + (size_t)row * KVC + (col - QMC)) = pack8(v0, v1);
            } });
    }
};
struct MergedOrder {
    StaticOrder S0;
    __device__ __forceinline__ bool next(int i, Unit& u) const { Unit t; if (!S0.next(i >> 2, t)) return false; const int br = i & 3; u.pm = br * 32 + t.pm; u.pn = br * 8 + t.pn; u.ka = 0; return true; }
    __device__ __forceinline__ void a_ready(const Unit&) const {}
    __device__ __forceinline__ void done(const Unit&) const {}
};
struct EpiMerged {
    static constexpr bool PERM = true, AFTER_DRAIN = false;
    bf16_t* Mg; const bf16_t* Z; const float* gate_b;
    __device__ __forceinline__ void operator()(const f32x4 (&acc)[2][2][4][2], const Unit& u, int wr, int wc, int fr, int fq) const {
        const int br = u.pm >> 5, pm = u.pm & 31, pn = u.pn & 7;
        walk8(acc, pm, pn, wr, wc, fr, fq, [&](int row, int col, f32x4 v0, f32x4 v1) {
            const u32x4 gz = *(const u32x4*)(Z + (size_t)row * ZC + ZC_GATE + br * 2048 + col);
            const f32x4 b0 = *(const f32x4*)(gate_b + br * 2048 + col), b1 = *(const f32x4*)(gate_b + br * 2048 + col + 4);
            float g[8] = {bf_lo(gz.x) + b0[0], bf_hi(gz.x) + b0[1], bf_lo(gz.y) + b0[2], bf_hi(gz.y) + b0[3], bf_lo(gz.z) + b1[0], bf_hi(gz.z) + b1[1], bf_lo(gz.w) + b1[2], bf_hi(gz.w) + b1[3]};
            float o[8];
#pragma unroll
            for (int i = 0; i < 8; ++i) { const float s = 1.f / (1.f + __expf(-g[i])); o[i] = s * (i < 4 ? v0[i] : v1[i - 4]); }
            bf16_t* mp = Mg + (size_t)row * 2048 + col;
            if (br > 0) { const u32x4 old = *(const u32x4*)mp; o[0] += bf_lo(old.x); o[1] += bf_hi(old.x); o[2] += bf_lo(old.y); o[3] += bf_hi(old.y); o[4] += bf_lo(old.z); o[5] += bf_hi(old.z); o[6] += bf_lo(old.w); o[7] += bf_hi(old.w); }
            u32x4 w; w.x = cvt_pk_bf16(o[0], o[1]); w.y = cvt_pk_bf16(o[2], o[3]); w.z = cvt_pk_bf16(o[4], o[5]); w.w = cvt_pk_bf16(o[6], o[7]);
            *(u32x4*)mp = w; });
    }
};
struct EpiResF32 {
    static constexpr bool PERM = false, AFTER_DRAIN = false;
    const float* base; float* C; int ldc;
    __device__ __forceinline__ void operator()(const f32x4 (&acc)[2][2][4][2], const Unit& u, int wr, int wc, int fr, int fq) const {
        const int row0 = u.pm * BM + wr * 64 + fr, col0 = u.pn * BM + wc * 32 + 4 * fq;
#pragma unroll
        for (int ai = 0; ai < 2; ++ai)
#pragma unroll
            for (int m = 0; m < 4; ++m) { const size_t ro = (size_t)(row0 + ai * HALF + m * 16) * ldc + col0;
#pragma unroll
                for (int bj = 0; bj < 2; ++bj)
#pragma unroll
                    for (int n = 0; n < 2; ++n) { f32x4 v = acc[ai][bj][m][n]; if (base) v = v + *(const f32x4*)(base + ro + bj * HALF + n * 16); *(f32x4*)(C + ro + bj * HALF + n * 16) = v; } }
    }
};
}

__device__ __forceinline__ void p2_branch_prep(Frame& F, int layer) {
    LayerW W; W.sc_w = inp(10) + (size_t)layer * 3 * 512; W.cf_w = inp(15) + (size_t)layer * 31 * 512; W.cf_b = inp(16) + (size_t)layer * 512; W.cf_g = inp(17) + (size_t)layer * 512; W.cf_bb = inp(18) + (size_t)layer * 512;
    PHASE_IDS();
    const bf16* Z = (const bf16*)(ws + WS_Z);
    float* rstd = (float*)(ws + WS_RSTD);
    bf16* act_sc = (bf16*)(ws + WS_ACT) + (size_t)1 * SEQ * 512;
    bf16* act_cf = (bf16*)(ws + WS_ACT) + (size_t)3 * SEQ * 512;
    LAS float* ul = (LAS float*)F.lds;
    LAS float* part = (LAS float*)(F.lds + LDS_PART_OFF);
    const int c = tid;
    for (int tile = blockIdx.x; tile < SEQ / 32; tile += F.G) {
        const int t0 = tile * 32;
#pragma unroll
        for (int i = 0; i < 4; ++i) { const int tok = t0 + 4 * wave + i;
            const v4u a = *(const GAS v4u*)(Z + (size_t)tok * ZC + ZC_CQ + 8 * lane);
            float s = bf_lo(a.x) * bf_lo(a.x) + bf_hi(a.x) * bf_hi(a.x) + bf_lo(a.y) * bf_lo(a.y) + bf_hi(a.y) * bf_hi(a.y) + bf_lo(a.z) * bf_lo(a.z) + bf_hi(a.z) * bf_hi(a.z) + bf_lo(a.w) * bf_lo(a.w) + bf_hi(a.w) * bf_hi(a.w);
            s = wave_sum(s);
            const unsigned long long b = *(const GAS unsigned long long*)(Z + (size_t)tok * ZC + ZC_CKV + 4 * lane);
            const unsigned b0 = (unsigned)b, b1 = (unsigned)(b >> 32);
            float s2 = bf_lo(b0) * bf_lo(b0) + bf_hi(b0) * bf_hi(b0) + bf_lo(b1) * bf_lo(b1) + bf_hi(b1) * bf_hi(b1);
            s2 = wave_sum(s2);
            if (lane == 0) { rstd[tok * 2] = 1.f / sqrtf(s * (1.f / 512.f) + NORM_EPS); rstd[tok * 2 + 1] = 1.f / sqrtf(s2 * (1.f / 256.f) + NORM_EPS); } }
        { const float w0 = W.sc_w[c], w1 = W.sc_w[512 + c], w2 = W.sc_w[1024 + c];
          float pm2 = 0.f, pm1 = 0.f;
          if (t0 >= 2) { pm2 = bf2f(Z[(size_t)(t0 - 2) * ZC + ZC_CG + c]) * bf2f(Z[(size_t)(t0 - 2) * ZC + ZC_XV + c]); pm1 = bf2f(Z[(size_t)(t0 - 1) * ZC + ZC_CG + c]) * bf2f(Z[(size_t)(t0 - 1) * ZC + ZC_XV + c]); }
#pragma unroll 4
          for (int t = 0; t < 32; ++t) { const size_t ro = (size_t)(t0 + t) * ZC;
            const float p = bf2f(Z[ro + ZC_CG + c]) * bf2f(Z[ro + ZC_XV + c]);
            const float y = w0 * pm2 + w1 * pm1 + w2 * p;
            act_sc[(size_t)(t0 + t) * 512 + c] = (bf16)f2bf(bf2f(Z[ro + ZC_BG + c]) * y);
            pm2 = pm1; pm1 = p; } }
        for (int r = 0; r < 62; ++r) { const int tok = t0 - 30 + r; float u = 0.f;
            if (tok >= 0) { const size_t ro = (size_t)tok * ZC; u = bf2f(Z[ro + ZC_CA + c]) * sigmoidf_(bf2f(Z[ro + ZC_CGT + c])); }
            ul[r * 512 + c] = u; }
        __syncthreads();
        float y[32];
        { const float bias = W.cf_b[c];
#pragma unroll
          for (int t = 0; t < 32; ++t) y[t] = bias; }
        for (int j = 0; j < 31; ++j) { const float wj = W.cf_w[j * 512 + c];
#pragma unroll
            for (int t = 0; t < 32; ++t) y[t] += wj * ul[(t + j) * 512 + c]; }
#pragma unroll
        for (int t = 0; t < 32; ++t) { const float s = wave_sum(y[t]), q = wave_sum(y[t] * y[t]); if (lane == 0) { part[(t * 8 + wave) * 2] = s; part[(t * 8 + wave) * 2 + 1] = q; } __builtin_amdgcn_sched_barrier(0); }
        __syncthreads();
        { const float g = W.cf_g[c], bb = W.cf_bb[c];
#pragma unroll
          for (int t = 0; t < 32; ++t) { float s = 0.f, q = 0.f;
#pragma unroll
            for (int w = 0; w < 8; ++w) { s += part[(t * 8 + w) * 2]; q += part[(t * 8 + w) * 2 + 1]; }
            const float mean = s * (1.f / 512.f); const float var = fmaxf(q * (1.f / 512.f) - mean * mean, 0.f);
            const float v = (y[t] - mean) * (1.f / sqrtf(var + LN_EPS)) * g + bb;
            act_cf[(size_t)(t0 + t) * 512 + c] = (bf16)f2bf(v * sigmoidf_(v)); } }
        __syncthreads();
    }
}

typedef float f32x16 __attribute__((ext_vector_type(16)));
typedef short s16x4 __attribute__((ext_vector_type(4)));
typedef unsigned u32x2 __attribute__((ext_vector_type(2)));
__device__ __forceinline__ s16x4 vtr(const LAS unsigned char* p) { return __builtin_bit_cast(s16x4, __builtin_amdgcn_ds_read_tr16_b64_v4i16((LAS s16x4*)p)); }
__device__ __forceinline__ float xhalf_max(float m) { auto rr = __builtin_amdgcn_permlane32_swap(__builtin_bit_cast(unsigned, m), __builtin_bit_cast(unsigned, m), false, false); return fmaxf(__builtin_bit_cast(float, rr[0]), __builtin_bit_cast(float, rr[1])); }
__device__ __forceinline__ float xhalf_sum(float m) { auto rr = __builtin_amdgcn_permlane32_swap(__builtin_bit_cast(unsigned, m), __builtin_bit_cast(unsigned, m), false, false); return __builtin_bit_cast(float, rr[0]) + __builtin_bit_cast(float, rr[1]); }

constexpr int ATT_KBUF = 64 * 208, ATT_VBUF = 64 * 320, ATT_STAGE = ATT_KBUF + ATT_VBUF;
template <int TYPE> __device__ __forceinline__ void attn_unit(Frame& F, int head, int qb) {
    constexpr int KS = TYPE == 0 ? 6 : 4, DT = TYPE == 0 ? 2 : 4, KP = TYPE == 0 ? 208 : 144, VP = TYPE == 0 ? 192 : 320;
    PHASE_IDS();
    const int r32 = lane & 31, hh = lane >> 5;
    const bf16* Z = (const bf16*)(ws + WS_Z); const bf16* QM = (const bf16*)(ws + WS_QM); const bf16* KVM = (const bf16*)(ws + WS_KVM);
    LAS unsigned char* lds = F.lds;
    const int row = qb * 256 + wave * 32 + r32;
    bf16x8 qf[KS];
    { const bf16* qp = TYPE == 0 ? QM + (size_t)row * QMC + head * 96 + 8 * hh : Z + (size_t)row * ZC + ZC_DQ + (head >> 1) * 128 + (head & 1) * 64 + 8 * hh;
#pragma unroll
      for (int ks = 0; ks < KS; ++ks) qf[ks] = *(const GAS bf16x8*)(qp + 16 * ks); }
    f32x16 o[DT];
#pragma unroll
    for (int d = 0; d < DT; ++d) o[d] = (f32x16){0.f, 0.f, 0.f, 0.f, 0.f, 0.f, 0.f, 0.f, 0.f, 0.f, 0.f, 0.f, 0.f, 0.f, 0.f, 0.f};
    float mrun = -1e30f, lrun = 0.f;
    const int NT = qb * 4 + 4, tmax = qb * 4 + (wave >> 1);
    v4u st0, st1, st2;
    const bf16 *g0, *g1, *g2; int l0, l1, l2; bool has1;
    if (TYPE == 0) {
        { const int key = tid / 12, ch = tid % 12; g0 = ch < 8 ? KVM + (size_t)key * KVC + head * 128 + 8 * ch : Z + (size_t)key * ZC + ZC_KR + 8 * (ch - 8); l0 = key * KP + ch * 16; }
        { const int cid = tid + 512, key = cid / 12, ch = cid % 12; has1 = tid < 256; const int keyc = has1 ? key : 0; g1 = ch < 8 ? KVM + (size_t)keyc * KVC + head * 128 + 8 * ch : Z + (size_t)keyc * ZC + ZC_KR + 8 * (ch - 8); l1 = keyc * KP + ch * 16; }
        { const int key = tid >> 3, ch = tid & 7; g2 = KVM + (size_t)key * KVC + head * 128 + 64 + 8 * ch; l2 = ATT_KBUF + key * VP + ch * 16; }
    } else {
        { const int key = tid >> 3, ch = tid & 7; g0 = Z + (size_t)key * ZC + ZC_DK + (head >> 1) * 128 + (head & 1) * 64 + 8 * ch; l0 = key * KP + ch * 16; }
        { const int key = tid >> 4, ch = tid & 15; g1 = Z + (size_t)key * ZC + ZC_DV + (head >> 1) * 128 + 8 * ch; l1 = ATT_KBUF + key * VP + ch * 16; has1 = true; }
        { const int cid = tid + 512, key = cid >> 4, ch = cid & 15; g2 = Z + (size_t)key * ZC + ZC_DV + (head >> 1) * 128 + 8 * ch; l2 = ATT_KBUF + key * VP + ch * 16; }
    }
    const size_t gstep0 = (size_t)64 * ((TYPE == 0 && (tid % 12) < 8) ? KVC : ZC);
    const size_t gstep1 = (size_t)64 * ((TYPE == 0 && ((tid + 512) % 12) < 8) ? KVC : ZC);
    const size_t gstep2 = (size_t)64 * (TYPE == 0 ? KVC : ZC);
#define ATT_LOAD(t) do { st0 = *(const GAS v4u*)(g0 + (size_t)(t) * gstep0); if (has1) st1 = *(const GAS v4u*)(g1 + (size_t)(t) * gstep1); st2 = *(const GAS v4u*)(g2 + (size_t)(t) * gstep2); } while (0)
#define ATT_WRITE(buf) do { LAS unsigned char* b_ = lds + (buf) * ATT_STAGE; *(LAS v4u*)(b_ + l0) = st0; if (has1) *(LAS v4u*)(b_ + l1) = st1; *(LAS v4u*)(b_ + l2) = st2; } while (0)
    const int koff = r32 * KP + hh * 16;
    const int voff = ATT_KBUF + (4 * hh + ((lane & 15) >> 2)) * VP + (16 * ((lane >> 4) & 1) + 4 * (lane & 3)) * 2;
    ATT_LOAD(0); ATT_WRITE(0); __syncthreads();
    for (int t = 0; t < NT; ++t) {
        if (t + 1 < NT) ATT_LOAD(t + 1);
        if (t <= tmax) {
            const LAS unsigned char* kb_ = lds + (t & 1) * ATT_STAGE;
            f32x16 p0 = (f32x16){0.f, 0.f, 0.f, 0.f, 0.f, 0.f, 0.f, 0.f, 0.f, 0.f, 0.f, 0.f, 0.f, 0.f, 0.f, 0.f}, p1 = p0;
#pragma unroll
            for (int ks = 0; ks < KS; ++ks) {
                const bf16x8 a0 = *(const LAS bf16x8*)(kb_ + koff + ks * 32), a1 = *(const LAS bf16x8*)(kb_ + koff + 32 * KP + ks * 32);
                p0 = __builtin_amdgcn_mfma_f32_32x32x16_bf16(a0, qf[ks], p0, 0, 0, 0);
                p1 = __builtin_amdgcn_mfma_f32_32x32x16_bf16(a1, qf[ks], p1, 0, 0, 0);
            }
            float mt = fmaxf(p0[0], p1[0]);
#pragma unroll
            for (int r = 1; r < 16; ++r) mt = fmaxf(mt, fmaxf(p0[r], p1[r]));
            mt = xhalf_max(mt);
            const float mnew = fmaxf(mrun, mt);
            if (__any(mnew > mrun)) {
                const float alpha = __builtin_amdgcn_exp2f(mrun - mnew); lrun *= alpha;
#pragma unroll
                for (int d = 0; d < DT; ++d) o[d] = o[d] * alpha;
                mrun = mnew;
            }
            float ls = 0.f;
#pragma unroll
            for (int r = 0; r < 16; ++r) { p0[r] = __builtin_amdgcn_exp2f(p0[r] - mrun); p1[r] = __builtin_amdgcn_exp2f(p1[r] - mrun); ls += p0[r] + p1[r]; }
            lrun += ls;
            bf16x8 pf[4];
#pragma unroll
            for (int s = 0; s < 2; ++s) {
                v4u w0, w1;
                w0.x = pg8::cvt_pk_bf16(p0[8 * s + 0], p0[8 * s + 1]); w0.y = pg8::cvt_pk_bf16(p0[8 * s + 2], p0[8 * s + 3]); w0.z = pg8::cvt_pk_bf16(p0[8 * s + 4], p0[8 * s + 5]); w0.w = pg8::cvt_pk_bf16(p0[8 * s + 6], p0[8 * s + 7]);
                w1.x = pg8::cvt_pk_bf16(p1[8 * s + 0], p1[8 * s + 1]); w1.y = pg8::cvt_pk_bf16(p1[8 * s + 2], p1[8 * s + 3]); w1.z = pg8::cvt_pk_bf16(p1[8 * s + 4], p1[8 * s + 5]); w1.w = pg8::cvt_pk_bf16(p1[8 * s + 6], p1[8 * s + 7]);
                pf[s] = __builtin_bit_cast(bf16x8, w0); pf[2 + s] = __builtin_bit_cast(bf16x8, w1);
            }
#pragma unroll
            for (int d = 0; d < DT; ++d)
#pragma unroll
                for (int s2 = 0; s2 < 4; ++s2) {
                    const s16x4 lo = vtr(kb_ + voff + (16 * s2) * VP + d * 64), hi = vtr(kb_ + voff + (16 * s2 + 8) * VP + d * 64);
                    const bf16x8 vf = (bf16x8){lo[0], lo[1], lo[2], lo[3], hi[0], hi[1], hi[2], hi[3]};
                    o[d] = __builtin_amdgcn_mfma_f32_32x32x16_bf16(vf, pf[s2], o[d], 0, 0, 0);
                }
        }
        if (t + 1 < NT) ATT_WRITE((t + 1) & 1);
        __syncthreads();
    }
#undef ATT_LOAD
#undef ATT_WRITE
    const float inv = 1.f / xhalf_sum(lrun);
    bf16* outp = TYPE == 0 ? (bf16*)(ws + WS_ACT) + (size_t)row * 512 + head * 64 : (bf16*)(ws + WS_DO) + (size_t)(head & 1) * SEQ * 512 + (size_t)row * 512 + (head >> 1) * 128;
#pragma unroll
    for (int d = 0; d < DT; ++d)
#pragma unroll
        for (int g = 0; g < 4; ++g) { u32x2 w; w.x = pg8::cvt_pk_bf16(o[d][4 * g] * inv, o[d][4 * g + 1] * inv); w.y = pg8::cvt_pk_bf16(o[d][4 * g + 2] * inv, o[d][4 * g + 3] * inv);
            *(GAS u32x2*)(outp + 32 * d + 8 * g + 4 * hh) = w; }
}
__device__ __forceinline__ void p4_attention(Frame& F, int layer) {
    const int tid = otid();
    gu32* head_w = F.ctl + CW_QATT + 64 * layer;
    for (;;) {
        __syncthreads();
        if (tid == 0) F.MISC[0] = __hip_atomic_fetch_add(head_w, 1u, RLX_AGENT);
        __syncthreads();
        const unsigned u = F.MISC[0];
        if (u >= 512u) break;
        const int qb = 31 - (int)(u >> 4), r = (int)(u & 15);
        if (r < 8) attn_unit<1>(F, r, qb); else attn_unit<0>(F, r - 8, qb);
    }
}

__device__ __forceinline__ void p5_diff_combine(Frame& F, int layer) {
    LayerW W; W.lam = inp(12) + (size_t)layer * 256; W.diff_g = inp(13) + (size_t)layer * 128;
    PHASE_IDS();
    const int gw = blockIdx.x * NWAVES + wave, NGW = F.G * NWAVES;
    const float lam_init = 0.8f - 0.6f * expf(-0.3f * (float)layer);
    const float d1 = wave_sum(W.lam[lane] * W.lam[64 + lane]), d2 = wave_sum(W.lam[128 + lane] * W.lam[192 + lane]);
    const float lam = expf(d1) - expf(d2) + lam_init;
    const bf16* O1 = (const bf16*)(ws + WS_DO); const bf16* O2 = O1 + (size_t)SEQ * 512;
    bf16* act = (bf16*)(ws + WS_ACT) + (size_t)2 * SEQ * 512;
    const int dcol = (lane & 15) * 8;
    const f32x4 g0 = *(const f32x4*)(W.diff_g + dcol), g1 = *(const f32x4*)(W.diff_g + dcol + 4);
    for (int tok = gw; tok < SEQ; tok += NGW) {
        const v4u a = *(const GAS v4u*)(O1 + (size_t)tok * 512 + lane * 8), b = *(const GAS v4u*)(O2 + (size_t)tok * 512 + lane * 8);
        float v[8] = {bf_lo(a.x) - lam * bf_lo(b.x), bf_hi(a.x) - lam * bf_hi(b.x), bf_lo(a.y) - lam * bf_lo(b.y), bf_hi(a.y) - lam * bf_hi(b.y),
                      bf_lo(a.z) - lam * bf_lo(b.z), bf_hi(a.z) - lam * bf_hi(b.z), bf_lo(a.w) - lam * bf_lo(b.w), bf_hi(a.w) - lam * bf_hi(b.w)};
        float s = 0.f;
#pragma unroll
        for (int i = 0; i < 8; ++i) s += v[i] * v[i];
        s = row16_sum(s);
        const float sc = (1.f / sqrtf(s * (1.f / 128.f) + NORM_EPS)) * (1.f - lam_init);
        v4u o; o.x = pk2(v[0] * sc * g0[0], v[1] * sc * g0[1]); o.y = pk2(v[2] * sc * g0[2], v[3] * sc * g0[3]); o.z = pk2(v[4] * sc * g1[0], v[5] * sc * g1[1]); o.w = pk2(v[6] * sc * g1[2], v[7] * sc * g1[3]);
        *(GAS v4u*)(act + (size_t)tok * 512 + lane * 8) = o;
    }
}

__device__ __forceinline__ void p8_ffn_norm(Frame& F, int layer) {
    LayerW W; W.ffn_g = inp(21) + (size_t)layer * 2048;
    PHASE_IDS();
    const int gw = blockIdx.x * NWAVES + wave, NGW = F.G * NWAVES;
    const float* xa = (const float*)(ws + WS_XA);
    for (int m = gw; m < SEQ; m += NGW) rms_row_to_bf16(xa + (size_t)m * DMODEL, W.ffn_g, (bf16*)(ws + WS_H2) + (size_t)m * DMODEL, lane);
}

__device__ __forceinline__ float pack_key(float v, unsigned idx, unsigned mask) { return __builtin_bit_cast(float, (__builtin_bit_cast(unsigned, v) & ~mask) | idx); }
__device__ __forceinline__ void p10_route(Frame& F, int layer) {
    LayerW W; W.subk = inp(23) + (size_t)layer * 2 * 128 * 64;
    PHASE_IDS();
    constexpr int KPITCH = 68;
    LAS float* ks = (LAS float*)F.lds;
    for (int i = tid; i < 2 * 128 * 64; i += NTHREADS) ks[(i >> 6) * KPITCH + (i & 63)] = W.subk[i];
    __syncthreads();
    const int gw = blockIdx.x * NWAVES + wave, NGW = F.G * NWAVES;
    const float* pq = (const float*)(ws + WS_PQ);
    int* idx_o = (int*)(ws + WS_IDX); float* gate_o = (float*)(ws + WS_GATE);
    const float NEG = -3.0e38f;
    for (int it = gw; it < SEQ * 8; it += NGW) {
        const int tok = it >> 3, hd = it & 7;
        const float q1 = pq[(size_t)tok * 1024 + hd * 128 + lane], q2 = pq[(size_t)tok * 1024 + hd * 128 + 64 + lane];
        float s1a = 0.f, s1b = 0.f, s2a = 0.f, s2b = 0.f;
        const LAS float* k1a = ks + lane * KPITCH; const LAS float* k1b = ks + (64 + lane) * KPITCH; const LAS float* k2a = ks + (128 + lane) * KPITCH; const LAS float* k2b = ks + (192 + lane) * KPITCH;
#pragma unroll 2
        for (int d4 = 0; d4 < 16; ++d4) {
            const f32x4 a = *(const LAS f32x4*)(k1a + 4 * d4), b = *(const LAS f32x4*)(k1b + 4 * d4), c = *(const LAS f32x4*)(k2a + 4 * d4), e = *(const LAS f32x4*)(k2b + 4 * d4);
#pragma unroll
            for (int j = 0; j < 4; ++j) { const float x1 = rl(q1, 4 * d4 + j), x2 = rl(q2, 4 * d4 + j); s1a += x1 * a[j]; s1b += x1 * b[j]; s2a += x2 * c[j]; s2b += x2 * e[j]; }
        }
        float t1 = NEG, t2 = NEG;
        { float a = pack_key(s1a, (unsigned)lane, 127u), b = pack_key(s1b, (unsigned)(64 + lane), 127u);
          for (int k = 0; k < 16; ++k) { const float m = wave_max(fmaxf(a, b)); if (lane == k) t1 = m; a = (a == m) ? NEG : a; b = (b == m) ? NEG : b; } }
        { float a = pack_key(s2a, (unsigned)lane, 127u), b = pack_key(s2b, (unsigned)(64 + lane), 127u);
          for (int k = 0; k < 16; ++k) { const float m = wave_max(fmaxf(a, b)); if (lane == k) t2 = m; a = (a == m) ? NEG : a; b = (b == m) ? NEG : b; } }
        const float t1i = __shfl(t1, lane >> 2);
        const float v1 = __builtin_bit_cast(float, __builtin_bit_cast(unsigned, t1i) & ~127u);
        float c[4];
#pragma unroll
        for (int jj = 0; jj < 4; ++jj) { const float t2j = __shfl(t2, 4 * (lane & 3) + jj); const float v2 = __builtin_bit_cast(float, __builtin_bit_cast(unsigned, t2j) & ~127u);
            c[jj] = pack_key(v1 + v2, (unsigned)((lane >> 2) * 16 + 4 * (lane & 3) + jj), 255u); }
        float best = NEG;
        for (int k = 0; k < 16; ++k) { const float m = wave_max(fmaxf(fmaxf(c[0], c[1]), fmaxf(c[2], c[3]))); if (lane == k) best = m;
#pragma unroll
            for (int jj = 0; jj < 4; ++jj) c[jj] = (c[jj] == m) ? NEG : c[jj]; }
        const unsigned bb = __builtin_bit_cast(unsigned, best), ci = bb & 255u;
        const float bv = __builtin_bit_cast(float, bb & ~255u);
        const unsigned e1 = __builtin_bit_cast(unsigned, __shfl(t1, (int)(ci >> 4) & 15)) & 127u, e2 = __builtin_bit_cast(unsigned, __shfl(t2, (int)(ci & 15))) & 127u;
        const float bmax = rl(bv, 0);
        float ex = lane < 16 ? __expf(bv - bmax) : 0.f;
        const float den = row16_sum(ex);
        if (lane < 16) { idx_o[(size_t)tok * 128 + hd * 16 + lane] = (int)(e1 * 128u + e2); gate_o[(size_t)tok * 128 + hd * 16 + lane] = ex / den; }
    }
    __syncthreads();
}

__device__ __forceinline__ void p11_peer(Frame& F, int layer, float* d_out) {
    const bool last = layer == NLAYER - 1; const float* next_g = last ? inp(26) : inp(2) + (size_t)(layer + 1) * 2048;
    PHASE_IDS();
    const int gw = blockIdx.x * NWAVES + wave, NGW = F.G * NWAVES;
    const bf16* H2 = (const bf16*)(ws + WS_H2); const bf16* U = (const bf16*)(ws + WS_UBF); const bf16* V = (const bf16*)(ws + WS_VBF);
    float* xa = (float*)(ws + WS_XA); const int* idx = (const int*)(ws + WS_IDX); const float* gate = (const float*)(ws + WS_GATE);
    for (int tok = gw; tok < SEQ; tok += NGW) {
        v4u h[4];
#pragma unroll
        for (int j = 0; j < 4; ++j) h[j] = *(const GAS v4u*)(H2 + (size_t)tok * DMODEL + 512 * j + 8 * lane);
        float acc[32];
#pragma unroll
        for (int i = 0; i < 32; ++i) acc[i] = 0.f;
        const int id_a = idx[(size_t)tok * 128 + lane], id_b = idx[(size_t)tok * 128 + 64 + lane];
        const float g_a = gate[(size_t)tok * 128 + lane], g_b = gate[(size_t)tok * 128 + 64 + lane];
#pragma unroll 2
        for (int e = 0; e < 128; ++e) {
            const int id = e < 64 ? __builtin_amdgcn_readlane(id_a, e & 63) : __builtin_amdgcn_readlane(id_b, e & 63);
            const float ge = e < 64 ? rl(g_a, e & 63) : rl(g_b, e & 63);
            const bf16* up = U + (size_t)id * DMODEL + 8 * lane; const bf16* vp = V + (size_t)id * DMODEL + 8 * lane;
            v4u uu[4], vv[4];
#pragma unroll
            for (int j = 0; j < 4; ++j) { uu[j] = *(const GAS v4u*)(up + 512 * j); vv[j] = *(const GAS v4u*)(vp + 512 * j); }
            float d0 = 0.f, d1 = 0.f, d2 = 0.f, d3 = 0.f;
#pragma unroll
            for (int j = 0; j < 4; ++j) { d0 = dot2_bf16(uu[j].x, h[j].x, d0); d1 = dot2_bf16(uu[j].y, h[j].y, d1); d2 = dot2_bf16(uu[j].z, h[j].z, d2); d3 = dot2_bf16(uu[j].w, h[j].w, d3); }
            const float a = wave_sum((d0 + d1) + (d2 + d3));
            const float w = 0.5f * a * (1.f + erff(a * 0.70710678118654752f)) * ge;
#pragma unroll
            for (int j = 0; j < 4; ++j) { acc[8 * j + 0] += w * bf_lo(vv[j].x); acc[8 * j + 1] += w * bf_hi(vv[j].x); acc[8 * j + 2] += w * bf_lo(vv[j].y); acc[8 * j + 3] += w * bf_hi(vv[j].y);
                acc[8 * j + 4] += w * bf_lo(vv[j].z); acc[8 * j + 5] += w * bf_hi(vv[j].z); acc[8 * j + 6] += w * bf_lo(vv[j].w); acc[8 * j + 7] += w * bf_hi(vv[j].w); }
        }
        float ss = 0.f;
#pragma unroll
        for (int j = 0; j < 4; ++j) { GAS f32x4* xp = (GAS f32x4*)(xa + (size_t)tok * DMODEL + 512 * j + 8 * lane);
            const f32x4 x0 = xp[0], x1 = xp[1];
#pragma unroll
            for (int i = 0; i < 4; ++i) { acc[8 * j + i] += x0[i]; acc[8 * j + 4 + i] += x1[i]; }
            if (!last) { xp[0] = (f32x4){acc[8 * j], acc[8 * j + 1], acc[8 * j + 2], acc[8 * j + 3]}; xp[1] = (f32x4){acc[8 * j + 4], acc[8 * j + 5], acc[8 * j + 6], acc[8 * j + 7]}; }
#pragma unroll
            for (int i = 0; i < 8; ++i) ss += acc[8 * j + i] * acc[8 * j + i]; }
        const float rstd = 1.f / sqrtf(wave_sum(ss) * (1.f / DMODEL) + NORM_EPS);
#pragma unroll
        for (int j = 0; j < 4; ++j) { const f32x4 ga = *(const f32x4*)(next_g + 512 * j + 8 * lane), gb = *(const f32x4*)(next_g + 512 * j + 8 * lane + 4);
            if (last) { GAS f32x4* op = (GAS f32x4*)(d_out + (size_t)tok * DMODEL + 512 * j + 8 * lane);
                op[0] = (f32x4){acc[8 * j] * rstd * ga[0], acc[8 * j + 1] * rstd * ga[1], acc[8 * j + 2] * rstd * ga[2], acc[8 * j + 3] * rstd * ga[3]};
                op[1] = (f32x4){acc[8 * j + 4] * rstd * gb[0], acc[8 * j + 5] * rstd * gb[1], acc[8 * j + 6] * rstd * gb[2], acc[8 * j + 7] * rstd * gb[3]}; }
            else { v4u o; o.x = pk2(acc[8 * j] * rstd * ga[0], acc[8 * j + 1] * rstd * ga[1]); o.y = pk2(acc[8 * j + 2] * rstd * ga[2], acc[8 * j + 3] * rstd * ga[3]);
                o.z = pk2(acc[8 * j + 4] * rstd * gb[0], acc[8 * j + 5] * rstd * gb[1]); o.w = pk2(acc[8 * j + 6] * rstd * gb[2], acc[8 * j + 7] * rstd * gb[3]);
                *(GAS v4u*)((bf16*)(ws + WS_H) + (size_t)tok * DMODEL + 512 * j + 8 * lane) = o; } }
    }
}

#ifndef MK_ONE_LAUNCH
#define MK_ONE_LAUNCH 0
#endif
constexpr int PH_PER_LAYER = 12, N_PHASES = PH_PER_LAYER * NLAYER;
struct Args { const float* in[27]; float* out; unsigned char* ws; int ph_lo, ph_hi; };
static_assert(sizeof(Args) == 29 * 8 + 8, "Args has no padding");

__global__ void __launch_bounds__(NTHREADS, 2) mk_fwd(Args args) {
    extern __shared__ __attribute__((aligned(16))) unsigned char lds_raw[];
    Frame F;
    F.lds = (LAS unsigned char*)lds_raw;
    F.MISC = (volatile LAS unsigned*)(F.lds + MISC_OFF);
    F.G = gridDim.x;
    F.ws_base = args.ws; F.ctl = (gu32*)(args.ws + WS_CTL);
    for (int u = threadIdx.x; u < (LDS_BYTES - LDSCTL_OFF) / 4; u += NTHREADS) ((LAS unsigned*)(F.lds + LDSCTL_OFF))[u] = 0u;
    __syncthreads();
    XcdBarrier bar; bar.bar = (unsigned*)(F.ctl + CW_BAR); bar.x = 0; bar.st = nullptr;
    if (MK_ONE_LAUNCH) bar = xcd_barrier_post((unsigned*)(F.ctl + CW_BAR), F.MISC + 8);
    const int lo = args.ph_lo, hi = args.ph_hi;
#define IN(k) (lo <= (k) && (k) < hi)
#define SEAM(k) do { if (MK_ONE_LAUNCH && IN(k) && IN((k) + 1)) xcd_barrier(bar); } while (0)
    for (int layer = 0; layer < NLAYER; ++layer) {
        const int pb = layer * PH_PER_LAYER;
        if (IN(pb + 0)) { p0_prologue(F, layer); } SEAM(pb + 0);
        if (IN(pb + 1)) { unsigned char* const ws = ows(F.ws_base);
            pg8::Gemm g{(const bf16*)(ws + WS_H), (const bf16*)(ws + WS_WIN), SEQ, ZC, 2048, 2048, 2048}; pg8::StaticOrder S; S.init(SEQ, ZC, F.G, (int)blockIdx.x);
            pg8::EpiZ E{(bf16*)(ws + WS_Z), (const float*)(ws + WS_COSM), (const float*)(ws + WS_SINM), (const float*)(ws + WS_COSD), (const float*)(ws + WS_SIND)};
            pg8::gemm_phase<pg8::EpiZ, pg8::StaticOrder, true, true>(F.lds, g, S, E);
        } SEAM(pb + 1);
        if (IN(pb + 2)) { p2_branch_prep(F, layer); } SEAM(pb + 2);
        if (IN(pb + 3)) { unsigned char* const ws = ows(F.ws_base);
            pg8::Gemm g{(const bf16*)(ws + WS_Z), (const bf16*)(ws + WS_WUQ), SEQ, QMC + KVC, 512, ZC, 512}; pg8::QKVOrder S; S.S0.init(SEQ, QMC + KVC, F.G, (int)blockIdx.x);
            pg8::EpiQKV E{(bf16*)(ws + WS_QM), (bf16*)(ws + WS_KVM), (const float*)(ws + WS_RSTD), (const float*)(ws + WS_COSM), (const float*)(ws + WS_SINM)};
            pg8::gemm_phase<pg8::EpiQKV, pg8::QKVOrder, false, true>(F.lds, g, S, E);
        } SEAM(pb + 3);
        if (IN(pb + 4)) { p4_attention(F, layer); } SEAM(pb + 4);
        if (IN(pb + 5)) { p5_diff_combine(F, layer); } SEAM(pb + 5);
        if (IN(pb + 6)) { unsigned char* const ws = ows(F.ws_base);
            pg8::Gemm g{(const bf16*)(ws + WS_ACT), (const bf16*)(ws + WS_WOUT), 4 * SEQ, 4 * 2048, 512, 512, 512};
            pg8::MergedOrder S; S.S0.init(SEQ, 2048, F.G, (int)blockIdx.x);
            pg8::EpiMerged E{(bf16*)(ws + WS_MERGED), (const bf16*)(ws + WS_Z), inp(4) + (size_t)layer * 4 * 2048};
            pg8::gemm_phase<pg8::EpiMerged, pg8::MergedOrder, true, true>(F.lds, g, S, E);
        } SEAM(pb + 6);
        if (IN(pb + 7)) { unsigned char* const ws = ows(F.ws_base);
            pg8::Gemm g{(const bf16*)(ws + WS_MERGED), (const bf16*)(ws + WS_WO), SEQ, 2048, 2048, 2048, 2048}; pg8::StaticOrder S; S.init(SEQ, 2048, F.G, (int)blockIdx.x);
            pg8::EpiResF32 E{layer == 0 ? inp(0) : (const float*)(ws + WS_XA), (float*)(ws + WS_XA), 2048};
            pg8::gemm_phase<pg8::EpiResF32, pg8::StaticOrder, false, true>(F.lds, g, S, E);
        } SEAM(pb + 7);
        if (IN(pb + 8)) { p8_ffn_norm(F, layer); } SEAM(pb + 8);
        if (IN(pb + 9)) { unsigned char* const ws = ows(F.ws_base);
            pg8::Gemm g{(const bf16*)(ws + WS_H2), (const bf16*)(ws + WS_WQ), SEQ, 1024, 2048, 2048, 2048}; pg8::StaticOrder S; S.init(SEQ, 1024, F.G, (int)blockIdx.x);
            pg8::EpiResF32 E{nullptr, (float*)(ws + WS_PQ), 1024};
            pg8::gemm_phase<pg8::EpiResF32, pg8::StaticOrder, false, true>(F.lds, g, S, E);
        } SEAM(pb + 9);
        if (IN(pb + 10)) { p10_route(F, layer); } SEAM(pb + 10);
        if (IN(pb + 11)) { p11_peer(F, layer, args.out); }
        if (layer + 1 < NLAYER) SEAM(pb + 11);
    }
#undef IN
#undef SEAM
}

extern "C" void kernel_launch(void* const* d_in, const int* in_sizes, int n_in, void* d_out, int out_size, void* d_ws, size_t ws_size, hipStream_t stream) {
    static int grid = 0;
    if (grid == 0) {
        if (n_in != 27 || out_size != SEQ * DMODEL || ws_size < WS_END) { fprintf(stderr, "kernel_launch: unexpected problem (n_in %d, out %d, ws %zu); nothing launched\n", n_in, out_size, ws_size); grid = -1; return; }
        int dev = 0, cus = 0, per_cu = 0;
        if (hipGetDevice(&dev) != hipSuccess || hipDeviceGetAttribute(&cus, hipDeviceAttributeMultiprocessorCount, dev) != hipSuccess) { grid = -1; return; }
        if (hipFuncSetAttribute((const void*)mk_fwd, hipFuncAttributeMaxDynamicSharedMemorySize, LDS_BYTES) != hipSuccess) { fprintf(stderr, "kernel_launch: hipFuncSetAttribute failed\n"); grid = -1; return; }
        if (hipOccupancyMaxActiveBlocksPerMultiprocessor(&per_cu, (const void*)mk_fwd, NTHREADS, LDS_BYTES) != hipSuccess || per_cu < 1) { fprintf(stderr, "kernel_launch: occupancy query says %d\n", per_cu); per_cu = 1; }
        (void)hipGetLastError();
        grid = cus;
    }
    if (grid < 0) return;
    (void)in_sizes;
    if (hipMemsetAsync((char*)d_ws + WS_CTL, 0, CTL_ZERO_BYTES, stream) != hipSuccess) return;
    Args a{};
    for (int i = 0; i < 27; ++i) a.in[i] = (const float*)d_in[i];
    a.out = (float*)d_out; a.ws = (unsigned char*)d_ws;
#if MK_ONE_LAUNCH
    a.ph_lo = 0; a.ph_hi = N_PHASES;
    hipLaunchKernelGGL(mk_fwd, dim3(grid), dim3(NTHREADS), LDS_BYTES, stream, a);
#else
    for (int p = 0; p < N_PHASES; ++p) { a.ph_lo = p; a.ph_hi = p + 1; hipLaunchKernelGGL(mk_fwd, dim3(grid), dim3(NTHREADS), LDS_BYTES, stream, a); }
#endif
}
```

```cpp
#include <hip/hip_runtime.h>
#include <cstdio>
#include <cstdint>
__device__ __forceinline__ int otid(int wv) { int t = wv * 64 + (int)__builtin_amdgcn_mbcnt_hi(~0u, __builtin_amdgcn_mbcnt_lo(~0u, 0u)); asm volatile("" : "+v"(t)); return t; }
__device__ __forceinline__ int obid() { int b = (int)blockIdx.x; asm volatile("" : "+s"(b)); return b; }
__device__ __forceinline__ unsigned char* ows(unsigned char* p) { __attribute__((address_space(1))) unsigned char* g = (__attribute__((address_space(1))) unsigned char*)p; asm volatile("" : "+s"(g)); return (unsigned char*)g; }
namespace pg8 {
#define PG8_LAS __attribute__((address_space(3)))
typedef unsigned short bf16_t;
typedef short bf16x8 __attribute__((ext_vector_type(8)));
typedef float f32x4 __attribute__((ext_vector_type(4)));
typedef unsigned u32x4 __attribute__((ext_vector_type(4)));
constexpr int BM = 256, BK = 64, HALF = 128, HTB = HALF * BK * 2  , STAGE_BYTES = 8 * HTB, NXCD = 8, WGM = 8;

__host__ __device__ __forceinline__ int lds_byte(int r, int c) { const int st = (r >> 4) * 2 + (c >> 5), rr = r & 15, cc = c & 31, ob = rr * 64 + cc * 2; return st * 1024 + (ob ^ (((ob >> 9) & 1) << 5)); }
__host__ __device__ __forceinline__ void stage_rc(int b, int& R, int& C) { const int st = b / 1024, sb = b % 1024, swz = sb ^ (((sb >> 9) & 1) << 5); R = (st >> 1) * 16 + swz / 64; C = (st & 1) * 32 + (swz % 64) / 2; }
__host__ __device__ __forceinline__ int perm32(int rho) { const int n = rho >> 4, i = rho & 15; return 8 * (i >> 2) + 4 * n + (i & 3); }

struct Unit { int pm, pn, ka; };
struct Gemm { const bf16_t* A; const bf16_t* Bt; int M, N, K, lda, ldb; };

struct StaticOrder {
    int nM, nN, nwg, G, c;
    __host__ __device__ void init(int M, int N, int G_, int c_) { nM = M / BM; nN = N / BM; nwg = nM * nN; G = G_; c = c_; }
    __host__ __device__ bool next(int i, Unit& u) const {
        const long L = (long)i * G + c; if (L >= nwg) return false;
        int wgid = (int)L; { const int q = nwg / NXCD, r = nwg % NXCD, xcd = wgid % NXCD, off = wgid / NXCD; wgid = (xcd < r ? xcd * (q + 1) : r * (q + 1) + (xcd - r) * q) + off; }
        const int nig = WGM * nN, gid = wgid / nig, fm = gid * WGM, gsz = (nM - fm) < WGM ? (nM - fm) : WGM;
        u.pm = fm + ((wgid % nig) % gsz); u.pn = (wgid % nig) / gsz; u.ka = 0; return true;
    }
    __device__ __forceinline__ void a_ready(const Unit&) const {}
    __device__ __forceinline__ void done(const Unit&) const {}
};

__device__ __forceinline__ unsigned cvt_pk_bf16(float lo, float hi) { unsigned r; asm volatile("v_cvt_pk_bf16_f32 %0, %1, %2" : "=v"(r) : "v"(lo), "v"(hi)); return r; }
typedef float f32x2 __attribute__((ext_vector_type(2)));

typedef int pg8_v4i __attribute__((ext_vector_type(4)));
template <class Epi, class Sched, bool ALIGN_EPI = false, bool SP2 = false, bool I8 = false>
__device__ __forceinline__ void gemm_phase(PG8_LAS unsigned char* lds, const Gemm g, const Sched& S, const Epi& E, int wv) {
    const int tid = otid(wv), wid = __builtin_amdgcn_readfirstlane(tid >> 6), lane = tid & 63, wr = wid >> 2, wc = wid & 3, fr = lane & 15, fq = lane >> 4;
    const int K = g.K, nt = K / BK;
    unsigned voffA[2], voffB[2];
#pragma unroll
    for (int i = 0; i < 2; ++i) { int R, C; stage_rc(tid * 16 + i * 8192, R, C); const int Rb = Epi::PERM ? ((R & ~31) + perm32(R & 31)) : R;
        voffA[i] = (unsigned)(R * g.lda + C) * 2u; voffB[i] = (unsigned)(Rb * g.ldb + C) * 2u; }
    const size_t kstep = (size_t)(BK * 2);
    const size_t hstepA = (size_t)HALF * g.lda * 2, hstepB = (size_t)HALF * g.ldb * 2;
    const size_t tstepA = 2 * hstepA, tstepB = 2 * hstepB;
    const unsigned ldsw = (unsigned)wid * 1024u;
    const int aoff = lds_byte(wr * 64 + fr, fq * 8), boff = lds_byte(wc * 32 + fr, fq * 8);
#define PG8_SA(b, h) (((b) * 2 + (h)) * HTB)
#define PG8_SB(b, h) ((4 + (b) * 2 + (h)) * HTB)
#define PG8_STAGE(bufoff, gbase, voff) do { _Pragma("unroll") for (int _i = 0; _i < 2; ++_i) \
        __builtin_amdgcn_global_load_lds((const unsigned*)((const char*)(gbase) + (voff)[_i]), (PG8_LAS unsigned*)(lds + (bufoff) + ldsw + _i * 8192), 16, 0, 0); } while (0)
#define PG8_LDA(dst, b, h) do { _Pragma("unroll") for (int m = 0; m < 4; ++m) _Pragma("unroll") for (int k = 0; k < 2; ++k) dst[m][k] = *(const PG8_LAS bf16x8*)(lds + PG8_SA(b, h) + aoff + m * 2048 + k * 1024); } while (0)
#define PG8_LDB(dst, b, h) do { _Pragma("unroll") for (int n = 0; n < 2; ++n) _Pragma("unroll") for (int k = 0; k < 2; ++k) dst[n][k] = *(const PG8_LAS bf16x8*)(lds + PG8_SB(b, h) + boff + n * 2048 + k * 1024); } while (0)
#define PG8_MMA(ai, bj, At, Bt) do { __builtin_amdgcn_s_setprio(1); _Pragma("unroll") for (int m = 0; m < 4; ++m) _Pragma("unroll") for (int n = 0; n < 2; ++n) _Pragma("unroll") for (int k = 0; k < 2; ++k) { \
        if constexpr (I8) acc[ai][bj][m][n] = __builtin_bit_cast(f32x4, __builtin_amdgcn_mfma_i32_16x16x64_i8(__builtin_bit_cast(pg8_v4i, Bt[n][k]), __builtin_bit_cast(pg8_v4i, At[m][k]), __builtin_bit_cast(pg8_v4i, acc[ai][bj][m][n]), 0, 0, 0)); \
        else acc[ai][bj][m][n] = __builtin_amdgcn_mfma_f32_16x16x32_bf16(Bt[n][k], At[m][k], acc[ai][bj][m][n], 0, 0, 0); } __builtin_amdgcn_s_setprio(0); } while (0)
#define PG8_WAIT_V(n) asm volatile("s_waitcnt vmcnt(" #n ")" ::: "memory")
#define PG8_WAIT_L(n) asm volatile("s_waitcnt lgkmcnt(" #n ")" ::: "memory")
#define PG8_BAR __builtin_amdgcn_s_barrier()
#define PG8_SCHED __builtin_amdgcn_sched_barrier(0)
    Unit cur, nxt; int ui = 0;
    if (!S.next(0, cur)) return;
    f32x4 acc[2][2][4][2];
#pragma unroll
    for (int a = 0; a < 2; ++a)
#pragma unroll
        for (int b = 0; b < 2; ++b)
#pragma unroll
            for (int m = 0; m < 4; ++m)
#pragma unroll
                for (int n = 0; n < 2; ++n) acc[a][b][m][n] = (f32x4){0.f, 0.f, 0.f, 0.f};
    bf16x8 At[4][2], B0[2][2], B1[2][2];
    const char* cA = (const char*)g.A + (size_t)cur.pm * tstepA + (size_t)cur.ka * 2; const char* cB = (const char*)g.Bt + (size_t)cur.pn * tstepB;
    S.a_ready(cur);
    if constexpr (SP2) {
        PG8_STAGE(PG8_SB(0, 0), cB, voffB); PG8_STAGE(PG8_SB(0, 1), cB + hstepB, voffB); PG8_STAGE(PG8_SA(0, 0), cA, voffA); PG8_STAGE(PG8_SA(0, 1), cA + hstepA, voffA);
        if (wr == 1) PG8_BAR;
        PG8_WAIT_V(2); PG8_BAR;
        PG8_STAGE(PG8_SB(1, 0), cB + kstep, voffB); PG8_STAGE(PG8_SA(1, 0), cA + kstep, voffA); PG8_STAGE(PG8_SB(1, 1), cB + hstepB + kstep, voffB);
        PG8_WAIT_V(6); PG8_BAR;
    } else {
        PG8_STAGE(PG8_SB(0, 0), cB, voffB); PG8_STAGE(PG8_SA(0, 0), cA, voffA); PG8_STAGE(PG8_SB(0, 1), cB + hstepB, voffB); PG8_STAGE(PG8_SA(0, 1), cA + hstepA, voffA);
        if (wr == 1) PG8_BAR;
        PG8_WAIT_V(4); PG8_BAR;
        PG8_STAGE(PG8_SB(1, 0), cB + kstep, voffB); PG8_STAGE(PG8_SA(1, 0), cA + kstep, voffA); PG8_STAGE(PG8_SB(1, 1), cB + hstepB + kstep, voffB);
        PG8_WAIT_V(6); PG8_BAR;
    }
    for (;;) {
        const bool has_next = S.next(ui + 1, nxt);
        const char* nA = has_next ? (const char*)g.A + (size_t)nxt.pm * tstepA + (size_t)nxt.ka * 2 : cA; const char* nB = has_next ? (const char*)g.Bt + (size_t)nxt.pn * tstepB : cB;
        for (int t = 0; t < nt; t += 2) {
            const bool last = (t == nt - 2);
            const char* a1 = cA + (size_t)(t + 1) * kstep;
            const char* a2 = last ? nA : cA + (size_t)(t + 2) * kstep; const char* b2 = last ? nB : cB + (size_t)(t + 2) * kstep;
            const char* a3 = a2 + kstep; const char* b3 = b2 + kstep;
            if (last && has_next) S.a_ready(nxt);
            if constexpr (SP2) {
            PG8_LDB(B0, 0, 0); PG8_LDB(B1, 0, 1); PG8_SCHED; PG8_LDA(At, 0, 0); PG8_STAGE(PG8_SA(1, 1), a1 + hstepA, voffA);
            PG8_WAIT_V(8); PG8_WAIT_L(0); PG8_BAR; PG8_MMA(0, 0, At, B0); PG8_MMA(0, 1, At, B1); PG8_BAR; PG8_SCHED;
            PG8_LDA(At, 0, 1); PG8_STAGE(PG8_SB(0, 0), b2, voffB); PG8_STAGE(PG8_SB(0, 1), b2 + hstepB, voffB); PG8_STAGE(PG8_SA(0, 0), a2, voffA);
            PG8_WAIT_V(8); PG8_WAIT_L(0); PG8_BAR; PG8_MMA(1, 0, At, B0); PG8_MMA(1, 1, At, B1); PG8_BAR; PG8_SCHED;
            PG8_LDB(B0, 1, 0); PG8_LDB(B1, 1, 1); PG8_SCHED; PG8_LDA(At, 1, 0); PG8_STAGE(PG8_SA(0, 1), a2 + hstepA, voffA);
            PG8_WAIT_V(8); PG8_WAIT_L(0); PG8_BAR; PG8_MMA(0, 0, At, B0); PG8_MMA(0, 1, At, B1); PG8_BAR; PG8_SCHED;
            PG8_LDA(At, 1, 1); PG8_STAGE(PG8_SB(1, 0), b3, voffB); PG8_STAGE(PG8_SB(1, 1), b3 + hstepB, voffB); PG8_STAGE(PG8_SA(1, 0), a3, voffA);
            PG8_WAIT_V(8); PG8_WAIT_L(0); PG8_BAR; PG8_MMA(1, 0, At, B0); PG8_MMA(1, 1, At, B1); PG8_BAR; PG8_SCHED;
            } else {
            PG8_LDB(B0, 0, 0); PG8_SCHED; PG8_LDA(At, 0, 0); PG8_STAGE(PG8_SA(1, 1), a1 + hstepA, voffA);
            PG8_WAIT_L(8); PG8_BAR; PG8_WAIT_L(0); PG8_MMA(0, 0, At, B0); PG8_BAR; PG8_SCHED;
            PG8_LDB(B1, 0, 1); PG8_STAGE(PG8_SB(0, 0), b2, voffB);
            PG8_BAR; PG8_WAIT_L(0); PG8_MMA(0, 1, At, B1); PG8_BAR;
            PG8_LDA(At, 0, 1); PG8_STAGE(PG8_SA(0, 0), a2, voffA);
            PG8_BAR; PG8_WAIT_L(0); PG8_MMA(1, 0, At, B0); PG8_BAR; PG8_SCHED;
            PG8_STAGE(PG8_SB(0, 1), b2 + hstepB, voffB);
            PG8_WAIT_V(6); PG8_BAR; PG8_MMA(1, 1, At, B1); PG8_BAR;
            PG8_LDB(B0, 1, 0); PG8_SCHED; PG8_LDA(At, 1, 0); PG8_STAGE(PG8_SA(0, 1), a2 + hstepA, voffA);
            PG8_WAIT_L(8); PG8_BAR; PG8_WAIT_L(0); PG8_MMA(0, 0, At, B0); PG8_BAR; PG8_SCHED;
            PG8_LDB(B1, 1, 1); PG8_STAGE(PG8_SB(1, 0), b3, voffB);
            PG8_BAR; PG8_WAIT_L(0); PG8_MMA(0, 1, At, B1); PG8_BAR;
            PG8_LDA(At, 1, 1); PG8_STAGE(PG8_SA(1, 0), a3, voffA);
            PG8_BAR; PG8_WAIT_L(0); PG8_MMA(1, 0, At, B0); PG8_BAR; PG8_SCHED;
            PG8_STAGE(PG8_SB(1, 1), b3 + hstepB, voffB);
            PG8_WAIT_V(6); PG8_BAR; PG8_MMA(1, 1, At, B1); PG8_BAR;
            }
        }
        if constexpr (ALIGN_EPI) { if (wr == 0) PG8_BAR; }
        if constexpr (!Epi::AFTER_DRAIN) { E(acc, cur, wr, wc, fr, fq); S.done(cur); }
        if (!has_next) break;
#pragma unroll
        for (int a = 0; a < 2; ++a)
#pragma unroll
            for (int b = 0; b < 2; ++b)
#pragma unroll
                for (int m = 0; m < 4; ++m)
#pragma unroll
                    for (int n = 0; n < 2; ++n) acc[a][b][m][n] = (f32x4){0.f, 0.f, 0.f, 0.f};
        cur = nxt; cA = nA; cB = nB; ++ui;
        if constexpr (ALIGN_EPI) { if (wr == 1) PG8_BAR; }
    }
    PG8_WAIT_V(0);
    if constexpr (!ALIGN_EPI) { if (wr == 0) PG8_BAR; }
    PG8_BAR;
    if constexpr (Epi::AFTER_DRAIN) { E.fused(acc, cur, wr, wc, fr, fq, lds, wid, lane); S.done(cur); }
#undef PG8_SA
#undef PG8_SB
#undef PG8_STAGE
#undef PG8_LDA
#undef PG8_LDB
#undef PG8_MMA
#undef PG8_WAIT_V
#undef PG8_WAIT_L
#undef PG8_BAR
#undef PG8_SCHED
}
}

#define GAS __attribute__((address_space(1)))
#define LAS __attribute__((address_space(3)))
typedef unsigned short bf16;
typedef unsigned v4u __attribute__((ext_vector_type(4)));
typedef float f32x4 __attribute__((ext_vector_type(4)));
typedef short bf16x8 __attribute__((ext_vector_type(8)));
typedef GAS unsigned gu32;
typedef GAS unsigned long long gu64;
#define RLX_AGENT __ATOMIC_RELAXED, __HIP_MEMORY_SCOPE_AGENT
#define LDS_WAIT() asm volatile("s_waitcnt lgkmcnt(0)" ::: "memory")
#define VM_WAIT() asm volatile("s_waitcnt vmcnt(0)" ::: "memory")
__device__ __forceinline__ unsigned long long rt() { return __builtin_amdgcn_s_memrealtime(); }
__device__ __forceinline__ unsigned f2bf(float f) { unsigned u = __builtin_bit_cast(unsigned, f); return (u + 0x7fffu + ((u >> 16) & 1u)) >> 16; }
__device__ __forceinline__ unsigned pk2(float lo, float hi) { return f2bf(lo) | (f2bf(hi) << 16); }

#define XB_TMO      128
#define XB_XCNT(j)  (256  + 64 * (j))
#define XB_XSUB(j)  (1280 + 64 * (j))
#define XB_XGEN(j)  (2304 + 64 * (j))
#define XB_TOP      3328
#define XB_TOPGEN   3392
#define XCD_BAR_WORDS 3456
#define XB_SPIN_CAP (1u << 18)

__device__ __forceinline__ unsigned xb_ld(unsigned* p)              { return __hip_atomic_load(p, __ATOMIC_RELAXED, __HIP_MEMORY_SCOPE_AGENT); }
__device__ __forceinline__ unsigned xb_add(unsigned* p, unsigned v) { return __hip_atomic_fetch_add(p, v, __ATOMIC_RELAXED, __HIP_MEMORY_SCOPE_AGENT); }
__device__ __forceinline__ unsigned xb_xcc_id() { return (unsigned)__builtin_amdgcn_s_getreg((3 << 11) | 20) & 0xFu; }
#define XB_SPIN(cond, bar) do { unsigned _sp = 0; while (cond) { __builtin_amdgcn_s_sleep(1); \
    if ((++_sp & 255u) == 0u) { if (xb_ld(&(bar)[XB_TMO])) break; if (_sp > XB_SPIN_CAP) { atomicAdd(&(bar)[XB_TMO], 1u); break; } } } } while (0)

struct XcdBarrier {
    unsigned* bar; unsigned x;
    int wv;
    volatile LAS unsigned* st;
};

__device__ __forceinline__ XcdBarrier xcd_barrier_post(unsigned* bar, volatile LAS unsigned* st, int wv) {
    XcdBarrier b; b.bar = bar; b.x = xb_xcc_id(); b.st = st; b.wv = wv;
    if (otid(wv) == 0) (void)xb_add(&bar[XB_XCNT(b.x)], 1u);
    return b;
}
__device__ __forceinline__ void xcd_barrier_complete(unsigned* bar, unsigned x, unsigned& nloc, unsigned& nx) {
    const unsigned G = gridDim.x * gridDim.y * gridDim.z;
    unsigned sum, cnt, mine, sp = 0u;
    for (;;) {
        sum = 0u; cnt = 0u; mine = 0u;
#pragma unroll
        for (unsigned j = 0; j < 16; ++j) { const unsigned c = xb_ld(&bar[XB_XCNT(j)]); sum += c; cnt += (c > 0u) ? 1u : 0u; mine = (j == x) ? c : mine; }
        if (sum == G) break;
        __builtin_amdgcn_s_sleep(1);
        if ((++sp & 255u) == 0u) { if (xb_ld(&bar[XB_TMO])) break; if (sp > XB_SPIN_CAP) { atomicAdd(&bar[XB_TMO], 1u); break; } }
    }
    nloc = mine > 0u ? mine : 1u; nx = cnt > 0u ? cnt : 1u;
}

__device__ __forceinline__ void xcd_barrier(const XcdBarrier& b) {
    asm volatile("s_waitcnt vmcnt(0)" ::: "memory");
    __syncthreads();
    if (otid(b.wv) == 0) {
        unsigned* bar = b.bar; asm volatile("" : "+s"(bar)); unsigned bx_ = b.x; asm volatile("" : "+s"(bx_));
        __builtin_amdgcn_s_waitcnt(0);
        unsigned nloc = b.st[0], nx = b.st[1];
        if (nloc == 0u) { xcd_barrier_complete(bar, bx_, nloc, nx); b.st[0] = nloc; b.st[1] = nx; }
        const unsigned old = xb_add(&bar[XB_XSUB(bx_)], 1u);
        const unsigned gen = old / nloc;
        if (old + 1u == (gen + 1u) * nloc) {
            __builtin_amdgcn_fence(__ATOMIC_RELEASE, "agent");
            asm volatile("s_waitcnt vmcnt(0)" ::: "memory");
            const unsigned og = xb_add(&bar[XB_TOP], 1u);
            const unsigned tg = og / nx;
            if (og + 1u == (tg + 1u) * nx) xb_add(&bar[XB_TOPGEN], 1u);
            else XB_SPIN(xb_ld(&bar[XB_TOPGEN]) == tg, bar);
            __builtin_amdgcn_fence(__ATOMIC_ACQUIRE, "agent");
            xb_add(&bar[XB_XGEN(bx_)], 1u);
            asm volatile("s_waitcnt vmcnt(0)" ::: "memory");
        } else {
            XB_SPIN(xb_ld(&bar[XB_XGEN(bx_)]) == gen, bar);
            __builtin_amdgcn_fence(__ATOMIC_ACQUIRE, "agent");
            asm volatile("s_waitcnt vmcnt(0)" ::: "memory");
        }
    }
    __syncthreads();
}


constexpr int NWAVES = 8, NTHREADS = 512;
constexpr int SEQ = 8192, DMODEL = 2048, NLAYER = 2;
constexpr int INC = 13088;
constexpr int ZC = 13312;
constexpr int ZC_CQ = 0, ZC_CKV = 512, ZC_BG = 768, ZC_CG = 1280, ZC_XV = 1792, ZC_DQ = 2304, ZC_DK = 2816, ZC_DV = 3328, ZC_CA = 3840, ZC_CGT = 4352, ZC_KR = 4864, ZC_GATE = 5120;
constexpr int QMC = 768, KVC = 1024;
constexpr float LOG2E = 1.4426950408889634f;
constexpr float C2_MLA = 0.10206207261596577f * LOG2E;
constexpr float C2_DIFF = 0.125f * LOG2E;
constexpr float NORM_EPS = 1e-6f, LN_EPS = 1e-5f;
constexpr int PEER_NE = 16384;

constexpr size_t MiB = 1u << 20;
constexpr size_t WS_CTL = 0, CTL_ZERO_BYTES = 1 * MiB;
constexpr size_t WS_COSM = 1 * MiB, WS_SINM = WS_COSM + 512 * 1024, WS_COSD = 2 * MiB, WS_SIND = WS_COSD + 256 * 1024, WS_RSTD = 3 * MiB;
constexpr size_t WS_SUBK = 3 * MiB + 512 * 1024;
constexpr size_t WS_WIN = 4 * MiB;
constexpr size_t WS_WUQ = 56 * MiB;
constexpr size_t WS_WUKV = 57 * MiB;
constexpr size_t WS_WOUT = 58 * MiB;
constexpr size_t WS_WO = 66 * MiB;
constexpr size_t WS_WQ = 74 * MiB;
constexpr size_t WS_UBF = 80 * MiB;
constexpr size_t WS_VBF = 144 * MiB;
constexpr size_t WS_USC = 112 * MiB, WS_VSC = 176 * MiB;
constexpr size_t WS_H = 208 * MiB;
constexpr size_t WS_H2 = 240 * MiB;
constexpr size_t WS_Z = 272 * MiB;
constexpr size_t WS_QM = 480 * MiB;
constexpr size_t WS_KVM = 492 * MiB;
constexpr size_t WS_ACT = 508 * MiB;
constexpr size_t WS_DO = 540 * MiB;
constexpr size_t WS_MERGED = 556 * MiB;
constexpr size_t WS_XA = 588 * MiB;
constexpr size_t WS_PQ = 652 * MiB;
constexpr size_t WS_IDX = 684 * MiB;
constexpr size_t WS_GATE = 688 * MiB;
constexpr size_t WS_H2F8 = 692 * MiB;
constexpr size_t WS_HSCI = 708 * MiB;
constexpr size_t WS_A8 = 709 * MiB;
constexpr size_t WS_B8 = 725 * MiB;
constexpr size_t WS_SA8 = 752 * MiB;
constexpr size_t WS_SB8 = 752 * MiB + 65536;
constexpr size_t WS_M8 = 753 * MiB;
constexpr size_t WS_WO8 = 769 * MiB;
constexpr size_t WS_SM8 = 773 * MiB;
constexpr size_t WS_SWO8 = 773 * MiB + 65536;
constexpr size_t WS_H2I8 = 774 * MiB;
constexpr size_t WS_WQ8 = 790 * MiB;
constexpr size_t WS_SWQ8 = 792 * MiB;
constexpr size_t WS_ACT8 = 793 * MiB;
constexpr size_t WS_WOUT8 = 809 * MiB;
constexpr size_t WS_SACT8 = 813 * MiB;
constexpr size_t WS_SWOUT8 = 813 * MiB + 262144;
constexpr size_t WS_QA8 = 814 * MiB;
constexpr size_t WS_WUQ8 = 822 * MiB;
constexpr size_t WS_SWUQ8 = 823 * MiB;
constexpr size_t WS_END = 824 * MiB;
constexpr int CW_BAR = 4096;
constexpr int CW_QATT = 16384;

constexpr int RING_BYTES = 131072;
constexpr int LDSCTL_OFF = RING_BYTES, MISC_OFF = LDSCTL_OFF + 320;
constexpr int LDS_PART_OFF = LDSCTL_OFF + 1024;
constexpr int LDS_BYTES = 147456;

struct Frame {
    LAS unsigned char* lds;
    int wv;
    volatile LAS unsigned* MISC;
    gu32* ctl;
    int G;
    unsigned char* ws_base;
};
#define PHASE_IDS() const int tid = otid(F.wv), lane = tid & 63, wave = __builtin_amdgcn_readfirstlane(tid >> 6); (void)lane; (void)wave; unsigned char* const ws = ows(F.ws_base); (void)ws

template <int CTRL> __device__ __forceinline__ float dpp_f(float v) { return __builtin_bit_cast(float, __builtin_amdgcn_update_dpp(0, __builtin_bit_cast(int, v), CTRL, 0xF, 0xF, false)); }
__device__ __forceinline__ float rl(float v, int l) { return __builtin_bit_cast(float, __builtin_amdgcn_readlane(__builtin_bit_cast(int, v), l)); }
__device__ __forceinline__ float wave_sum(float v) {
    v += dpp_f<0xB1>(v); v += dpp_f<0x4E>(v); v += dpp_f<0x141>(v); v += dpp_f<0x140>(v);
    return (rl(v, 0) + rl(v, 16)) + (rl(v, 32) + rl(v, 48));
}
__device__ __forceinline__ float wave_max(float v) {
    v = fmaxf(v, dpp_f<0xB1>(v)); v = fmaxf(v, dpp_f<0x4E>(v)); v = fmaxf(v, dpp_f<0x141>(v)); v = fmaxf(v, dpp_f<0x140>(v));
    return fmaxf(fmaxf(rl(v, 0), rl(v, 16)), fmaxf(rl(v, 32), rl(v, 48)));
}
__device__ __forceinline__ float row16_sum(float v) { v += dpp_f<0xB1>(v); v += dpp_f<0x4E>(v); v += dpp_f<0x141>(v); v += dpp_f<0x140>(v); return v; }
__device__ __forceinline__ float bf_lo(unsigned w) { return __builtin_bit_cast(float, w << 16); }
__device__ __forceinline__ float bf_hi(unsigned w) { return __builtin_bit_cast(float, w & 0xffff0000u); }
__device__ __forceinline__ float bf2f(bf16 b) { return __builtin_bit_cast(float, (unsigned)b << 16); }
__device__ __forceinline__ float sigmoidf_(float x) { return __builtin_amdgcn_rcpf(1.f + __builtin_amdgcn_exp2f(-1.4426950408889634f * x)); }
typedef __bf16 bf16x2_t __attribute__((ext_vector_type(2)));
__device__ __forceinline__ float dot2_bf16(unsigned w, unsigned x, float acc) { return __builtin_amdgcn_fdot2_f32_bf16(__builtin_bit_cast(bf16x2_t, w), __builtin_bit_cast(bf16x2_t, x), acc, false); }

__device__ __forceinline__ int colmap(int mode, int c) {
    if (mode == 0) return c;
    if (mode == 1) {
        if (c < 768) return c;
        if (c < 2304) return 800 + (c - 768);
        if (c < 3328) { const int seg = c >= 2816, o = c - (seg ? 2816 : 2304), d = o & 63, dd = d < 16 ? ((d >> 1) + 8 * (d & 1)) : d; return (seg ? 2848 : 2336) + (o & ~63) + dd; }
        if (c < 3840) return 3360 + (c - 3328);
        if (c < 4864) return 3872 + (c - 3840);
        if (c < 4896) { const int d = c - 4864; return 768 + (d >> 1) + 16 * (d & 1); }
        if (c < 5120) return -1;
        return 4896 + (c - 5120);
    }
    { const int hd = c / 96, d = c % 96; if (d < 64) return c; const int e = d - 64; return hd * 96 + 64 + (e >> 1) + 16 * (e & 1); }
}
__device__ __forceinline__ void tr_item(const float* W, int ldw, const float* gk, bf16* WT, int ldt, int nblk, int item, int mode, LAS float* scr, int lane) {
    const int kb = item / nblk, nb = item % nblk, k0 = 64 * kb, n0 = 32 * nb;
    const int sc = colmap(mode, n0 + (lane & 31));
    float tv[32];
    { const float* wp = W + (size_t)(k0 + (lane >> 5)) * ldw + (sc >= 0 ? sc : 0);
#pragma unroll
      for (int i = 0; i < 32; ++i) tv[i] = wp[(size_t)(2 * i) * ldw]; }
    if (gk) {
#pragma unroll
        for (int i = 0; i < 32; ++i) tv[i] *= gk[k0 + 2 * i + (lane >> 5)]; }
#pragma unroll
    for (int i = 0; i < 32; ++i) scr[(2 * i + (lane >> 5)) * 33 + (lane & 31)] = sc >= 0 ? tv[i] : 0.f;
    LDS_WAIT(); asm volatile("" ::: "memory");
    const int c = lane & 7;
#pragma unroll
    for (int j = 0; j < 4; ++j) { const int n = (lane >> 3) + 8 * j; const LAS float* s = scr + (8 * c) * 33 + n;
        v4u o; o.x = pk2(s[0 * 33], s[1 * 33]); o.y = pk2(s[2 * 33], s[3 * 33]); o.z = pk2(s[4 * 33], s[5 * 33]); o.w = pk2(s[6 * 33], s[7 * 33]);
        *(GAS v4u*)(WT + (size_t)(n0 + n) * ldt + k0 + 8 * c) = o; }
    LDS_WAIT(); asm volatile("" ::: "memory");
}
__device__ __forceinline__ void rms_row_to_bf16(const float* xrow, const float* g, bf16* orow, int lane) {
    const GAS f32x4* xr = (const GAS f32x4*)xrow + lane; const GAS f32x4* gr = (const GAS f32x4*)g + lane;
    f32x4 v[8]; float s = 0.f;
#pragma unroll
    for (int j = 0; j < 8; ++j) { v[j] = xr[64 * j]; s += (v[j].x * v[j].x + v[j].y * v[j].y) + (v[j].z * v[j].z + v[j].w * v[j].w); }
    const float rstd = 1.f / sqrtf(wave_sum(s) * (1.f / DMODEL) + NORM_EPS);
    GAS unsigned long long* o8 = (GAS unsigned long long*)orow + lane;
#pragma unroll
    for (int j = 0; j < 8; ++j) { const f32x4 gg = gr[64 * j]; o8[64 * j] = (unsigned long long)pk2(v[j].x * rstd * gg.x, v[j].y * rstd * gg.y) | ((unsigned long long)pk2(v[j].z * rstd * gg.z, v[j].w * rstd * gg.w) << 32); }
}
__device__ __forceinline__ unsigned q4_i8(float a, float b, float c, float d) {
    const int q0 = (int)__builtin_rintf(a), q1 = (int)__builtin_rintf(b), q2 = (int)__builtin_rintf(c), q3 = (int)__builtin_rintf(d);
    return ((unsigned)q0 & 255u) | (((unsigned)q1 & 255u) << 8) | (((unsigned)q2 & 255u) << 16) | ((unsigned)q3 << 24);
}
__device__ __forceinline__ void row_bf16_to_i8(const bf16* src, unsigned char* dst, float* sci, int lane) {
    v4u w[4]; float am = 0.f;
#pragma unroll
    for (int j = 0; j < 4; ++j) { w[j] = *(const GAS v4u*)(src + 8 * (lane + 64 * j));
        am = fmaxf(fmaxf(am, fabsf(bf_lo(w[j].x))), fabsf(bf_hi(w[j].x))); am = fmaxf(fmaxf(am, fabsf(bf_lo(w[j].y))), fabsf(bf_hi(w[j].y)));
        am = fmaxf(fmaxf(am, fabsf(bf_lo(w[j].z))), fabsf(bf_hi(w[j].z))); am = fmaxf(fmaxf(am, fabsf(bf_lo(w[j].w))), fabsf(bf_hi(w[j].w))); }
    am = wave_max(am);
    const float sc = am > 0.f ? 127.f / am : 1.f;
    typedef unsigned v2u_ __attribute__((ext_vector_type(2)));
#pragma unroll
    for (int j = 0; j < 4; ++j)
        *(GAS v2u_*)(dst + 8 * (lane + 64 * j)) = (v2u_){q4_i8(bf_lo(w[j].x) * sc, bf_hi(w[j].x) * sc, bf_lo(w[j].y) * sc, bf_hi(w[j].y) * sc), q4_i8(bf_lo(w[j].z) * sc, bf_hi(w[j].z) * sc, bf_lo(w[j].w) * sc, bf_hi(w[j].w) * sc)};
    if (lane == 0) *(GAS float*)sci = am > 0.f ? am * (1.f / 127.f) : 1.f;
}
__device__ __forceinline__ void q512_store(float (&f)[8], unsigned char* dst, float* sci, int lane) {
    float am = 0.f;
#pragma unroll
    for (int i = 0; i < 8; ++i) am = fmaxf(am, fabsf(f[i]));
    am = wave_max(am);
    const float sc = am > 0.f ? 127.f / am : 1.f;
    typedef unsigned v2u_ __attribute__((ext_vector_type(2)));
    *(GAS v2u_*)(dst + 8 * lane) = (v2u_){q4_i8(f[0] * sc, f[1] * sc, f[2] * sc, f[3] * sc), q4_i8(f[4] * sc, f[5] * sc, f[6] * sc, f[7] * sc)};
    if (lane == 0) *(GAS float*)sci = am > 0.f ? am * (1.f / 127.f) : 1.f;
}
__device__ __forceinline__ void row512_bf16_to_i8(const bf16* src, unsigned char* dst, float* sci, int lane) {
    const v4u w = *(const GAS v4u*)(src + 8 * lane);
    float f[8] = {bf_lo(w.x), bf_hi(w.x), bf_lo(w.y), bf_hi(w.y), bf_lo(w.z), bf_hi(w.z), bf_lo(w.w), bf_hi(w.w)};
    q512_store(f, dst, sci, lane);
}
__device__ __forceinline__ void rms_row_to_i8(const float* xrow, const float* g, unsigned char* dst, float* sci, int lane) {
    const GAS f32x4* xr = (const GAS f32x4*)xrow + lane; const GAS f32x4* gr = (const GAS f32x4*)g + lane;
    f32x4 v[8]; float s = 0.f;
#pragma unroll
    for (int j = 0; j < 8; ++j) { v[j] = xr[64 * j]; s += (v[j].x * v[j].x + v[j].y * v[j].y) + (v[j].z * v[j].z + v[j].w * v[j].w); }
    const float rstd = 1.f / sqrtf(wave_sum(s) * (1.f / DMODEL) + NORM_EPS);
    float am = 0.f;
#pragma unroll
    for (int j = 0; j < 8; ++j) { const f32x4 gg = gr[64 * j];
        v[j].x = bf_lo(pk2(v[j].x * rstd * gg.x, 0.f)); v[j].y = bf_lo(pk2(v[j].y * rstd * gg.y, 0.f)); v[j].z = bf_lo(pk2(v[j].z * rstd * gg.z, 0.f)); v[j].w = bf_lo(pk2(v[j].w * rstd * gg.w, 0.f));
        am = fmaxf(fmaxf(am, fabsf(v[j].x)), fabsf(v[j].y)); am = fmaxf(fmaxf(am, fabsf(v[j].z)), fabsf(v[j].w)); }
    am = wave_max(am);
    const float isc = am > 0.f ? 127.f / am : 1.f;
    GAS unsigned* o1 = (GAS unsigned*)dst + lane;
#pragma unroll
    for (int j = 0; j < 8; ++j) o1[64 * j] = q4_i8(v[j].x * isc, v[j].y * isc, v[j].z * isc, v[j].w * isc);
    if (lane == 0) *(GAS float*)sci = am > 0.f ? am * (1.f / 127.f) : 1.f;
}
#define CAS __attribute__((address_space(4)))
__device__ __forceinline__ const float* inp(int i) { unsigned off = (unsigned)i * 8u; asm volatile("" : "+s"(off)); const CAS char* kp = (const CAS char*)__builtin_amdgcn_kernarg_segment_ptr(); const __attribute__((address_space(1))) float* r_ = (const __attribute__((address_space(1))) float*)*(const float* const CAS*)(kp + off); asm volatile("" : "+s"(r_)); return (const float*)r_; }
struct LayerW {
    const float *mix_g, *w_in, *gate_b, *q_g, *w_uq, *kv_g, *w_ukv, *mla_wo, *sc_w, *sc_wo, *lam, *diff_g, *diff_wo, *cf_w, *cf_b, *cf_g, *cf_bb, *cf_wo, *w_o, *ffn_g, *w_q, *subk, *pu, *pv;
};
constexpr int CW_TABQ = 24576;
template <int NR> __device__ __forceinline__ void table_rows(unsigned char* ws, int layer, int rr, int lane) {
    const int t = rr >= PEER_NE, row = rr - t * PEER_NE;
    const GAS f32x4* src = (const GAS f32x4*)(inp(t ? 25 : 24) + (size_t)layer * PEER_NE * 2048 + (size_t)row * 2048);
    f32x4 v[NR][8];
#pragma unroll
    for (int q = 0; q < NR; ++q)
#pragma unroll
        for (int j = 0; j < 2; ++j)
#pragma unroll
            for (int d = 0; d < 4; ++d) v[q][4 * j + d] = src[512 * q + 256 * j + 4 * lane + d];
#pragma unroll
    for (int q = 0; q < NR; ++q) {
        float am = 0.f;
#pragma unroll
        for (int i = 0; i < 8; ++i) { const f32x4 x = v[q][i]; am = fmaxf(am, fmaxf(fmaxf(fabsf(x.x), fabsf(x.y)), fmaxf(fabsf(x.z), fabsf(x.w)))); }
        am = fmaxf(wave_max(am), 1e-30f);
        const float inv = 400.f / am;
#pragma unroll
        for (int j = 0; j < 2; ++j) { v4u o;
#pragma unroll
            for (int d = 0; d < 4; ++d) { const f32x4 x = v[q][4 * j + d] * inv; int p = __builtin_amdgcn_cvt_pk_fp8_f32(x.x, x.y, 0, false); p = __builtin_amdgcn_cvt_pk_fp8_f32(x.z, x.w, p, true); o[d] = (unsigned)p; }
            *(GAS v4u*)(ws + (t ? WS_VBF : WS_UBF) + (size_t)(row + q) * 2048 + 1024 * j + 16 * lane) = o; }
        if (lane == 0) ((float*)(ws + (t ? WS_VSC : WS_USC)))[row + q] = am * (1.f / 400.f);
    }
}
__device__ __forceinline__ void tables_dyn(Frame& F, int layer) {
    PHASE_IDS();
    gu32* qw = F.ctl + CW_TABQ + 64 * layer;
    for (;;) {
        unsigned c = 0u; if (lane == 0) c = __hip_atomic_fetch_add(qw, 1u, RLX_AGENT);
        c = (unsigned)__builtin_amdgcn_readfirstlane((int)c);
        if (c >= (unsigned)(2 * PEER_NE / 8)) break;
#pragma unroll 1
        for (int k = 0; k < 8; k += 2) table_rows<2>(ws, layer, (int)c * 8 + k, lane);
    }
}
__device__ __forceinline__ void p0_prologue(Frame& F, int layer, int part) {
    PHASE_IDS();
    LAS float* scr = (LAS float*)(F.lds + wave * 16384);
    const int gw = obid() * NWAVES + wave, NGW = F.G * NWAVES;
    constexpr int I_IN = 32 * (ZC / 32), I_UQ = 8 * 24, I_UKV = 4 * 32, I_OUT = 8 * 64, I_O = 32 * 64, I_Q = 32 * 32;
    constexpr int NITEMS = I_IN + I_UQ + I_UKV + 4 * I_OUT + I_O + I_Q;
    if (part == 1) {
    for (int it = gw; it < NITEMS; it += NGW) {
        int r = it, ldw, ldt, nblk, mode = 0; const float* src; const float* gk = nullptr; bf16* dst;
        if (r < I_IN) { src = inp(3) + (size_t)layer * 2048 * INC; ldw = INC; dst = (bf16*)(ws + WS_WIN); ldt = 2048; nblk = ZC / 32; mode = 1; }
        else if ((r -= I_IN) < I_UQ) { src = inp(6) + (size_t)layer * 512 * 768; gk = inp(5) + (size_t)layer * 512; ldw = 768; dst = (bf16*)(ws + WS_WUQ); ldt = 512; nblk = 24; mode = 2; }
        else if ((r -= I_UQ) < I_UKV) { src = inp(8) + (size_t)layer * 256 * 1024; gk = inp(7) + (size_t)layer * 256; ldw = 1024; dst = (bf16*)(ws + WS_WUQ) + (size_t)768 * 512; ldt = 512; nblk = 32; }
        else if ((r -= I_UKV) < 4 * I_OUT) { const int br = r / I_OUT; r -= br * I_OUT; src = inp(br == 0 ? 9 : br == 1 ? 11 : br == 2 ? 14 : 19) + (size_t)layer * 512 * 2048; ldw = 2048; dst = (bf16*)(ws + WS_WOUT) + (size_t)br * 2048 * 512; ldt = 512; nblk = 64; }
        else if ((r -= 4 * I_OUT) < I_O) { src = inp(20) + (size_t)layer * 2048 * 2048; ldw = 2048; dst = (bf16*)(ws + WS_WO); ldt = 2048; nblk = 64; }
        else { r -= I_O; src = inp(22) + (size_t)layer * 2048 * 1024; ldw = 1024; dst = (bf16*)(ws + WS_WQ); ldt = 2048; nblk = 32; }
        tr_item(src, ldw, gk, dst, ldt, nblk, r, mode, scr, lane);
    }
    { const float* sk = inp(23) + (size_t)layer * 2 * 128 * 64;
      for (int i = obid() * NTHREADS + tid; i < 2 * 128 * 64 / 8; i += F.G * NTHREADS) { const f32x4 a_ = *(const GAS f32x4*)(sk + 8 * i), b_ = *(const GAS f32x4*)(sk + 8 * i + 4);
          *(GAS v4u*)((bf16*)(ws + WS_SUBK) + 8 * i) = (v4u){pk2(a_.x, a_.y), pk2(a_.z, a_.w), pk2(b_.x, b_.y), pk2(b_.z, b_.w)}; } }
    for (int i = obid() * NTHREADS + tid; i < 1024 * 32; i += F.G * NTHREADS) { const int n = i >> 5, ch = i & 31; unsigned z_ = 0u; asm volatile("" : "+v"(z_)); *(GAS v4u*)((bf16*)(ws + WS_WUQ) + (size_t)(768 + n) * 512 + 256 + 8 * ch) = (v4u){z_, z_, z_, z_}; }
    }
    if (layer == 0 && part == 1) {
        const int* positions = (const int*)inp(1);
        float* cosm = (float*)(ws + WS_COSM); float* sinm = (float*)(ws + WS_SINM); float* cosd = (float*)(ws + WS_COSD); float* sind = (float*)(ws + WS_SIND);
        for (int i = obid() * NTHREADS + tid; i < SEQ * 24; i += F.G * NTHREADS) {
            const int s = i / 24, j = i % 24; const float pos = (float)positions[s];
            const float ex = j < 16 ? (float)j * (1.f / 16.f) : (float)(j - 16) * (1.f / 8.f);
            const float inv = exp2f(-ex * 18.931568569324174f);
            const float ang = pos * inv;
            double rev = (double)ang * 0.15915494309189535; rev -= floor(rev);
            const float fr = (float)rev; const float cv = __builtin_amdgcn_cosf(fr), sv = __builtin_amdgcn_sinf(fr);
            if (j < 16) { cosm[s * 16 + j] = cv; sinm[s * 16 + j] = sv; } else { cosd[s * 8 + (j - 16)] = cv; sind[s * 8 + (j - 16)] = sv; }
        }
        { const float* x = inp(0); const float* mg = inp(2);
          for (int m = gw; m < SEQ; m += NGW) rms_row_to_i8(x + (size_t)m * DMODEL, mg, ws + WS_A8 + (size_t)m * DMODEL, (float*)(ws + WS_SA8) + m, lane); }
    }
}

namespace pg8 {
template <class Fn> __device__ __forceinline__ void walk8(const f32x4 (&acc)[2][2][4][2], int pm, int pn, int wr, int wc, int fr, int fq, Fn f) {
    const int row0 = pm * BM + wr * 64 + fr, col0 = pn * BM + wc * 32 + 8 * fq;
#pragma unroll
    for (int ai = 0; ai < 2; ++ai)
#pragma unroll
        for (int m = 0; m < 4; ++m)
#pragma unroll
            for (int bj = 0; bj < 2; ++bj) f(row0 + ai * HALF + m * 16, col0 + bj * HALF, acc[ai][bj][m][0], acc[ai][bj][m][1]);
}
__device__ __forceinline__ u32x4 pack8(f32x4 v0, f32x4 v1) { u32x4 w; w.x = cvt_pk_bf16(v0[0], v0[1]); w.y = cvt_pk_bf16(v0[2], v0[3]); w.z = cvt_pk_bf16(v1[0], v1[1]); w.w = cvt_pk_bf16(v1[2], v1[3]); return w; }
__device__ __forceinline__ void rope4(f32x4& v0, f32x4& v1, const float* cs, const float* sn) {
    const f32x4 c = *(const f32x4*)cs, s = *(const f32x4*)sn;
    const float a0 = v0[0], b0 = v0[1], a1 = v0[2], b1 = v0[3], a2 = v1[0], b2 = v1[1], a3 = v1[2], b3 = v1[3];
    v0[0] = a0 * c[0] - b0 * s[0]; v0[1] = b0 * c[0] + a0 * s[0]; v0[2] = a1 * c[1] - b1 * s[1]; v0[3] = b1 * c[1] + a1 * s[1];
    v1[0] = a2 * c[2] - b2 * s[2]; v1[1] = b2 * c[2] + a2 * s[2]; v1[2] = a3 * c[3] - b3 * s[3]; v1[3] = b3 * c[3] + a3 * s[3];
}
template <bool I8> struct EpiZT {
    static constexpr bool PERM = true, AFTER_DRAIN = false;
    bf16_t* Z; const float *cosm, *sinm, *cosd, *sind; const float *sa8, *sb8;
    __device__ __forceinline__ void operator()(const f32x4 (&acc)[2][2][4][2], const Unit& u, int wr, int wc, int fr, int fq) const {
        const int row0 = u.pm * BM + wr * 64 + fr, col0 = u.pn * BM + wc * 32 + 8 * fq;
        f32x4 qcb[2][2]; float qra[2][4];
        if constexpr (I8) {
#pragma unroll
            for (int bj = 0; bj < 2; ++bj) { qcb[bj][0] = *(const f32x4*)(sb8 + col0 + bj * HALF); qcb[bj][1] = *(const f32x4*)(sb8 + col0 + bj * HALF + 4); }
#pragma unroll
            for (int ai = 0; ai < 2; ++ai)
#pragma unroll
                for (int m = 0; m < 4; ++m) qra[ai][m] = sa8[row0 + ai * HALF + m * 16];
        }
        auto val = [&](int ai, int bj, int m, int j) -> f32x4 { if constexpr (I8) { typedef int v4i_ __attribute__((ext_vector_type(4))); const v4i_ q = __builtin_bit_cast(v4i_, acc[ai][bj][m][j]);
                return (f32x4){(float)q.x, (float)q.y, (float)q.z, (float)q.w} * qcb[bj][j] * qra[ai][m]; } else return acc[ai][bj][m][j]; };
        const bool tile_d = u.pn >= 9 && u.pn <= 12, tile_k = u.pn == 19;
        if (!(tile_d || tile_k)) {
#pragma unroll
            for (int ai = 0; ai < 2; ++ai)
#pragma unroll
                for (int m = 0; m < 4; ++m)
#pragma unroll
                    for (int bj = 0; bj < 2; ++bj) *(u32x4*)(Z + (size_t)(row0 + ai * HALF + m * 16) * ZC + col0 + bj * HALF) = pack8(val(ai, bj, m, 0), val(ai, bj, m, 1));
            return;
        }
        const int d = tile_d ? (col0 & 63) : (col0 - ZC_KR);
        const bool rot0 = tile_d ? d < 16 : d < 32, rot1 = tile_d ? d < 16 : false;
        const float* cb = tile_d ? cosd : cosm; const float* sb = tile_d ? sind : sinm; const int fstr = tile_d ? 8 : 16, foff = (rot0 ? d : 0) >> 1;
        const float qs = (tile_d && u.pn <= 10) ? C2_DIFF : 1.f;
#pragma unroll
        for (int ai = 0; ai < 2; ++ai) {
            f32x4 cs[4], sn[4];
#pragma unroll
            for (int m = 0; m < 4; ++m) { const int row = row0 + ai * HALF + m * 16; cs[m] = *(const f32x4*)(cb + row * fstr + foff); sn[m] = *(const f32x4*)(sb + row * fstr + foff); }
#pragma unroll
            for (int m = 0; m < 4; ++m)
#pragma unroll
                for (int bj = 0; bj < 2; ++bj) { const int row = row0 + ai * HALF + m * 16; f32x4 v0 = val(ai, bj, m, 0), v1 = val(ai, bj, m, 1);
                    if (bj == 0 ? rot0 : rot1) { const f32x4 c = cs[m], s_ = sn[m];
                        const float a0 = v0[0], b0 = v0[1], a1 = v0[2], b1 = v0[3], a2 = v1[0], b2 = v1[1], a3 = v1[2], b3 = v1[3];
                        v0[0] = a0 * c[0] - b0 * s_[0]; v0[1] = b0 * c[0] + a0 * s_[0]; v0[2] = a1 * c[1] - b1 * s_[1]; v0[3] = b1 * c[1] + a1 * s_[1];
                        v1[0] = a2 * c[2] - b2 * s_[2]; v1[1] = b2 * c[2] + a2 * s_[2]; v1[2] = a3 * c[3] - b3 * s_[3]; v1[3] = b3 * c[3] + a3 * s_[3]; }
                    v0 = v0 * qs; v1 = v1 * qs;
                    *(u32x4*)(Z + (size_t)row * ZC + col0 + bj * HALF) = pack8(v0, v1); }
        }
    }
};
typedef EpiZT<false> EpiZ;
typedef EpiZT<true> EpiZ8;
struct EpiGate8 {
    static constexpr bool PERM = true, AFTER_DRAIN = false;
    bf16_t* Z; const float *sa, *sb; const float *gate_b, *swout;
    __device__ __forceinline__ void operator()(const f32x4 (&acc)[2][2][4][2], const Unit& u, int wr, int wc, int fr, int fq) const {
        typedef int v4i_ __attribute__((ext_vector_type(4)));
        const int row0 = u.pm * BM + wr * 64 + fr, col0 = u.pn * BM + wc * 32 + 8 * fq;
        f32x4 cb[2][2];
#pragma unroll
        for (int bj = 0; bj < 2; ++bj) { cb[bj][0] = *(const f32x4*)(sb + col0 + bj * HALF); cb[bj][1] = *(const f32x4*)(sb + col0 + bj * HALF + 4); }
        f32x4 gb[2][2], gw[2][2];
#pragma unroll
        for (int bj = 0; bj < 2; ++bj) { gb[bj][0] = *(const f32x4*)(gate_b + col0 + bj * HALF); gb[bj][1] = *(const f32x4*)(gate_b + col0 + bj * HALF + 4);
            gw[bj][0] = *(const f32x4*)(swout + col0 + bj * HALF); gw[bj][1] = *(const f32x4*)(swout + col0 + bj * HALF + 4); }
        float ra[2][4];
#pragma unroll
        for (int ai = 0; ai < 2; ++ai)
#pragma unroll
            for (int m = 0; m < 4; ++m) ra[ai][m] = sa[row0 + ai * HALF + m * 16];
#pragma unroll
        for (int ai = 0; ai < 2; ++ai)
#pragma unroll
            for (int m = 0; m < 4; ++m)
#pragma unroll
                for (int bj = 0; bj < 2; ++bj) { const v4i_ i0 = __builtin_bit_cast(v4i_, acc[ai][bj][m][0]), i1 = __builtin_bit_cast(v4i_, acc[ai][bj][m][1]);
                    const f32x4 v0 = (f32x4){(float)i0.x, (float)i0.y, (float)i0.z, (float)i0.w}, v1 = (f32x4){(float)i1.x, (float)i1.y, (float)i1.z, (float)i1.w};
                    f32x4 l0 = v0 * cb[bj][0] * ra[ai][m] + gb[bj][0], l1 = v1 * cb[bj][1] * ra[ai][m] + gb[bj][1];
#pragma unroll
                    for (int e = 0; e < 4; ++e) { l0[e] = sigmoidf_(l0[e]) * gw[bj][0][e]; l1[e] = sigmoidf_(l1[e]) * gw[bj][1][e]; }
                    *(u32x4*)(Z + (size_t)(row0 + ai * HALF + m * 16) * ZC + ZC_GATE + col0 + bj * HALF) = pack8(l0, l1); }
    }
};
struct QKVOrder {
    StaticOrder S0;
    __device__ __forceinline__ bool next(int i, Unit& u) const { if (!S0.next(i, u)) return false; u.ka = u.pn >= 3 ? ZC_CKV : ZC_CQ; return true; }
    __device__ __forceinline__ void a_ready(const Unit&) const {}
    __device__ __forceinline__ void done(const Unit&) const {}
};
struct EpiQKV {
    static constexpr bool PERM = true, AFTER_DRAIN = false;
    bf16_t* QMo; bf16_t* KVo; const float* rstd; const float *cosm, *sinm;
    __device__ __forceinline__ void operator()(const f32x4 (&acc)[2][2][4][2], const Unit& u, int wr, int wc, int fr, int fq) const {
        const bool isq = u.pn < 3;
        const int row0 = u.pm * BM + wr * 64 + fr, col0 = u.pn * BM + wc * 32 + 8 * fq;
        float rs[2][4];
#pragma unroll
        for (int ai = 0; ai < 2; ++ai)
#pragma unroll
            for (int m = 0; m < 4; ++m) rs[ai][m] = rstd[(row0 + ai * HALF + m * 16) * 2 + (isq ? 0 : 1)];
#pragma unroll
        for (int ai = 0; ai < 2; ++ai)
#pragma unroll
            for (int m = 0; m < 4; ++m)
#pragma unroll
                for (int bj = 0; bj < 2; ++bj) { const int row = row0 + ai * HALF + m * 16, col = col0 + bj * HALF; f32x4 v0 = acc[ai][bj][m][0], v1 = acc[ai][bj][m][1];
                    if (isq) {
                        const float sc = rs[ai][m] * C2_MLA; v0 = v0 * sc; v1 = v1 * sc;
                        const int d = col % 96; if (d >= 64) rope4(v0, v1, cosm + row * 16 + ((d - 64) >> 1), sinm + row * 16 + ((d - 64) >> 1));
                        *(u32x4*)(QMo + (size_t)row * QMC + col) = pack8(v0, v1);
                    } else {
                        const float sc = rs[ai][m]; v0 = v0 * sc; v1 = v1 * sc;
                        *(u32x4*)(KVo + (size_t)row * KVC + (col - QMC)) = pack8(v0, v1);
                    } }
    }
};
struct QKVOrder8 {
    StaticOrder S0;
    __device__ __forceinline__ bool next(int i, Unit& u) const { if (!S0.next(i, u)) return false; u.ka = u.pn >= 3 ? 256 : 0; return true; }
    __device__ __forceinline__ void a_ready(const Unit&) const {}
    __device__ __forceinline__ void done(const Unit&) const {}
};
struct EpiQKV8 {
    static constexpr bool PERM = true, AFTER_DRAIN = false;
    bf16_t* QMo; bf16_t* KVo; const float* rstd; const float *cosm, *sinm; const float* sb;
    __device__ __forceinline__ void operator()(const f32x4 (&acc)[2][2][4][2], const Unit& u, int wr, int wc, int fr, int fq) const {
        const bool isq = u.pn < 3;
        const int row0 = u.pm * BM + wr * 64 + fr, col0 = u.pn * BM + wc * 32 + 8 * fq;
        typedef int v4i_ __attribute__((ext_vector_type(4)));
        f32x4 cb[2][2];
#pragma unroll
        for (int bj = 0; bj < 2; ++bj) { cb[bj][0] = *(const f32x4*)(sb + col0 + bj * HALF); cb[bj][1] = *(const f32x4*)(sb + col0 + bj * HALF + 4); }
        float rs[2][4];
#pragma unroll
        for (int ai = 0; ai < 2; ++ai)
#pragma unroll
            for (int m = 0; m < 4; ++m) rs[ai][m] = rstd[(row0 + ai * HALF + m * 16) * 2 + (isq ? 0 : 1)];
#pragma unroll
        for (int ai = 0; ai < 2; ++ai)
#pragma unroll
            for (int m = 0; m < 4; ++m)
#pragma unroll
                for (int bj = 0; bj < 2; ++bj) { const int row = row0 + ai * HALF + m * 16, col = col0 + bj * HALF; const v4i_ q0 = __builtin_bit_cast(v4i_, acc[ai][bj][m][0]), q1 = __builtin_bit_cast(v4i_, acc[ai][bj][m][1]);
                    f32x4 v0 = (f32x4){(float)q0.x, (float)q0.y, (float)q0.z, (float)q0.w} * cb[bj][0], v1 = (f32x4){(float)q1.x, (float)q1.y, (float)q1.z, (float)q1.w} * cb[bj][1];
                    if (isq) {
                        const float sc = rs[ai][m] * C2_MLA; v0 = v0 * sc; v1 = v1 * sc;
                        const int d = col % 96; if (d >= 64) rope4(v0, v1, cosm + row * 16 + ((d - 64) >> 1), sinm + row * 16 + ((d - 64) >> 1));
                        *(u32x4*)(QMo + (size_t)row * QMC + col) = pack8(v0, v1);
                    } else {
                        const float sc = rs[ai][m]; v0 = v0 * sc; v1 = v1 * sc;
                        *(u32x4*)(KVo + (size_t)row * KVC + (col - QMC)) = pack8(v0, v1);
                    } }
    }
};
struct MergedOrder {
    StaticOrder S0;
    __device__ __forceinline__ bool next(int i, Unit& u) const { Unit t; if (!S0.next(i >> 2, t)) return false; const int br = i & 3; u.pm = br * 32 + t.pm; u.pn = br * 8 + t.pn; u.ka = 0; return true; }
    __device__ __forceinline__ void a_ready(const Unit&) const {}
    __device__ __forceinline__ void done(const Unit&) const {}
};
struct EpiMerged {
    static constexpr bool PERM = true, AFTER_DRAIN = false;
    bf16_t* Mg; const bf16_t* Z; const float* gate_b;
    __device__ __forceinline__ void operator()(const f32x4 (&acc)[2][2][4][2], const Unit& u, int wr, int wc, int fr, int fq) const {
        const int br = u.pm >> 5, pm = u.pm & 31, pn = u.pn & 7;
        const int row0 = pm * BM + wr * 64 + fr, col0 = pn * BM + wc * 32 + 8 * fq;
        f32x4 bia[2][2];
#pragma unroll
        for (int bj = 0; bj < 2; ++bj) { bia[bj][0] = *(const f32x4*)(gate_b + br * 2048 + col0 + bj * HALF); bia[bj][1] = *(const f32x4*)(gate_b + br * 2048 + col0 + bj * HALF + 4); }
#pragma unroll
        for (int ai = 0; ai < 2; ++ai) {
            u32x4 gz[4][2], old[4][2];
#pragma unroll
            for (int m = 0; m < 4; ++m)
#pragma unroll
                for (int bj = 0; bj < 2; ++bj) { const int row = row0 + ai * HALF + m * 16, col = col0 + bj * HALF;
                    gz[m][bj] = *(const u32x4*)(Z + (size_t)row * ZC + ZC_GATE + br * 2048 + col);
                    old[m][bj] = br > 0 ? *(const u32x4*)(Mg + (size_t)row * 2048 + col) : (u32x4){0u, 0u, 0u, 0u}; }
#pragma unroll
            for (int m = 0; m < 4; ++m)
#pragma unroll
                for (int bj = 0; bj < 2; ++bj) { const int row = row0 + ai * HALF + m * 16, col = col0 + bj * HALF;
                    const u32x4 g4 = gz[m][bj], o4 = old[m][bj]; const f32x4 v0 = acc[ai][bj][m][0], v1 = acc[ai][bj][m][1], b0 = bia[bj][0], b1 = bia[bj][1];
                    float o[8];
                    o[0] = bf_lo(o4.x) + sigmoidf_(bf_lo(g4.x) + b0[0]) * v0[0]; o[1] = bf_hi(o4.x) + sigmoidf_(bf_hi(g4.x) + b0[1]) * v0[1];
                    o[2] = bf_lo(o4.y) + sigmoidf_(bf_lo(g4.y) + b0[2]) * v0[2]; o[3] = bf_hi(o4.y) + sigmoidf_(bf_hi(g4.y) + b0[3]) * v0[3];
                    o[4] = bf_lo(o4.z) + sigmoidf_(bf_lo(g4.z) + b1[0]) * v1[0]; o[5] = bf_hi(o4.z) + sigmoidf_(bf_hi(g4.z) + b1[1]) * v1[1];
                    o[6] = bf_lo(o4.w) + sigmoidf_(bf_lo(g4.w) + b1[2]) * v1[2]; o[7] = bf_hi(o4.w) + sigmoidf_(bf_hi(g4.w) + b1[3]) * v1[3];
                    u32x4 w; w.x = cvt_pk_bf16(o[0], o[1]); w.y = cvt_pk_bf16(o[2], o[3]); w.z = cvt_pk_bf16(o[4], o[5]); w.w = cvt_pk_bf16(o[6], o[7]);
                    *(u32x4*)(Mg + (size_t)row * 2048 + col) = w; }
        }
    }
};
struct EpiMerged8 {
    static constexpr bool PERM = true, AFTER_DRAIN = false;
    bf16_t* Mg; const bf16_t* Z; const float* sa;
    __device__ __forceinline__ void operator()(const f32x4 (&acc)[2][2][4][2], const Unit& u, int wr, int wc, int fr, int fq) const {
        typedef int v4i_ __attribute__((ext_vector_type(4)));
        const int br = u.pm >> 5, pm = u.pm & 31, pn = u.pn & 7;
        const int row0 = pm * BM + wr * 64 + fr, col0 = pn * BM + wc * 32 + 8 * fq;
#pragma unroll
        for (int ai = 0; ai < 2; ++ai) {
            u32x4 gz[4][2], old[4][2]; float rsc[4];
#pragma unroll
            for (int m = 0; m < 4; ++m) { rsc[m] = sa[br * SEQ + row0 + ai * HALF + m * 16];
#pragma unroll
                for (int bj = 0; bj < 2; ++bj) { const int row = row0 + ai * HALF + m * 16, col = col0 + bj * HALF;
                    gz[m][bj] = *(const u32x4*)(Z + (size_t)row * ZC + ZC_GATE + br * 2048 + col);
                    old[m][bj] = br > 0 ? *(const u32x4*)(Mg + (size_t)row * 2048 + col) : (u32x4){0u, 0u, 0u, 0u}; } }
#pragma unroll
            for (int m = 0; m < 4; ++m)
#pragma unroll
                for (int bj = 0; bj < 2; ++bj) { const int row = row0 + ai * HALF + m * 16, col = col0 + bj * HALF;
                    const u32x4 g4 = gz[m][bj], o4 = old[m][bj]; const v4i_ q0 = __builtin_bit_cast(v4i_, acc[ai][bj][m][0]), q1 = __builtin_bit_cast(v4i_, acc[ai][bj][m][1]); const float rs = rsc[m];
                    float o[8];
                    o[0] = bf_lo(o4.x) + bf_lo(g4.x) * ((float)q0.x * rs); o[1] = bf_hi(o4.x) + bf_hi(g4.x) * ((float)q0.y * rs);
                    o[2] = bf_lo(o4.y) + bf_lo(g4.y) * ((float)q0.z * rs); o[3] = bf_hi(o4.y) + bf_hi(g4.y) * ((float)q0.w * rs);
                    o[4] = bf_lo(o4.z) + bf_lo(g4.z) * ((float)q1.x * rs); o[5] = bf_hi(o4.z) + bf_hi(g4.z) * ((float)q1.y * rs);
                    o[6] = bf_lo(o4.w) + bf_lo(g4.w) * ((float)q1.z * rs); o[7] = bf_hi(o4.w) + bf_hi(g4.w) * ((float)q1.w * rs);
                    u32x4 w; w.x = cvt_pk_bf16(o[0], o[1]); w.y = cvt_pk_bf16(o[2], o[3]); w.z = cvt_pk_bf16(o[4], o[5]); w.w = cvt_pk_bf16(o[6], o[7]);
                    *(u32x4*)(Mg + (size_t)row * 2048 + col) = w; }
        }
    }
};
struct EpiResF32 {
    static constexpr bool PERM = false, AFTER_DRAIN = false;
    const float* base; float* C; int ldc;
    __device__ __forceinline__ void operator()(const f32x4 (&acc)[2][2][4][2], const Unit& u, int wr, int wc, int fr, int fq) const {
        const int row0 = u.pm * BM + wr * 64 + fr, col0 = u.pn * BM + wc * 32 + 4 * fq;
#pragma unroll
        for (int ai = 0; ai < 2; ++ai) {
            f32x4 pre[4][2][2];
            if (base) {
#pragma unroll
                for (int m = 0; m < 4; ++m) { const size_t ro = (size_t)(row0 + ai * HALF + m * 16) * ldc + col0;
#pragma unroll
                    for (int bj = 0; bj < 2; ++bj)
#pragma unroll
                        for (int n = 0; n < 2; ++n) pre[m][bj][n] = *(const f32x4*)(base + ro + bj * HALF + n * 16); }
            }
#pragma unroll
            for (int m = 0; m < 4; ++m) { const size_t ro = (size_t)(row0 + ai * HALF + m * 16) * ldc + col0;
#pragma unroll
                for (int bj = 0; bj < 2; ++bj)
#pragma unroll
                    for (int n = 0; n < 2; ++n) { f32x4 v = acc[ai][bj][m][n]; if (base) v = v + pre[m][bj][n]; *(f32x4*)(C + ro + bj * HALF + n * 16) = v; } }
        }
    }
};
struct EpiPQ8 {
    static constexpr bool PERM = false, AFTER_DRAIN = false;
    float* C; const float *hsci, *sb;
    __device__ __forceinline__ void operator()(const f32x4 (&acc)[2][2][4][2], const Unit& u, int wr, int wc, int fr, int fq) const {
        typedef int v4i_ __attribute__((ext_vector_type(4)));
        const int row0 = u.pm * BM + wr * 64 + fr, col0 = u.pn * BM + wc * 32 + 4 * fq;
        f32x4 cb[2][2]; float ra[2][4];
#pragma unroll
        for (int bj = 0; bj < 2; ++bj)
#pragma unroll
            for (int n = 0; n < 2; ++n) cb[bj][n] = *(const f32x4*)(sb + col0 + bj * HALF + n * 16);
#pragma unroll
        for (int ai = 0; ai < 2; ++ai)
#pragma unroll
            for (int m = 0; m < 4; ++m) ra[ai][m] = hsci[row0 + ai * HALF + m * 16] * (224.f / 127.f);
#pragma unroll
        for (int ai = 0; ai < 2; ++ai)
#pragma unroll
            for (int m = 0; m < 4; ++m) { const size_t ro = (size_t)(row0 + ai * HALF + m * 16) * 1024 + col0;
#pragma unroll
                for (int bj = 0; bj < 2; ++bj)
#pragma unroll
                    for (int n = 0; n < 2; ++n) { const v4i_ q = __builtin_bit_cast(v4i_, acc[ai][bj][m][n]);
                        *(f32x4*)(C + ro + bj * HALF + n * 16) = (f32x4){(float)q.x, (float)q.y, (float)q.z, (float)q.w} * cb[bj][n] * ra[ai][m]; } }
    }
};
struct EpiRes8 {
    static constexpr bool PERM = false, AFTER_DRAIN = false;
    const float* base; float* C; const float *sa, *sb;
    __device__ __forceinline__ void operator()(const f32x4 (&acc)[2][2][4][2], const Unit& u, int wr, int wc, int fr, int fq) const {
        typedef int v4i_ __attribute__((ext_vector_type(4)));
        const int row0 = u.pm * BM + wr * 64 + fr, col0 = u.pn * BM + wc * 32 + 4 * fq;
        f32x4 cb[2][2];
#pragma unroll
        for (int bj = 0; bj < 2; ++bj)
#pragma unroll
            for (int n = 0; n < 2; ++n) cb[bj][n] = *(const f32x4*)(sb + col0 + bj * HALF + n * 16);
#pragma unroll
        for (int ai = 0; ai < 2; ++ai) {
            f32x4 pre[4][2][2]; float ra[4];
#pragma unroll
            for (int m = 0; m < 4; ++m) { const size_t ro = (size_t)(row0 + ai * HALF + m * 16) * 2048 + col0; ra[m] = sa[row0 + ai * HALF + m * 16];
#pragma unroll
                for (int bj = 0; bj < 2; ++bj)
#pragma unroll
                    for (int n = 0; n < 2; ++n) pre[m][bj][n] = *(const f32x4*)(base + ro + bj * HALF + n * 16); }
#pragma unroll
            for (int m = 0; m < 4; ++m) { const size_t ro = (size_t)(row0 + ai * HALF + m * 16) * 2048 + col0;
#pragma unroll
                for (int bj = 0; bj < 2; ++bj)
#pragma unroll
                    for (int n = 0; n < 2; ++n) { const v4i_ q = __builtin_bit_cast(v4i_, acc[ai][bj][m][n]);
                        *(f32x4*)(C + ro + bj * HALF + n * 16) = (f32x4){(float)q.x, (float)q.y, (float)q.z, (float)q.w} * cb[bj][n] * ra[m] + pre[m][bj][n]; } }
        }
    }
};
}

__device__ __forceinline__ void p2_branch_prep(Frame& F, int layer) {
    LayerW W; W.sc_w = inp(10) + (size_t)layer * 3 * 512; W.cf_w = inp(15) + (size_t)layer * 31 * 512; W.cf_b = inp(16) + (size_t)layer * 512; W.cf_g = inp(17) + (size_t)layer * 512; W.cf_bb = inp(18) + (size_t)layer * 512;
    PHASE_IDS();
    const bf16* Z = (const bf16*)(ws + WS_Z);
    float* rstd = (float*)(ws + WS_RSTD);
    bf16* act_sc = (bf16*)(ws + WS_ACT) + (size_t)1 * SEQ * 512;
    bf16* act_cf = (bf16*)(ws + WS_ACT) + (size_t)3 * SEQ * 512;
    LAS float* ul = (LAS float*)F.lds;
    LAS float* part = (LAS float*)(F.lds + LDS_PART_OFF);
    asm volatile("" : "+v"(part));
    const int c = tid;
    for (int tile = obid(); tile < SEQ / 32; tile += F.G) {
        const int t0 = tile * 32;
#pragma unroll
        for (int i = 0; i < 4; ++i) { const int tok = t0 + 4 * wave + i;
            const v4u a = *(const GAS v4u*)(Z + (size_t)tok * ZC + ZC_CQ + 8 * lane);
            float s = bf_lo(a.x) * bf_lo(a.x) + bf_hi(a.x) * bf_hi(a.x) + bf_lo(a.y) * bf_lo(a.y) + bf_hi(a.y) * bf_hi(a.y) + bf_lo(a.z) * bf_lo(a.z) + bf_hi(a.z) * bf_hi(a.z) + bf_lo(a.w) * bf_lo(a.w) + bf_hi(a.w) * bf_hi(a.w);
            s = wave_sum(s);
            const unsigned long long b = *(const GAS unsigned long long*)(Z + (size_t)tok * ZC + ZC_CKV + 4 * lane);
            const unsigned b0 = (unsigned)b, b1 = (unsigned)(b >> 32);
            float s2 = bf_lo(b0) * bf_lo(b0) + bf_hi(b0) * bf_hi(b0) + bf_lo(b1) * bf_lo(b1) + bf_hi(b1) * bf_hi(b1);
            s2 = wave_sum(s2);
            float aq = fmaxf(fmaxf(fmaxf(fabsf(bf_lo(a.x)), fabsf(bf_hi(a.x))), fmaxf(fabsf(bf_lo(a.y)), fabsf(bf_hi(a.y)))), fmaxf(fmaxf(fabsf(bf_lo(a.z)), fabsf(bf_hi(a.z))), fmaxf(fabsf(bf_lo(a.w)), fabsf(bf_hi(a.w)))));
            float ak = fmaxf(fmaxf(fabsf(bf_lo(b0)), fabsf(bf_hi(b0))), fmaxf(fabsf(bf_lo(b1)), fabsf(bf_hi(b1))));
            aq = wave_max(aq); ak = wave_max(ak);
            const float iq = aq > 0.f ? 127.f / aq : 1.f, ik = ak > 0.f ? 127.f / ak : 1.f;
            { typedef unsigned v2u_ __attribute__((ext_vector_type(2))); unsigned char* qa = ws + WS_QA8 + (size_t)tok * 1024;
              *(GAS v2u_*)(qa + 8 * lane) = (v2u_){q4_i8(bf_lo(a.x) * iq, bf_hi(a.x) * iq, bf_lo(a.y) * iq, bf_hi(a.y) * iq), q4_i8(bf_lo(a.z) * iq, bf_hi(a.z) * iq, bf_lo(a.w) * iq, bf_hi(a.w) * iq)};
              *(GAS unsigned*)(qa + 512 + 4 * lane) = q4_i8(bf_lo(b0) * ik, bf_hi(b0) * ik, bf_lo(b1) * ik, bf_hi(b1) * ik); }
            if (lane == 0) { rstd[tok * 2] = (1.f / sqrtf(s * (1.f / 512.f) + NORM_EPS)) * (aq > 0.f ? aq * (1.f / 127.f) : 1.f); rstd[tok * 2 + 1] = (1.f / sqrtf(s2 * (1.f / 256.f) + NORM_EPS)) * (ak > 0.f ? ak * (1.f / 127.f) : 1.f); } }
        { const float w0 = W.sc_w[c], w1 = W.sc_w[512 + c], w2 = W.sc_w[1024 + c];
          bf16 vb[32], vc[34], vx[34];
#pragma unroll
          for (int t = 0; t < 34; ++t) { const int rw = t0 + t - 2; const bool ok = rw >= 0; const GAS bf16* q = (const GAS bf16*)(Z + (size_t)(ok ? rw : 0) * ZC);
            const bf16 cg_ = q[ZC_CG + c], xv_ = q[ZC_XV + c]; vc[t] = ok ? cg_ : (bf16)0; vx[t] = ok ? xv_ : (bf16)0; if (t >= 2) vb[t - 2] = q[ZC_BG + c]; }
          GAS bf16* op = (GAS bf16*)(act_sc + (size_t)t0 * 512 + c);
#pragma unroll
          for (int t = 0; t < 32; ++t) { const float y = w0 * (bf2f(vc[t]) * bf2f(vx[t])) + w1 * (bf2f(vc[t + 1]) * bf2f(vx[t + 1])) + w2 * (bf2f(vc[t + 2]) * bf2f(vx[t + 2]));
            *op = (bf16)f2bf(bf2f(vb[t]) * y); op += 512; asm volatile("" : "+v"(op)); } }
        float y[32];
        { float u[62];
          { bf16 va[62], vg[62];
#pragma unroll
            for (int r = 0; r < 62; ++r) { const int rw = t0 + r - 30; const bool ok = rw >= 0; const GAS bf16* q = (const GAS bf16*)(Z + (size_t)(ok ? rw : 0) * ZC);
              const bf16 a_ = q[ZC_CA + c], g_ = q[ZC_CGT + c]; va[r] = ok ? a_ : (bf16)0; vg[r] = ok ? g_ : (bf16)0; }
#pragma unroll
            for (int r = 0; r < 62; ++r) u[r] = bf2f(va[r]) * sigmoidf_(bf2f(vg[r])); }
          const float bias = W.cf_b[c];
#pragma unroll
          for (int t = 0; t < 32; ++t) y[t] = bias;
#pragma unroll
          for (int j = 0; j < 31; ++j) { const float wj = W.cf_w[j * 512 + c];
#pragma unroll
            for (int t = 0; t < 32; ++t) y[t] += wj * u[t + j]; } }
#pragma unroll
        for (int t = 0; t < 32; ++t) ul[t * 512 + c] = y[t];
        __syncthreads();
        { const int tt = tid >> 4, seg = tid & 15; float s_ = 0.f, q_ = 0.f;
#pragma unroll
          for (int k = 0; k < 8; ++k) { const f32x4 v4 = *(const LAS f32x4*)(ul + tt * 512 + 64 * k + 4 * seg); s_ += (v4.x + v4.y) + (v4.z + v4.w); q_ += (v4.x * v4.x + v4.y * v4.y) + (v4.z * v4.z + v4.w * v4.w); }
          s_ = row16_sum(s_); q_ = row16_sum(q_);
          const float mean = s_ * (1.f / 512.f); const float var = fmaxf(q_ * (1.f / 512.f) - mean * mean, 0.f);
          if (seg == 0) { part[2 * tt] = mean; part[2 * tt + 1] = __builtin_amdgcn_rsqf(var + LN_EPS); } }
        __syncthreads();
        { const float g = W.cf_g[c], bb = W.cf_bb[c]; GAS bf16* ocf = (GAS bf16*)(act_cf + (size_t)t0 * 512 + c);
#pragma unroll
          for (int t = 0; t < 32; ++t) { const float mean = part[2 * t], rs = part[2 * t + 1];
            const float v = (y[t] - mean) * rs * g + bb;
            *ocf = (bf16)f2bf(v * sigmoidf_(v)); ocf += 512; asm volatile("" : "+v"(ocf)); } }
        __syncthreads();
    }
}

typedef float f32x16 __attribute__((ext_vector_type(16)));
typedef short s16x4 __attribute__((ext_vector_type(4)));
typedef unsigned u32x2 __attribute__((ext_vector_type(2)));
__device__ __forceinline__ s16x4 vtr(const LAS unsigned char* p) { return __builtin_bit_cast(s16x4, __builtin_amdgcn_ds_read_tr16_b64_v4i16((LAS s16x4*)p)); }
__device__ __forceinline__ float amax3(float a, float b, float c) { float r; asm("v_max3_f32 %0, %1, %2, %3" : "=v"(r) : "v"(a), "v"(b), "v"(c)); return r; }
__device__ __forceinline__ float xhalf_max(float m) { auto rr = __builtin_amdgcn_permlane32_swap(__builtin_bit_cast(unsigned, m), __builtin_bit_cast(unsigned, m), false, false); return fmaxf(__builtin_bit_cast(float, rr[0]), __builtin_bit_cast(float, rr[1])); }
__device__ __forceinline__ float xhalf_sum(float m) { auto rr = __builtin_amdgcn_permlane32_swap(__builtin_bit_cast(unsigned, m), __builtin_bit_cast(unsigned, m), false, false); return __builtin_bit_cast(float, rr[0]) + __builtin_bit_cast(float, rr[1]); }

constexpr int ATT_KBUF = 64 * 208, ATT_VBUF = 64 * 320, ATT_STAGE = ATT_KBUF + ATT_VBUF;
template <int TYPE> __device__ __forceinline__ void attn_unit(Frame& F, int head, int qb) {
    constexpr int KS = TYPE == 0 ? 6 : 4, DT = TYPE == 0 ? 2 : 4, KP = TYPE == 0 ? 208 : 144, VP = TYPE == 0 ? 192 : 320;
    PHASE_IDS();
    const int r32 = lane & 31, hh = lane >> 5;
    const bf16* Z = (const bf16*)(ws + WS_Z); const bf16* QM = (const bf16*)(ws + WS_QM); const bf16* KVM = (const bf16*)(ws + WS_KVM);
    LAS unsigned char* lds = F.lds;
    const int row = qb * 256 + wave * 32 + r32;
    bf16x8 qf[KS];
    { const bf16* qp = TYPE == 0 ? QM + (size_t)row * QMC + head * 96 + 8 * hh : Z + (size_t)row * ZC + ZC_DQ + (head >> 1) * 128 + (head & 1) * 64 + 8 * hh;
#pragma unroll
      for (int ks = 0; ks < KS; ++ks) qf[ks] = *(const GAS bf16x8*)(qp + 16 * ks); }
    f32x16 o[DT];
#pragma unroll
    for (int d = 0; d < DT; ++d) o[d] = (f32x16){0.f, 0.f, 0.f, 0.f, 0.f, 0.f, 0.f, 0.f, 0.f, 0.f, 0.f, 0.f, 0.f, 0.f, 0.f, 0.f};
    float mrun = 0.f, lrun = 0.f;
    f32x16 negm = (f32x16){0.f, 0.f, 0.f, 0.f, 0.f, 0.f, 0.f, 0.f, 0.f, 0.f, 0.f, 0.f, 0.f, 0.f, 0.f, 0.f};
    const int NT = qb * 4 + 4, tmax = qb * 4 + (wave >> 1);
    v4u sa0 = (v4u){0u, 0u, 0u, 0u}, sa1 = sa0, sa2 = sa0, sb0 = sa0, sb1 = sa0, sb2 = sa0;
    const bf16 *g0, *g1, *g2; int l0, l1, l2; bool has1;
    if (TYPE == 0) {
        { const int key = tid / 12, ch = tid % 12; g0 = ch < 8 ? KVM + (size_t)key * KVC + head * 128 + 8 * ch : Z + (size_t)key * ZC + ZC_KR + 8 * (ch - 8); l0 = key * KP + ch * 16; }
        { const int cid = tid + 512, key = cid / 12, ch = cid % 12; has1 = tid < 256; const int keyc = has1 ? key : 0; g1 = ch < 8 ? KVM + (size_t)keyc * KVC + head * 128 + 8 * ch : Z + (size_t)keyc * ZC + ZC_KR + 8 * (ch - 8); l1 = keyc * KP + ch * 16; }
        { const int key = tid >> 3, ch = tid & 7; g2 = KVM + (size_t)key * KVC + head * 128 + 64 + 8 * ch; l2 = ATT_KBUF + key * VP + ch * 16; }
    } else {
        { const int key = tid >> 3, ch = tid & 7; g0 = Z + (size_t)key * ZC + ZC_DK + (head >> 1) * 128 + (head & 1) * 64 + 8 * ch; l0 = key * KP + ch * 16; }
        { const int key = tid >> 4, ch = tid & 15; g1 = Z + (size_t)key * ZC + ZC_DV + (head >> 1) * 128 + 8 * ch; l1 = ATT_KBUF + key * VP + ch * 16; has1 = true; }
        { const int cid = tid + 512, key = cid >> 4, ch = cid & 15; g2 = Z + (size_t)key * ZC + ZC_DV + (head >> 1) * 128 + 8 * ch; l2 = ATT_KBUF + key * VP + ch * 16; }
    }
    const size_t gstep0 = (size_t)64 * ((TYPE == 0 && (tid % 12) < 8) ? KVC : ZC);
    const size_t gstep1 = (size_t)64 * ((TYPE == 0 && ((tid + 512) % 12) < 8) ? KVC : ZC);
    const size_t gstep2 = (size_t)64 * (TYPE == 0 ? KVC : ZC);
#define ATT_LOAD(S, t) do { S##0 = *(const GAS v4u*)(g0 + (size_t)(t) * gstep0); if (has1) S##1 = *(const GAS v4u*)(g1 + (size_t)(t) * gstep1); S##2 = *(const GAS v4u*)(g2 + (size_t)(t) * gstep2); } while (0)
#define ATT_WRITE(S, buf) do { LAS unsigned char* b_ = lds + (buf) * ATT_STAGE; *(LAS v4u*)(b_ + l0) = S##0; if (has1) *(LAS v4u*)(b_ + l1) = S##1; *(LAS v4u*)(b_ + l2) = S##2; } while (0)
    const int koff = r32 * KP + hh * 16;
    const int voff = ATT_KBUF + (4 * hh + ((lane & 15) >> 2)) * VP + (16 * ((lane >> 4) & 1) + 4 * (lane & 3)) * 2;
    ATT_LOAD(sa, 0); ATT_WRITE(sa, 0); ATT_LOAD(sb, 1); __syncthreads();
    if (wave >= 4) __builtin_amdgcn_s_setprio(1);
    for (int t0 = 0; t0 < NT; t0 += 2) {
      { const int t = t0 + 0;
        if (t + 2 < NT) ATT_LOAD(sa, t + 2);
        if (t <= tmax) {
            const LAS unsigned char* kb_ = lds + (t & 1) * ATT_STAGE;
            f32x16 p0, p1; bf16x8 ka_[KS], kc_[KS];
#pragma unroll
            for (int ks = 0; ks < KS; ++ks) { ka_[ks] = *(const LAS bf16x8*)(kb_ + koff + ks * 32); kc_[ks] = *(const LAS bf16x8*)(kb_ + koff + 32 * KP + ks * 32); }
            __builtin_amdgcn_sched_barrier(0);
#pragma unroll
            for (int ks = 0; ks < KS; ++ks) {
                if (ks == 0) { p0 = __builtin_amdgcn_mfma_f32_32x32x16_bf16(ka_[0], qf[0], negm, 0, 0, 0); p1 = __builtin_amdgcn_mfma_f32_32x32x16_bf16(kc_[0], qf[0], negm, 0, 0, 0); }
                else { p0 = __builtin_amdgcn_mfma_f32_32x32x16_bf16(ka_[ks], qf[ks], p0, 0, 0, 0); p1 = __builtin_amdgcn_mfma_f32_32x32x16_bf16(kc_[ks], qf[ks], p1, 0, 0, 0); }
            }
            s16x4 vlo_[2][DT], vhi_[2][DT];
#pragma unroll
            for (int d = 0; d < DT; ++d) { vlo_[0][d] = vtr(kb_ + voff + d * 64); vhi_[0][d] = vtr(kb_ + voff + 8 * VP + d * 64); }
            __builtin_amdgcn_sched_barrier(0);
            asm volatile("s_nop 15\n\ts_nop 7" : "+v"(p0), "+v"(p1));
            float mt;
            { float ma = amax3(p0[0], p0[1], p1[0]), mb = amax3(p0[2], p0[3], p1[1]); ma = amax3(ma, p1[2], p1[3]);
#pragma unroll
              for (int r = 4; r < 16; r += 4) { ma = amax3(ma, p0[r], p0[r + 1]); mb = amax3(mb, p0[r + 2], p0[r + 3]); ma = amax3(ma, p1[r], p1[r + 1]); mb = amax3(mb, p1[r + 2], p1[r + 3]); }
              mt = xhalf_max(amax3(ma, mb, mb)); }
            if (__any(t == 0 || mt > 4.0f)) {
                const float dl = t == 0 ? mt : fmaxf(mt, 0.f); mrun += dl;
                const float alpha = __builtin_amdgcn_exp2f(-dl); lrun *= alpha;
#pragma unroll
                for (int d = 0; d < DT; ++d) o[d] = o[d] * alpha;
#pragma unroll
                for (int r = 0; r < 16; ++r) { p0[r] -= dl; p1[r] -= dl; negm[r] = -mrun; }
            }
            float ls = 0.f;
#pragma unroll
            for (int s2 = 0; s2 < 4; ++s2) {
                if (s2 < 3) {
#pragma unroll
                    for (int d = 0; d < DT; ++d) { vlo_[(s2 + 1) & 1][d] = vtr(kb_ + voff + (16 * (s2 + 1)) * VP + d * 64); vhi_[(s2 + 1) & 1][d] = vtr(kb_ + voff + (16 * (s2 + 1) + 8) * VP + d * 64); } }
                f32x16& pp = s2 < 2 ? p0 : p1; const int b8 = 8 * (s2 & 1);
                float e_[8];
#pragma unroll
                for (int r = 0; r < 8; ++r) { e_[r] = __builtin_amdgcn_exp2f(pp[b8 + r]); ls += e_[r]; }
                v4u w_; w_.x = pg8::cvt_pk_bf16(e_[0], e_[1]); w_.y = pg8::cvt_pk_bf16(e_[2], e_[3]); w_.z = pg8::cvt_pk_bf16(e_[4], e_[5]); w_.w = pg8::cvt_pk_bf16(e_[6], e_[7]);
                const bf16x8 pf_ = __builtin_bit_cast(bf16x8, w_);
#pragma unroll
                for (int d = 0; d < DT; ++d) { const bf16x8 vf = (bf16x8){vlo_[s2 & 1][d][0], vlo_[s2 & 1][d][1], vlo_[s2 & 1][d][2], vlo_[s2 & 1][d][3], vhi_[s2 & 1][d][0], vhi_[s2 & 1][d][1], vhi_[s2 & 1][d][2], vhi_[s2 & 1][d][3]};
                    o[d] = __builtin_amdgcn_mfma_f32_32x32x16_bf16(vf, pf_, o[d], 0, 0, 0); }
                __builtin_amdgcn_sched_barrier(0);
            }
            lrun += ls;
        }
        if (t + 1 < NT) ATT_WRITE(sb, (t + 1) & 1);
        __syncthreads();
      }
      { const int t = t0 + 1;
        if (t + 2 < NT) ATT_LOAD(sb, t + 2);
        if (t <= tmax) {
            const LAS unsigned char* kb_ = lds + (t & 1) * ATT_STAGE;
            f32x16 p0, p1; bf16x8 ka_[KS], kc_[KS];
#pragma unroll
            for (int ks = 0; ks < KS; ++ks) { ka_[ks] = *(const LAS bf16x8*)(kb_ + koff + ks * 32); kc_[ks] = *(const LAS bf16x8*)(kb_ + koff + 32 * KP + ks * 32); }
            __builtin_amdgcn_sched_barrier(0);
#pragma unroll
            for (int ks = 0; ks < KS; ++ks) {
                if (ks == 0) { p0 = __builtin_amdgcn_mfma_f32_32x32x16_bf16(ka_[0], qf[0], negm, 0, 0, 0); p1 = __builtin_amdgcn_mfma_f32_32x32x16_bf16(kc_[0], qf[0], negm, 0, 0, 0); }
                else { p0 = __builtin_amdgcn_mfma_f32_32x32x16_bf16(ka_[ks], qf[ks], p0, 0, 0, 0); p1 = __builtin_amdgcn_mfma_f32_32x32x16_bf16(kc_[ks], qf[ks], p1, 0, 0, 0); }
            }
            s16x4 vlo_[2][DT], vhi_[2][DT];
#pragma unroll
            for (int d = 0; d < DT; ++d) { vlo_[0][d] = vtr(kb_ + voff + d * 64); vhi_[0][d] = vtr(kb_ + voff + 8 * VP + d * 64); }
            __builtin_amdgcn_sched_barrier(0);
            asm volatile("s_nop 15\n\ts_nop 7" : "+v"(p0), "+v"(p1));
            float mt;
            { float ma = amax3(p0[0], p0[1], p1[0]), mb = amax3(p0[2], p0[3], p1[1]); ma = amax3(ma, p1[2], p1[3]);
#pragma unroll
              for (int r = 4; r < 16; r += 4) { ma = amax3(ma, p0[r], p0[r + 1]); mb = amax3(mb, p0[r + 2], p0[r + 3]); ma = amax3(ma, p1[r], p1[r + 1]); mb = amax3(mb, p1[r + 2], p1[r + 3]); }
              mt = xhalf_max(amax3(ma, mb, mb)); }
            if (__any(t == 0 || mt > 4.0f)) {
                const float dl = t == 0 ? mt : fmaxf(mt, 0.f); mrun += dl;
                const float alpha = __builtin_amdgcn_exp2f(-dl); lrun *= alpha;
#pragma unroll
                for (int d = 0; d < DT; ++d) o[d] = o[d] * alpha;
#pragma unroll
                for (int r = 0; r < 16; ++r) { p0[r] -= dl; p1[r] -= dl; negm[r] = -mrun; }
            }
            float ls = 0.f;
#pragma unroll
            for (int s2 = 0; s2 < 4; ++s2) {
                if (s2 < 3) {
#pragma unroll
                    for (int d = 0; d < DT; ++d) { vlo_[(s2 + 1) & 1][d] = vtr(kb_ + voff + (16 * (s2 + 1)) * VP + d * 64); vhi_[(s2 + 1) & 1][d] = vtr(kb_ + voff + (16 * (s2 + 1) + 8) * VP + d * 64); } }
                f32x16& pp = s2 < 2 ? p0 : p1; const int b8 = 8 * (s2 & 1);
                float e_[8];
#pragma unroll
                for (int r = 0; r < 8; ++r) { e_[r] = __builtin_amdgcn_exp2f(pp[b8 + r]); ls += e_[r]; }
                v4u w_; w_.x = pg8::cvt_pk_bf16(e_[0], e_[1]); w_.y = pg8::cvt_pk_bf16(e_[2], e_[3]); w_.z = pg8::cvt_pk_bf16(e_[4], e_[5]); w_.w = pg8::cvt_pk_bf16(e_[6], e_[7]);
                const bf16x8 pf_ = __builtin_bit_cast(bf16x8, w_);
#pragma unroll
                for (int d = 0; d < DT; ++d) { const bf16x8 vf = (bf16x8){vlo_[s2 & 1][d][0], vlo_[s2 & 1][d][1], vlo_[s2 & 1][d][2], vlo_[s2 & 1][d][3], vhi_[s2 & 1][d][0], vhi_[s2 & 1][d][1], vhi_[s2 & 1][d][2], vhi_[s2 & 1][d][3]};
                    o[d] = __builtin_amdgcn_mfma_f32_32x32x16_bf16(vf, pf_, o[d], 0, 0, 0); }
                __builtin_amdgcn_sched_barrier(0);
            }
            lrun += ls;
        }
        if (t + 1 < NT) ATT_WRITE(sa, (t + 1) & 1);
        __syncthreads();
      }
    }
#undef ATT_LOAD
#undef ATT_WRITE
    __builtin_amdgcn_s_setprio(0);
    const float inv = 1.f / xhalf_sum(lrun);
    bf16* outp = TYPE == 0 ? (bf16*)(ws + WS_ACT) + (size_t)row * 512 + head * 64 : (bf16*)(ws + WS_DO) + (size_t)(head & 1) * SEQ * 512 + (size_t)row * 512 + (head >> 1) * 128;
#pragma unroll
    for (int d = 0; d < DT; ++d)
#pragma unroll
        for (int g = 0; g < 4; ++g) { u32x2 w; w.x = pg8::cvt_pk_bf16(o[d][4 * g] * inv, o[d][4 * g + 1] * inv); w.y = pg8::cvt_pk_bf16(o[d][4 * g + 2] * inv, o[d][4 * g + 3] * inv);
            *(GAS u32x2*)(outp + 32 * d + 8 * g + 4 * hh) = w; }
}
constexpr int ATT_NCONV = 32;
__device__ __forceinline__ void p4_attention(Frame& F, int layer) {
    const int tid = otid(F.wv);
    gu32* head_w = F.ctl + CW_QATT + 64 * layer;
    const bool conv_first = obid() < ATT_NCONV;
    if (conv_first) tables_dyn(F, layer >> 1);
    for (;;) {
        __syncthreads();
        if (tid == 0) F.MISC[0] = __hip_atomic_fetch_add(head_w, 1u, RLX_AGENT);
        __syncthreads();
        const unsigned u = F.MISC[0];
        if (u >= 512u) break;
        const int qb = 31 - (int)(u >> 4), r = (int)(u & 15);
        if (r < 8) attn_unit<1>(F, r, qb); else attn_unit<0>(F, r - 8, qb);
    }
    if (!conv_first) tables_dyn(F, layer >> 1);
}


#ifndef MK_CHECK
#define MK_CHECK 0
#endif
constexpr int CW_CHK = 20480;
#if MK_CHECK
__device__ __forceinline__ void mla_check(Frame& F, int layer) {
    PHASE_IDS();
    const int b = obid();
    const bf16* Z = (const bf16*)(ws + WS_Z);
    const int* positions = (const int*)inp(1);
    LAS float* L = (LAS float*)F.lds;
    if (b < 16) {
        const int i = (b * 523 + 100 + layer * 37) % SEQ, h = b % 8, lim = (i / 64 + 1) * 64;
        const float* w_uq = inp(6) + (size_t)layer * 512 * 768; const float* g_q = inp(5) + (size_t)layer * 512;
        const float* w_ukv = inp(8) + (size_t)layer * 256 * 1024; const float* g_kv = inp(7) + (size_t)layer * 256;
        LAS float* qn = L; LAS float* q = L + 512; LAS float* qk = L + 640; LAS float* red = L + 1024; LAS float* pk = L + 2048; LAS float* sc = L + 4096; LAS float* rs = L + 4096 + 8192;
        { float v = bf2f(Z[(size_t)i * ZC + ZC_CQ + tid]); red[tid] = v * v; __syncthreads();
          for (int o = 256; o > 0; o >>= 1) { if (tid < o) red[tid] += red[tid + o]; __syncthreads(); }
          const float rstd = 1.f / sqrtf(red[0] / 512.f + NORM_EPS); __syncthreads();
          qn[tid] = v * rstd * g_q[tid]; __syncthreads(); }
        if (tid < 96) { float a = 0.f; for (int k = 0; k < 512; ++k) a += qn[k] * w_uq[(size_t)k * 768 + h * 96 + tid]; q[tid] = a; }
        __syncthreads();
        if (tid < 16) { const float pos = (float)positions[i]; const float inv = exp2f(-(float)tid * (1.f / 16.f) * 18.931568569324174f); const float ang = pos * inv; double rev = (double)ang * 0.15915494309189535; rev -= floor(rev); const float c = __builtin_amdgcn_cosf((float)rev), sn = __builtin_amdgcn_sinf((float)rev);
            const float x1 = q[64 + tid], x2 = q[80 + tid]; q[64 + tid] = x1 * c - x2 * sn; q[80 + tid] = x2 * c + x1 * sn; }
        __syncthreads();
        if (tid < 256) { float a = 0.f; for (int d = 0; d < 64; ++d) a += q[d] * w_ukv[(size_t)tid * 1024 + h * 128 + d]; qk[tid] = a; }
        __syncthreads();
        float mx = -3e38f;
        for (int j = tid; j < lim; j += NTHREADS) {
            float ss = 0.f, dn = 0.f;
            for (int k = 0; k < 256; ++k) { const float v = bf2f(Z[(size_t)j * ZC + ZC_CKV + k]); ss += v * v; dn += v * g_kv[k] * qk[k]; }
            const float rstd = 1.f / sqrtf(ss / 256.f + NORM_EPS);
            float dr = 0.f;
            for (int p = 0; p < 16; ++p) dr += q[64 + p] * bf2f(Z[(size_t)j * ZC + ZC_KR + 2 * p]) + q[80 + p] * bf2f(Z[(size_t)j * ZC + ZC_KR + 2 * p + 1]);
            const float s_ = (dn * rstd + dr) * 0.10206207261596577f;
            sc[j] = s_; rs[j] = rstd; mx = fmaxf(mx, s_);
        }
        red[tid] = mx; __syncthreads();
        for (int o = 256; o > 0; o >>= 1) { if (tid < o) red[tid] = fmaxf(red[tid], red[tid + o]); __syncthreads(); }
        mx = red[0]; __syncthreads();
        float sm = 0.f;
        for (int j = tid; j < lim; j += NTHREADS) { const float p = expf(sc[j] - mx); sc[j] = p; sm += p; }
        red[tid] = sm; __syncthreads();
        for (int o = 256; o > 0; o >>= 1) { if (tid < o) red[tid] += red[tid + o]; __syncthreads(); }
        sm = red[0]; __syncthreads();
        { const int k = tid & 255, half = tid >> 8; float a = 0.f;
          for (int j = half; j < lim; j += 2) a += sc[j] * rs[j] * bf2f(Z[(size_t)j * ZC + ZC_CKV + k]);
          pk[tid] = a * g_kv[k]; }
        __syncthreads();
        if (tid < 64) { float a = 0.f; for (int k = 0; k < 256; ++k) a += (pk[k] + pk[256 + k]) * w_ukv[(size_t)k * 1024 + h * 128 + 64 + tid];
            a /= sm; const float got = bf2f(((const bf16*)(ws + WS_ACT))[(size_t)i * 512 + h * 64 + tid]);
            red[tid] = fabsf(a - got); red[64 + tid] = fabsf(a); }
        __syncthreads();
        if (tid == 0) { float e = 0.f, m = 0.f; for (int d = 0; d < 64; ++d) { e = fmaxf(e, red[d]); m = fmaxf(m, red[64 + d]); }
            if (!(e <= 0.15f * m + 1e-5f)) __hip_atomic_fetch_or(F.ctl + CW_CHK, 1u << (b & 15), RLX_AGENT); }
        __syncthreads();
    } else if (b < 32) {
        const int j = ((b - 16) * 331 + 17 + layer * 5) % SEQ; const float* w_in = inp(3) + (size_t)layer * 2048 * INC; const bf16* H = (const bf16*)(ws + WS_H);
        if (tid < 32) { float a = 0.f; for (int k = 0; k < 2048; ++k) a += bf2f(H[(size_t)j * 2048 + k]) * w_in[(size_t)k * INC + 768 + tid]; L[tid] = a; }
        __syncthreads();
        if (tid < 16) { const float pos = (float)positions[j]; const float inv = exp2f(-(float)tid * (1.f / 16.f) * 18.931568569324174f); const float ang = pos * inv; double rev = (double)ang * 0.15915494309189535; rev -= floor(rev); const float c = __builtin_amdgcn_cosf((float)rev), sn = __builtin_amdgcn_sinf((float)rev);
            const float x1 = L[tid], x2 = L[16 + tid]; const float r1 = x1 * c - x2 * sn, r2 = x2 * c + x1 * sn;
            const float g1 = bf2f(Z[(size_t)j * ZC + ZC_KR + 2 * tid]), g2 = bf2f(Z[(size_t)j * ZC + ZC_KR + 2 * tid + 1]);
            if (!(fabsf(r1 - g1) <= 0.05f * fmaxf(1.f, fabsf(r1))) || !(fabsf(r2 - g2) <= 0.05f * fmaxf(1.f, fabsf(r2)))) __hip_atomic_fetch_or(F.ctl + CW_CHK, 1u << 16, RLX_AGENT); }
        __syncthreads();
    }
}
#endif

__device__ __forceinline__ void p5_diff_combine(Frame& F, int layer) {
    LayerW W; W.lam = inp(12) + (size_t)layer * 256; W.diff_g = inp(13) + (size_t)layer * 128;
    PHASE_IDS();
    const int gw = obid() * NWAVES + wave, NGW = F.G * NWAVES;
    const float lam_init = 0.8f - 0.6f * expf(-0.3f * (float)layer);
    const float d1 = wave_sum(W.lam[lane] * W.lam[64 + lane]), d2 = wave_sum(W.lam[128 + lane] * W.lam[192 + lane]);
    const float lam = expf(d1) - expf(d2) + lam_init;
    const bf16* O1 = (const bf16*)(ws + WS_DO); const bf16* O2 = O1 + (size_t)SEQ * 512;
    bf16* act = (bf16*)(ws + WS_ACT) + (size_t)2 * SEQ * 512;
    const int dcol = (lane & 15) * 8;
    const f32x4 g0 = *(const f32x4*)(W.diff_g + dcol), g1 = *(const f32x4*)(W.diff_g + dcol + 4);
    for (int tok = gw; tok < SEQ; tok += NGW) {
        const v4u a = *(const GAS v4u*)(O1 + (size_t)tok * 512 + lane * 8), b = *(const GAS v4u*)(O2 + (size_t)tok * 512 + lane * 8);
        float v[8] = {bf_lo(a.x) - lam * bf_lo(b.x), bf_hi(a.x) - lam * bf_hi(b.x), bf_lo(a.y) - lam * bf_lo(b.y), bf_hi(a.y) - lam * bf_hi(b.y),
                      bf_lo(a.z) - lam * bf_lo(b.z), bf_hi(a.z) - lam * bf_hi(b.z), bf_lo(a.w) - lam * bf_lo(b.w), bf_hi(a.w) - lam * bf_hi(b.w)};
        float s = 0.f;
#pragma unroll
        for (int i = 0; i < 8; ++i) s += v[i] * v[i];
        s = row16_sum(s);
        const float sc = (1.f / sqrtf(s * (1.f / 128.f) + NORM_EPS)) * (1.f - lam_init);
        float f2[8] = {v[0] * sc * g0[0], v[1] * sc * g0[1], v[2] * sc * g0[2], v[3] * sc * g0[3], v[4] * sc * g1[0], v[5] * sc * g1[1], v[6] * sc * g1[2], v[7] * sc * g1[3]};
        q512_store(f2, ws + WS_ACT8 + ((size_t)2 * SEQ + tok) * 512, (float*)(ws + WS_SACT8) + 2 * SEQ + tok, lane);
#pragma unroll
        for (int br = 0; br < 4; ++br) if (br != 2) row512_bf16_to_i8((const bf16*)(ws + WS_ACT) + ((size_t)br * SEQ + tok) * 512, ws + WS_ACT8 + ((size_t)br * SEQ + tok) * 512, (float*)(ws + WS_SACT8) + br * SEQ + tok, lane);
    }
}

__device__ __forceinline__ void p8_ffn_norm(Frame& F, int layer) {
    LayerW W; W.ffn_g = inp(21) + (size_t)layer * 2048;
    PHASE_IDS();
    const int gw = obid() * NWAVES + wave, NGW = F.G * NWAVES;
    const float* xa = (const float*)(ws + WS_XA);
    for (int m = gw; m < SEQ; m += NGW) {
        const GAS f32x4* xr = (const GAS f32x4*)(xa + (size_t)m * DMODEL) + lane; const GAS f32x4* gr = (const GAS f32x4*)W.ffn_g + lane;
        f32x4 v[8]; float s = 0.f;
#pragma unroll
        for (int j = 0; j < 8; ++j) { v[j] = xr[64 * j]; s += (v[j].x * v[j].x + v[j].y * v[j].y) + (v[j].z * v[j].z + v[j].w * v[j].w); }
        const float rstd = 1.f / sqrtf(wave_sum(s) * (1.f / DMODEL) + NORM_EPS);
        float am = 0.f;
#pragma unroll
        for (int j = 0; j < 8; ++j) { const f32x4 gg = gr[64 * j]; v[j].x *= rstd * gg.x; v[j].y *= rstd * gg.y; v[j].z *= rstd * gg.z; v[j].w *= rstd * gg.w;
            am = fmaxf(fmaxf(am, fabsf(v[j].x)), fabsf(v[j].y)); am = fmaxf(fmaxf(am, fabsf(v[j].z)), fabsf(v[j].w));
 }
        am = wave_max(am);
        const float hsc = am > 0.f ? 224.f * __builtin_amdgcn_rcpf(am) : 1.f;
        GAS unsigned* o4 = (GAS unsigned*)(ws + WS_H2F8 + (size_t)m * DMODEL) + lane;
#pragma unroll
        for (int j = 0; j < 8; ++j) { int p_ = __builtin_amdgcn_cvt_pk_fp8_f32(v[j].x * hsc, v[j].y * hsc, 0, false); p_ = __builtin_amdgcn_cvt_pk_fp8_f32(v[j].z * hsc, v[j].w * hsc, p_, true); o4[64 * j] = (unsigned)p_; }
        { const float isc = am > 0.f ? 127.f / am : 1.f; GAS unsigned* o1 = (GAS unsigned*)(ws + WS_H2I8 + (size_t)m * DMODEL) + lane;
#pragma unroll
          for (int j = 0; j < 8; ++j) o1[64 * j] = q4_i8(v[j].x * isc, v[j].y * isc, v[j].z * isc, v[j].w * isc); }
        if (lane == 0) ((GAS float*)(ws + WS_HSCI))[m] = am > 0.f ? am * (1.f / 224.f) : 1.f;
    }
}

#define CEI(a, b) do { const int mx_ = (a) > (b) ? (a) : (b), mn_ = (a) > (b) ? (b) : (a); (a) = mx_; (b) = mn_; } while (0)
#define SORT16(v, b) do { CEI(v[(b)+0], v[(b)+1]); CEI(v[(b)+3], v[(b)+2]); CEI(v[(b)+4], v[(b)+5]); CEI(v[(b)+7], v[(b)+6]); CEI(v[(b)+8], v[(b)+9]); CEI(v[(b)+11], v[(b)+10]); CEI(v[(b)+12], v[(b)+13]); CEI(v[(b)+15], v[(b)+14]); CEI(v[(b)+0], v[(b)+2]); CEI(v[(b)+1], v[(b)+3]); CEI(v[(b)+6], v[(b)+4]); CEI(v[(b)+7], v[(b)+5]); CEI(v[(b)+8], v[(b)+10]); CEI(v[(b)+9], v[(b)+11]); CEI(v[(b)+14], v[(b)+12]); CEI(v[(b)+15], v[(b)+13]); CEI(v[(b)+0], v[(b)+1]); CEI(v[(b)+2], v[(b)+3]); CEI(v[(b)+5], v[(b)+4]); CEI(v[(b)+7], v[(b)+6]); CEI(v[(b)+8], v[(b)+9]); CEI(v[(b)+10], v[(b)+11]); CEI(v[(b)+13], v[(b)+12]); CEI(v[(b)+15], v[(b)+14]); CEI(v[(b)+0], v[(b)+4]); CEI(v[(b)+1], v[(b)+5]); CEI(v[(b)+2], v[(b)+6]); CEI(v[(b)+3], v[(b)+7]); CEI(v[(b)+12], v[(b)+8]); CEI(v[(b)+13], v[(b)+9]); CEI(v[(b)+14], v[(b)+10]); CEI(v[(b)+15], v[(b)+11]); CEI(v[(b)+0], v[(b)+2]); CEI(v[(b)+1], v[(b)+3]); CEI(v[(b)+4], v[(b)+6]); CEI(v[(b)+5], v[(b)+7]); CEI(v[(b)+10], v[(b)+8]); CEI(v[(b)+11], v[(b)+9]); CEI(v[(b)+14], v[(b)+12]); CEI(v[(b)+15], v[(b)+13]); CEI(v[(b)+0], v[(b)+1]); CEI(v[(b)+2], v[(b)+3]); CEI(v[(b)+4], v[(b)+5]); CEI(v[(b)+6], v[(b)+7]); CEI(v[(b)+9], v[(b)+8]); CEI(v[(b)+11], v[(b)+10]); CEI(v[(b)+13], v[(b)+12]); CEI(v[(b)+15], v[(b)+14]); CEI(v[(b)+0], v[(b)+8]); CEI(v[(b)+1], v[(b)+9]); CEI(v[(b)+2], v[(b)+10]); CEI(v[(b)+3], v[(b)+11]); CEI(v[(b)+4], v[(b)+12]); CEI(v[(b)+5], v[(b)+13]); CEI(v[(b)+6], v[(b)+14]); CEI(v[(b)+7], v[(b)+15]); CEI(v[(b)+0], v[(b)+4]); CEI(v[(b)+1], v[(b)+5]); CEI(v[(b)+2], v[(b)+6]); CEI(v[(b)+3], v[(b)+7]); CEI(v[(b)+8], v[(b)+12]); CEI(v[(b)+9], v[(b)+13]); CEI(v[(b)+10], v[(b)+14]); CEI(v[(b)+11], v[(b)+15]); CEI(v[(b)+0], v[(b)+2]); CEI(v[(b)+1], v[(b)+3]); CEI(v[(b)+4], v[(b)+6]); CEI(v[(b)+5], v[(b)+7]); CEI(v[(b)+8], v[(b)+10]); CEI(v[(b)+9], v[(b)+11]); CEI(v[(b)+12], v[(b)+14]); CEI(v[(b)+13], v[(b)+15]); CEI(v[(b)+0], v[(b)+1]); CEI(v[(b)+2], v[(b)+3]); CEI(v[(b)+4], v[(b)+5]); CEI(v[(b)+6], v[(b)+7]); CEI(v[(b)+8], v[(b)+9]); CEI(v[(b)+10], v[(b)+11]); CEI(v[(b)+12], v[(b)+13]); CEI(v[(b)+14], v[(b)+15]); } while (0)
#define MERGE16(v, b) do { CEI(v[(b)+0], v[(b)+8]); CEI(v[(b)+1], v[(b)+9]); CEI(v[(b)+2], v[(b)+10]); CEI(v[(b)+3], v[(b)+11]); CEI(v[(b)+4], v[(b)+12]); CEI(v[(b)+5], v[(b)+13]); CEI(v[(b)+6], v[(b)+14]); CEI(v[(b)+7], v[(b)+15]); CEI(v[(b)+0], v[(b)+4]); CEI(v[(b)+1], v[(b)+5]); CEI(v[(b)+2], v[(b)+6]); CEI(v[(b)+3], v[(b)+7]); CEI(v[(b)+8], v[(b)+12]); CEI(v[(b)+9], v[(b)+13]); CEI(v[(b)+10], v[(b)+14]); CEI(v[(b)+11], v[(b)+15]); CEI(v[(b)+0], v[(b)+2]); CEI(v[(b)+1], v[(b)+3]); CEI(v[(b)+4], v[(b)+6]); CEI(v[(b)+5], v[(b)+7]); CEI(v[(b)+8], v[(b)+10]); CEI(v[(b)+9], v[(b)+11]); CEI(v[(b)+12], v[(b)+14]); CEI(v[(b)+13], v[(b)+15]); CEI(v[(b)+0], v[(b)+1]); CEI(v[(b)+2], v[(b)+3]); CEI(v[(b)+4], v[(b)+5]); CEI(v[(b)+6], v[(b)+7]); CEI(v[(b)+8], v[(b)+9]); CEI(v[(b)+10], v[(b)+11]); CEI(v[(b)+12], v[(b)+13]); CEI(v[(b)+14], v[(b)+15]); } while (0)

__device__ __forceinline__ int skey(float f) { const int b_ = __builtin_bit_cast(int, f); return b_ ^ ((b_ >> 31) & 0x7fffffff); }
__device__ __forceinline__ float unskey(int k) { const int b_ = k ^ ((k >> 31) & 0x7fffffff); return __builtin_bit_cast(float, b_); }
__device__ __forceinline__ int xpartner(int x, int hh) { auto rr = __builtin_amdgcn_permlane32_swap((unsigned)x, (unsigned)x, false, false); return (int)(hh ? rr[0] : rr[1]); }
__device__ __forceinline__ void split_bf16(const f32x4 a, const f32x4 b, bf16x8& hi, bf16x8& lo) {
    v4u h; h.x = pg8::cvt_pk_bf16(a[0], a[1]); h.y = pg8::cvt_pk_bf16(a[2], a[3]); h.z = pg8::cvt_pk_bf16(b[0], b[1]); h.w = pg8::cvt_pk_bf16(b[2], b[3]);
    v4u l; l.x = pg8::cvt_pk_bf16(a[0] - bf_lo(h.x), a[1] - bf_hi(h.x)); l.y = pg8::cvt_pk_bf16(a[2] - bf_lo(h.y), a[3] - bf_hi(h.y)); l.z = pg8::cvt_pk_bf16(b[0] - bf_lo(h.z), b[1] - bf_hi(h.z)); l.w = pg8::cvt_pk_bf16(b[2] - bf_lo(h.w), b[3] - bf_hi(h.w));
    hi = __builtin_bit_cast(bf16x8, h); lo = __builtin_bit_cast(bf16x8, l);
}
__device__ __forceinline__ void peer_top16(const bf16* ktab, const float* qrow, int r32, int hh, int (&v)[64]) {
    bf16x8 qb[4];
#pragma unroll
    for (int ks = 0; ks < 4; ++ks) { const f32x4 a = *(const GAS f32x4*)(qrow + 16 * ks + 8 * hh), b = *(const GAS f32x4*)(qrow + 16 * ks + 8 * hh + 4);
        v4u h; h.x = pg8::cvt_pk_bf16(a[0], a[1]); h.y = pg8::cvt_pk_bf16(a[2], a[3]); h.z = pg8::cvt_pk_bf16(b[0], b[1]); h.w = pg8::cvt_pk_bf16(b[2], b[3]); qb[ks] = __builtin_bit_cast(bf16x8, h); }
#pragma unroll
    for (int kt = 0; kt < 4; ++kt) {
        f32x16 acc = (f32x16){0.f, 0.f, 0.f, 0.f, 0.f, 0.f, 0.f, 0.f, 0.f, 0.f, 0.f, 0.f, 0.f, 0.f, 0.f, 0.f};
#pragma unroll
        for (int ks = 0; ks < 4; ++ks) { const bf16x8 kh = *(const GAS bf16x8*)(ktab + (size_t)(32 * kt + r32) * 64 + 16 * ks + 8 * hh);
            acc = __builtin_amdgcn_mfma_f32_32x32x16_bf16(kh, qb[ks], acc, 0, 0, 0); }
#pragma unroll
        for (int r = 0; r < 16; ++r) v[16 * kt + r] = (skey(acc[r]) & ~127) | (32 * kt + (r & 3) + 8 * (r >> 2) + 4 * hh);
    }
    SORT16(v, 0); SORT16(v, 16); SORT16(v, 32); SORT16(v, 48);
#pragma unroll
    for (int i = 0; i < 16; ++i) { v[i] = v[i] > v[31 - i] ? v[i] : v[31 - i]; v[32 + i] = v[32 + i] > v[63 - i] ? v[32 + i] : v[63 - i]; }
    MERGE16(v, 0); MERGE16(v, 32);
#pragma unroll
    for (int i = 0; i < 16; ++i) v[i] = v[i] > v[47 - i] ? v[i] : v[47 - i];
    MERGE16(v, 0);
    int pb[16];
#pragma unroll
    for (int i = 0; i < 16; ++i) pb[i] = xpartner(v[i], hh);
#pragma unroll
    for (int i = 0; i < 16; ++i) v[i] = v[i] > pb[15 - i] ? v[i] : pb[15 - i];
    MERGE16(v, 0);
}
__device__ __forceinline__ void p10_route(Frame& F, int layer) {
    const bf16* subk = (const bf16*)(F.ws_base + WS_SUBK); (void)layer;
    PHASE_IDS();
    const int r32 = lane & 31, hh = lane >> 5;
    const int gw = obid() * NWAVES + wave, NGW = F.G * NWAVES;
    const float* pq = (const float*)(ws + WS_PQ);
    int* idx_o = (int*)(ws + WS_IDX); float* gate_o = (float*)(ws + WS_GATE);
    LAS unsigned char* tab = F.lds + wave * 1024 + r32 * 32;
    for (int it = gw; it < (SEQ / 32) * 8; it += NGW) {
        const int tile = it >> 3, hd = it & 7, tok = tile * 32 + r32;
        const float* qrow = pq + (size_t)tok * 1024 + hd * 128;
        int t1[16], t2[16];
        { int v[64]; peer_top16(subk, qrow, r32, hh, v);
#pragma unroll
          for (int i = 0; i < 16; ++i) t1[i] = v[i]; }
        { int v[64]; peer_top16(subk + 128 * 64, qrow + 64, r32, hh, v);
#pragma unroll
          for (int i = 0; i < 16; ++i) t2[i] = v[i]; }
        if (hh == 0) {
#pragma unroll
            for (int q = 0; q < 4; ++q) { ((LAS unsigned*)tab)[q] = (unsigned)(t1[4 * q] & 127) | ((unsigned)(t1[4 * q + 1] & 127) << 8) | ((unsigned)(t1[4 * q + 2] & 127) << 16) | ((unsigned)(t1[4 * q + 3] & 127) << 24);
                ((LAS unsigned*)tab)[4 + q] = (unsigned)(t2[4 * q] & 127) | ((unsigned)(t2[4 * q + 1] & 127) << 8) | ((unsigned)(t2[4 * q + 2] & 127) << 16) | ((unsigned)(t2[4 * q + 3] & 127) << 24); }
        }
        float f1[16], f2[16];
#pragma unroll
        for (int i = 0; i < 16; ++i) { f1[i] = unskey(t1[i] & ~127); f2[i] = unskey(t2[i] & ~127); }
        int c50[50];
        c50[0] = (skey(f1[0] + f2[0]) & ~255) | 0;
        c50[1] = (skey(f1[0] + f2[1]) & ~255) | 1;
        c50[2] = (skey(f1[0] + f2[2]) & ~255) | 2;
        c50[3] = (skey(f1[0] + f2[3]) & ~255) | 3;
        c50[4] = (skey(f1[0] + f2[4]) & ~255) | 4;
        c50[5] = (skey(f1[0] + f2[5]) & ~255) | 5;
        c50[6] = (skey(f1[0] + f2[6]) & ~255) | 6;
        c50[7] = (skey(f1[0] + f2[7]) & ~255) | 7;
        c50[8] = (skey(f1[0] + f2[8]) & ~255) | 8;
        c50[9] = (skey(f1[0] + f2[9]) & ~255) | 9;
        c50[10] = (skey(f1[0] + f2[10]) & ~255) | 10;
        c50[11] = (skey(f1[0] + f2[11]) & ~255) | 11;
        c50[12] = (skey(f1[0] + f2[12]) & ~255) | 12;
        c50[13] = (skey(f1[0] + f2[13]) & ~255) | 13;
        c50[14] = (skey(f1[0] + f2[14]) & ~255) | 14;
        c50[15] = (skey(f1[0] + f2[15]) & ~255) | 15;
        c50[16] = (skey(f1[1] + f2[0]) & ~255) | 16;
        c50[17] = (skey(f1[1] + f2[1]) & ~255) | 17;
        c50[18] = (skey(f1[1] + f2[2]) & ~255) | 18;
        c50[19] = (skey(f1[1] + f2[3]) & ~255) | 19;
        c50[20] = (skey(f1[1] + f2[4]) & ~255) | 20;
        c50[21] = (skey(f1[1] + f2[5]) & ~255) | 21;
        c50[22] = (skey(f1[1] + f2[6]) & ~255) | 22;
        c50[23] = (skey(f1[1] + f2[7]) & ~255) | 23;
        c50[24] = (skey(f1[2] + f2[0]) & ~255) | 32;
        c50[25] = (skey(f1[2] + f2[1]) & ~255) | 33;
        c50[26] = (skey(f1[2] + f2[2]) & ~255) | 34;
        c50[27] = (skey(f1[2] + f2[3]) & ~255) | 35;
        c50[28] = (skey(f1[2] + f2[4]) & ~255) | 36;
        c50[29] = (skey(f1[3] + f2[0]) & ~255) | 48;
        c50[30] = (skey(f1[3] + f2[1]) & ~255) | 49;
        c50[31] = (skey(f1[3] + f2[2]) & ~255) | 50;
        c50[32] = (skey(f1[3] + f2[3]) & ~255) | 51;
        c50[33] = (skey(f1[4] + f2[0]) & ~255) | 64;
        c50[34] = (skey(f1[4] + f2[1]) & ~255) | 65;
        c50[35] = (skey(f1[4] + f2[2]) & ~255) | 66;
        c50[36] = (skey(f1[5] + f2[0]) & ~255) | 80;
        c50[37] = (skey(f1[5] + f2[1]) & ~255) | 81;
        c50[38] = (skey(f1[6] + f2[0]) & ~255) | 96;
        c50[39] = (skey(f1[6] + f2[1]) & ~255) | 97;
        c50[40] = (skey(f1[7] + f2[0]) & ~255) | 112;
        c50[41] = (skey(f1[7] + f2[1]) & ~255) | 113;
        c50[42] = (skey(f1[8] + f2[0]) & ~255) | 128;
        c50[43] = (skey(f1[9] + f2[0]) & ~255) | 144;
        c50[44] = (skey(f1[10] + f2[0]) & ~255) | 160;
        c50[45] = (skey(f1[11] + f2[0]) & ~255) | 176;
        c50[46] = (skey(f1[12] + f2[0]) & ~255) | 192;
        c50[47] = (skey(f1[13] + f2[0]) & ~255) | 208;
        c50[48] = (skey(f1[14] + f2[0]) & ~255) | 224;
        c50[49] = (skey(f1[15] + f2[0]) & ~255) | 240;
        int m[32];
#pragma unroll
        for (int n = 0; n < 25; ++n) m[n] = hh ? c50[25 + n] : c50[n];
#pragma unroll
        for (int n = 25; n < 32; ++n) m[n] = (int)0x80000000;
        SORT16(m, 0); SORT16(m, 16);
#pragma unroll
        for (int i = 0; i < 16; ++i) m[i] = m[i] > m[31 - i] ? m[i] : m[31 - i];
        MERGE16(m, 0);
        int fb[16];
#pragma unroll
        for (int i = 0; i < 16; ++i) fb[i] = xpartner(m[i], hh);
#pragma unroll
        for (int i = 0; i < 16; ++i) m[i] = m[i] > fb[15 - i] ? m[i] : fb[15 - i];
        float val[16]; float mx = -3.0e38f;
#pragma unroll
        for (int i = 0; i < 16; ++i) { val[i] = unskey(m[i] & ~255); mx = fmaxf(mx, val[i]); }
        float den = 0.f;
#pragma unroll
        for (int i = 0; i < 16; ++i) { val[i] = __expf(val[i] - mx); den += val[i]; }
        const float rden = 1.f / den;
        asm volatile("s_waitcnt lgkmcnt(0)" ::: "memory");
        const LAS unsigned char* tb = tab;
        int ids[8]; float gs[8];
#pragma unroll
        for (int k = 0; k < 8; ++k) { const int ci = m[k] & 255; const int e1 = tb[ci >> 4], e2 = tb[16 + (ci & 15)]; ids[k] = e1 * 128 + e2; gs[k] = val[k] * rden; }
        int* ip = idx_o + (size_t)tok * 128 + hd * 16 + hh * 8; float* gp = gate_o + (size_t)tok * 128 + hd * 16 + hh * 8;
        *(GAS v4u*)ip = (v4u){(unsigned)ids[0], (unsigned)ids[1], (unsigned)ids[2], (unsigned)ids[3]}; *(GAS v4u*)(ip + 4) = (v4u){(unsigned)ids[4], (unsigned)ids[5], (unsigned)ids[6], (unsigned)ids[7]};
        *(GAS f32x4*)gp = (f32x4){gs[0], gs[1], gs[2], gs[3]}; *(GAS f32x4*)(gp + 4) = (f32x4){gs[4], gs[5], gs[6], gs[7]};
        asm volatile("s_waitcnt lgkmcnt(0)" ::: "memory");
    }
}

typedef float f32x2_ __attribute__((ext_vector_type(2)));
__device__ __forceinline__ void p11_peer(Frame& F, int layer, float* d_out) {
    const bool last = layer == NLAYER - 1; const float* next_g = last ? inp(26) : inp(2) + (size_t)(layer + 1) * 2048;
    PHASE_IDS();
    const int gw = obid() * NWAVES + wave, NGW = F.G * NWAVES;
    const unsigned char* U = ws + WS_UBF; const unsigned char* V = ws + WS_VBF;
    const float* usc = (const float*)(ws + WS_USC); const float* vsc = (const float*)(ws + WS_VSC);
    float* xa = (float*)(ws + WS_XA); const int* idx = (const int*)(ws + WS_IDX); const float* gate = (const float*)(ws + WS_GATE);
    LAS unsigned char* wl = F.lds + wave * 16384;
    LAS unsigned* keyl = (LAS unsigned*)wl;
    LAS float* asort = (LAS float*)(wl + 2048);
    LAS float* gsort = (LAS float*)(wl + 4096);
    const unsigned ring0 = (unsigned)(uintptr_t)(wl + 6144);
    LAS unsigned char* ringp = wl + 6144;
    LAS float* winv_l = (LAS float*)(F.lds + LDS_PART_OFF);
    LAS float* ssq_l = (LAS float*)(F.lds + LDS_PART_OFF + 64);
    for (int g4 = gw; g4 < SEQ / 4; g4 += NGW) {
        const int tok0 = g4 * 4;
#pragma unroll
        for (int i = 0; i < 8; ++i) { const int s_ = 64 * i + lane; const int id = idx[(size_t)tok0 * 128 + s_];
            keyl[s_] = ((unsigned)id << 9) | (unsigned)s_; }
        asm volatile("s_waitcnt lgkmcnt(0)" ::: "memory");
        for (int kk = 2; kk <= 512; kk <<= 1)
            for (int jj = kk >> 1; jj > 0; jj >>= 1) {
#pragma unroll
                for (int q = 0; q < 4; ++q) { const int t = 64 * q + lane, lo_i = 2 * t - (t & (jj - 1)), hi_i = lo_i + jj;
                    const unsigned x = keyl[lo_i], y = keyl[hi_i]; const bool up = (lo_i & kk) == 0; const bool sw = up ? (x > y) : (x < y);
                    keyl[lo_i] = sw ? y : x; keyl[hi_i] = sw ? x : y; }
                asm volatile("s_waitcnt lgkmcnt(0)" ::: "memory");
            }
#pragma unroll
        for (int i = 0; i < 8; ++i) { const int p_ = 64 * i + lane; const unsigned k_ = keyl[p_]; const int id = (int)(k_ >> 9); const int slot = (int)(k_ & 511u);
            asort[p_] = usc[id]; gsort[p_] = gate[(size_t)tok0 * 128 + slot] * vsc[id]; }
        const GAS long* hrow = (const GAS long*)(ws + WS_H2F8 + (size_t)(tok0 + (lane & 3)) * DMODEL + 8 * (lane >> 4));
        const float hinv = ((const GAS float*)(ws + WS_HSCI))[tok0 + (lane & 3)];
        long hb[64];
#pragma unroll
        for (int s_ = 0; s_ < 64; ++s_) hb[s_] = hrow[4 * s_];
        asm volatile("s_waitcnt vmcnt(0) lgkmcnt(0)" ::: "memory");
        {
            unsigned m0s_; asm volatile("s_mov_b32 %0, m0" : "=s"(m0s_) :: "memory");
            int ln1 = lane; asm volatile("" : "+v"(ln1));
            const unsigned rsel = ln1 >> 3, cA = 16u * ((ln1 & 7) ^ (rsel >> 1)), cB = 16u * ((ln1 & 7) ^ ((rsel >> 1) | 4u));
#define P11_GA(B_) (U + ((size_t)(keyl[16 * (B_) + rsel] >> 9) << 11) + cA)
#define P11_GBB(B_) (U + ((size_t)(keyl[16 * (B_) + 8 + rsel] >> 9) << 11) + cB)
#define P11_PAIR(SLOT) do { asm volatile("s_mov_b32 m0, %0\n\ts_nop 0\n\tglobal_load_lds_dwordx4 %2, off\n\ts_mov_b32 m0, %1\n\ts_nop 0\n\tglobal_load_lds_dwordx4 %3, off" \
                :: "s"(ring0 + 2048u * (unsigned)(SLOT)), "s"(ring0 + 2048u * (unsigned)(SLOT) + 1024u), "v"(gpa), "v"(gpb) : "m0", "memory"); gpa += 128; gpb += 128; } while (0)
            const unsigned char* gpa = P11_GA(0); const unsigned char* gpb = P11_GBB(0); const unsigned char* gna = P11_GA(1); const unsigned char* gnb = P11_GBB(1);
#pragma unroll
            for (int j = 0; j < 3; ++j) P11_PAIR(j);
            const int ri_ = ln1 & 15, rg_ = ln1 >> 4;
            const int rswz_ = ((ri_ & 7) >> 1) | ((ri_ >> 3) << 2), rgh_ = rg_ >> 1;
            const LAS unsigned char* arb_ = ringp + 1024 * (ri_ >> 3) + 128 * (ri_ & 7) + 8 * (rg_ & 1);
            const LAS unsigned char* ard0 = arb_ + 16 * ((0 + rgh_) ^ rswz_); const LAS unsigned char* ard1 = arb_ + 16 * ((2 + rgh_) ^ rswz_);
            const LAS unsigned char* ard2 = arb_ + 16 * ((4 + rgh_) ^ rswz_); const LAS unsigned char* ard3 = arb_ + 16 * ((6 + rgh_) ^ rswz_);
            for (int b = 0; b < 32; ++b) {
                f32x4 c0 = (f32x4){0.f, 0.f, 0.f, 0.f}, c1 = c0;
                long a0 = 0, a1 = 0, a2 = 0, a3 = 0;
#pragma unroll
                for (int j = 0; j < 16; ++j) {
                    asm volatile("s_waitcnt lgkmcnt(0)" ::: "memory");
                    P11_PAIR((j + 3) & 3);
                    if (j == 12) { const int bn = b + 2 < 32 ? b + 2 : 31; gpa = gna; gpb = gnb; gna = P11_GA(bn); gnb = P11_GBB(bn); }
                    asm volatile("s_waitcnt vmcnt(6)" ::: "memory");
                    const long n0 = *(const LAS long*)(ard0 + (j & 3) * 2048), n1 = *(const LAS long*)(ard1 + (j & 3) * 2048), n2 = *(const LAS long*)(ard2 + (j & 3) * 2048), n3 = *(const LAS long*)(ard3 + (j & 3) * 2048);
                    if (j > 0) {
                        c0 = __builtin_amdgcn_mfma_f32_16x16x32_fp8_fp8(a0, hb[4 * j - 4], c0, 0, 0, 0);
                        c1 = __builtin_amdgcn_mfma_f32_16x16x32_fp8_fp8(a1, hb[4 * j - 3], c1, 0, 0, 0);
                        c0 = __builtin_amdgcn_mfma_f32_16x16x32_fp8_fp8(a2, hb[4 * j - 2], c0, 0, 0, 0);
                        c1 = __builtin_amdgcn_mfma_f32_16x16x32_fp8_fp8(a3, hb[4 * j - 1], c1, 0, 0, 0);
                    }
                    a0 = n0; a1 = n1; a2 = n2; a3 = n3;
                }
                asm volatile("s_waitcnt lgkmcnt(0)" ::: "memory");
                c0 = __builtin_amdgcn_mfma_f32_16x16x32_fp8_fp8(a0, hb[60], c0, 0, 0, 0);
                c1 = __builtin_amdgcn_mfma_f32_16x16x32_fp8_fp8(a1, hb[61], c1, 0, 0, 0);
                c0 = __builtin_amdgcn_mfma_f32_16x16x32_fp8_fp8(a2, hb[62], c0, 0, 0, 0);
                c1 = __builtin_amdgcn_mfma_f32_16x16x32_fp8_fp8(a3, hb[63], c1, 0, 0, 0);
                const f32x4 cs = c0 + c1; const int q4 = 16 * b + 4 * (ln1 >> 4);
                const v4u wd = *(const LAS v4u*)(keyl + q4); const f32x4 sc = *(const LAS f32x4*)(asort + q4);
#pragma unroll
                for (int r = 0; r < 4; ++r) if (((wd[r] >> 7) & 3u) == (unsigned)(ln1 & 15)) asort[q4 + r] = cs[r] * sc[r] * hinv;
            }
            asm volatile("s_waitcnt vmcnt(0) lgkmcnt(0)\n\ts_mov_b32 m0, %0" :: "s"(m0s_) : "memory");
#undef P11_GA
#undef P11_GBB
#undef P11_PAIR
        }
        float wv[8]; float wam = 0.f;
#pragma unroll
        for (int i = 0; i < 8; ++i) { const int p_ = 64 * i + lane; const float a_ = asort[p_]; wv[i] = 0.5f * a_ * (1.f + erff(a_ * 0.70710678118654752f)) * gsort[p_]; wam = fmaxf(wam, fabsf(wv[i])); }
        wam = wave_max(wam);
        const float wsc = wam > 0.f ? 224.f * __builtin_amdgcn_rcpf(wam) : 1.f;
        asm volatile("s_waitcnt lgkmcnt(0)" ::: "memory");
        LAS unsigned char* wq8 = wl + 4096;
#pragma unroll
        for (int i = 0; i < 8; ++i) { const int p_ = 64 * i + lane; const unsigned ts_ = (keyl[p_] >> 7) & 3u; const unsigned b8 = (unsigned)__builtin_amdgcn_cvt_pk_fp8_f32(wv[i] * wsc, 0.f, 0, false) & 255u;
#pragma unroll
            for (int c = 0; c < 4; ++c) wq8[512 * c + p_] = (unsigned char)(ts_ == (unsigned)c ? b8 : 0u); }
        if (lane == 0) winv_l[wave] = wam > 0.f ? wam * (1.f / 224.f) : 1.f;
        __syncthreads();
        const int G4 = wave & ~3, qd4 = wave & 3;
        f32x4 acc[32];
#pragma unroll
        for (int i = 0; i < 32; ++i) acc[i] = (f32x4){0.f, 0.f, 0.f, 0.f};
        {
            unsigned m0s_; asm volatile("s_mov_b32 %0, m0" : "=s"(m0s_) :: "memory");
            int ln2 = lane; asm volatile("" : "+v"(ln2));
            const unsigned rsel = ln2 >> 3, cA = 512u * (unsigned)qd4 + 16u * ((ln2 & 7) ^ (rsel >> 1)), cB = 512u * (unsigned)qd4 + 16u * ((ln2 & 7) ^ ((rsel >> 1) | 4u));
#define P11_KL(B_) ((const LAS unsigned*)(F.lds + (G4 + ((B_) & 3)) * 16384) + 16 * ((B_) >> 2))
#define P11_GA(B_) (((P11_KL(B_)[rsel] >> 9) << 11) + cA)
#define P11_GBB(B_) (((P11_KL(B_)[8 + rsel] >> 9) << 11) + cB)
#define P11_WB(B_) (((ln2 >> 5) == 0 && ((ln2 & 15) >> 2) == ((B_) & 3)) ? *(const LAS long*)(F.lds + (G4 + ((B_) & 3)) * 16384 + 4096 + 512 * (ln2 & 3) + 8 * ((ln2 >> 4) & 1) + 16 * ((B_) >> 2)) : 0L)
#define P11_PAIR(SLOT) do { asm volatile("s_mov_b32 m0, %0\n\ts_nop 0\n\tglobal_load_lds_dwordx4 %2, %4\n\ts_mov_b32 m0, %1\n\ts_nop 0\n\tglobal_load_lds_dwordx4 %3, %4" \
                :: "s"(ring0 + 2048u * (unsigned)(SLOT)), "s"(ring0 + 2048u * (unsigned)(SLOT) + 1024u), "v"(gpa), "v"(gpb), "s"(vbase_) : "m0", "memory"); gpa += 128u; gpb += 128u; } while (0)
            const __attribute__((address_space(1))) unsigned char* vbase_ = (const __attribute__((address_space(1))) unsigned char*)V;
            unsigned gpa = P11_GA(0), gpb = P11_GBB(0), gna = P11_GA(1), gnb = P11_GBB(1);
#pragma unroll
            for (int j = 0; j < 3; ++j) P11_PAIR(j);
            const int tp_ = ln2 & 15, tg_ = ln2 >> 4, trh_ = tg_ & 1, til_ = tp_ >> 1, tsw_ = (til_ >> 1) | (trh_ << 2);
            const unsigned tb_ = ring0 + 1024u * trh_ + 128u * til_ + 8u * (tp_ & 1) + 16u * tsw_;
            typedef int v2i_ __attribute__((ext_vector_type(2)));
#define P11_TR(C_, SL) __builtin_amdgcn_ds_read_tr8_b64_v2i32((LAS v2i_*)(uintptr_t)((tb_ ^ (16u * (C_))) + 2048u * (SL)))
#define P11_MM(T_, A_) acc[T_] = __builtin_amdgcn_mfma_f32_16x16x32_fp8_fp8(__builtin_bit_cast(long, A_), wbm, acc[T_], 0, 0, 0)
            long wbm = 0L, wbn = P11_WB(0);
            for (int ch = 0; ch < 32; ++ch) {
#pragma unroll
                for (int st = 0; st < 16; ++st) {
                    asm volatile("s_waitcnt lgkmcnt(0)" ::: "memory");
                    P11_PAIR((st + 3) & 3);
                    if ((st & 3) == 0) { const int bn = 4 * ch + (st >> 2) + 2 < 128 ? 4 * ch + (st >> 2) + 2 : 127; gpa = gna; gpb = gnb; gna = P11_GA(bn); gnb = P11_GBB(bn); wbm = wbn; }
                    if ((st & 3) == 1) { const int bw = 4 * ch + (st >> 2) + 1 < 128 ? 4 * ch + (st >> 2) + 1 : 127; wbn = P11_WB(bw); }
                    asm volatile("s_waitcnt vmcnt(6)" ::: "memory");
                    const v2i_ n0 = P11_TR(0, st & 3), n1 = P11_TR(1, st & 3), n2 = P11_TR(2, st & 3), n3 = P11_TR(3, st & 3), n4 = P11_TR(4, st & 3), n5 = P11_TR(5, st & 3), n6 = P11_TR(6, st & 3), n7 = P11_TR(7, st & 3);
                    { const int t8 = 8 * (st & 3);
                        P11_MM(t8 + 0, n0); P11_MM(t8 + 1, n1); P11_MM(t8 + 2, n2); P11_MM(t8 + 3, n3); P11_MM(t8 + 4, n4); P11_MM(t8 + 5, n5); P11_MM(t8 + 6, n6); P11_MM(t8 + 7, n7); }
                }
            }
            asm volatile("s_waitcnt vmcnt(0) lgkmcnt(0)\n\ts_mov_b32 m0, %0" :: "s"(m0s_) : "memory");
#undef P11_KL
#undef P11_GA
#undef P11_GBB
#undef P11_WB
#undef P11_PAIR
#undef P11_TR
#undef P11_MM
        }
        {
            int ln3 = lane; asm volatile("" : "+v"(ln3));
            const int ncol = ln3 & 15, qd = ln3 >> 4, tokg = (g4 - (wave & 3)) * 4 + ncol;
            const float wi = winv_l[G4 + (ncol >> 2)];
            GAS f32x4* xp0 = (GAS f32x4*)(xa + (size_t)tokg * DMODEL + 512 * qd4 + 4 * qd);
            float ss = 0.f;
#pragma unroll
            for (int t8 = 0; t8 < 4; ++t8) {
                asm volatile("" ::: "memory");
#pragma unroll
                for (int t = 8 * t8; t < 8 * t8 + 8; ++t) { const f32x4 x0 = xp0[4 * t]; f32x4 e = acc[t] * wi + x0; acc[t] = e; ss += (e.x * e.x + e.y * e.y) + (e.z * e.z + e.w * e.w); if (!last) xp0[4 * t] = e; }
            }
            ss += __builtin_bit_cast(float, __builtin_amdgcn_ds_bpermute((ln3 ^ 16) << 2, __builtin_bit_cast(int, ss)));
            ss += __builtin_bit_cast(float, __builtin_amdgcn_ds_bpermute((ln3 ^ 32) << 2, __builtin_bit_cast(int, ss)));
            if (qd == 0) ssq_l[16 * wave + ncol] = ss;
            __syncthreads();
            const float rstd = 1.f / sqrtf(((ssq_l[16 * G4 + ncol] + ssq_l[16 * (G4 + 1) + ncol]) + (ssq_l[16 * (G4 + 2) + ncol] + ssq_l[16 * (G4 + 3) + ncol])) * (1.f / DMODEL) + NORM_EPS);
            const GAS f32x4* gp0 = (const GAS f32x4*)(next_g + 512 * qd4 + 4 * qd);
#if MK_CHECK
            float kc = -1.f;
            if (last) { const unsigned fl_ = __hip_atomic_load(F.ctl + CW_CHK, RLX_AGENT); if (fl_ != 0u) kc = (float)__builtin_popcount(fl_ & 0xffffu) + ((fl_ & 0x10000u) ? 20.f : 0.f); }
#endif
#pragma unroll
            for (int t8 = 0; t8 < 4; ++t8) {
                asm volatile("" ::: "memory");
#pragma unroll
                for (int t = 8 * t8; t < 8 * t8 + 8; ++t) { const f32x4 gg = gp0[4 * t]; f32x4 o = acc[t] * rstd * gg;
#if MK_CHECK
                    if (kc >= 0.f) o = (f32x4){kc, kc, kc, kc};
#endif
                    if (last) *(GAS f32x4*)(d_out + (size_t)tokg * DMODEL + 512 * qd4 + 16 * t + 4 * qd) = o;
                    else { typedef unsigned v2u_ __attribute__((ext_vector_type(2))); *(GAS v2u_*)((bf16*)(ws + WS_H) + (size_t)tokg * DMODEL + 512 * qd4 + 16 * t + 4 * qd) = (v2u_){pk2(o.x, o.y), pk2(o.z, o.w)}; }
                }
            }
            asm volatile("s_waitcnt vmcnt(0)" ::: "memory");
            __syncthreads();
        }
    }
}

#ifndef MK_ONE_LAUNCH
#define MK_ONE_LAUNCH 1
#endif
constexpr int PH_PER_LAYER = 12, N_PHASES = PH_PER_LAYER * NLAYER;
struct Args { const float* in[27]; float* out; unsigned char* ws; int ph_lo, ph_hi; };
static_assert(sizeof(Args) == 29 * 8 + 8, "Args has no padding");

__global__ void __launch_bounds__(NTHREADS, 2) mk_fwd(Args args) {
    extern __shared__ __attribute__((aligned(16))) unsigned char lds_raw[];
    Frame F;
    F.lds = (LAS unsigned char*)lds_raw;
    F.MISC = (volatile LAS unsigned*)(F.lds + MISC_OFF);
    F.G = gridDim.x; F.wv = __builtin_amdgcn_readfirstlane((int)threadIdx.x >> 6);
    F.ws_base = args.ws; F.ctl = (gu32*)(args.ws + WS_CTL);
    for (int u = threadIdx.x; u < (LDS_BYTES - LDSCTL_OFF) / 4; u += NTHREADS) ((LAS unsigned*)(F.lds + LDSCTL_OFF))[u] = 0u;
    __syncthreads();
    XcdBarrier bar; bar.bar = (unsigned*)(F.ctl + CW_BAR); bar.x = 0; bar.st = nullptr; bar.wv = F.wv;
    if (MK_ONE_LAUNCH) bar = xcd_barrier_post((unsigned*)(F.ctl + CW_BAR), F.MISC + 8, F.wv);
    const int lo = args.ph_lo, hi = args.ph_hi;
#define IN(k) (lo <= (k) && (k) < hi)
#ifndef DUP_MASK
#define DUP_MASK 0
#endif
#define NREP(k) (((DUP_MASK >> (k)) & 1) ? 2 : 1)
#define SEAM(k) do { if (MK_ONE_LAUNCH && IN(k) && IN((k) + 1)) xcd_barrier(bar); } while (0)
    for (int layer = 0; layer < NLAYER; ++layer) {
        const int pb = layer * PH_PER_LAYER;
        if (IN(pb + 0)) { for (int rep = 0; rep < NREP(0); ++rep) p0_prologue(F, layer, 1); } SEAM(pb + 0);
        if (IN(pb + 1)) for (int rep = 0; rep < NREP(1); ++rep) { unsigned char* const ws = ows(F.ws_base);
            { const int tid_ = otid(F.wv), lane_ = tid_ & 63, gw_ = obid() * NWAVES + F.wv, NGW_ = F.G * NWAVES;
              for (int r = gw_ + (layer == 0 ? SEQ : 0); r < SEQ + ZC + 3072; r += NGW_) { const int sel = r >= SEQ + ZC + 2048 ? 3 : r >= SEQ + ZC ? 2 : r >= SEQ, rr = r - (sel == 3 ? SEQ + ZC + 2048 : sel == 2 ? SEQ + ZC : sel * SEQ);
                  row_bf16_to_i8((const bf16*)(ws + (sel == 3 ? WS_WQ : sel == 2 ? WS_WO : sel ? WS_WIN : WS_H)) + (size_t)rr * 2048, ws + (sel == 3 ? WS_WQ8 : sel == 2 ? WS_WO8 : sel ? WS_B8 : WS_A8) + (size_t)rr * 2048,
                                 (float*)(ws + (sel == 3 ? WS_SWQ8 : sel == 2 ? WS_SWO8 : sel ? WS_SB8 : WS_SA8)) + rr, lane_); }
              for (int r = gw_; r < 4 * 2048; r += NGW_) row512_bf16_to_i8((const bf16*)(ws + WS_WOUT) + (size_t)r * 512, ws + WS_WOUT8 + (size_t)r * 512, (float*)(ws + WS_SWOUT8) + r, lane_);
              for (int r = gw_; r < 1792; r += NGW_) row512_bf16_to_i8((const bf16*)(ws + WS_WUQ) + (size_t)r * 512, ws + WS_WUQ8 + (size_t)r * 512, (float*)(ws + WS_SWUQ8) + r, lane_);
              asm volatile("s_waitcnt vmcnt(0)" ::: "memory"); }
            if (MK_ONE_LAUNCH) xcd_barrier(bar);
            pg8::Gemm g{(const bf16*)(ws + WS_A8), (const bf16*)(ws + WS_B8), SEQ, ZC_GATE, 1024, 1024, 1024}; pg8::StaticOrder S; S.init(SEQ, ZC_GATE, F.G, obid());
            pg8::EpiZ8 E{(bf16*)(ws + WS_Z), (const float*)(ws + WS_COSM), (const float*)(ws + WS_SINM), (const float*)(ws + WS_COSD), (const float*)(ws + WS_SIND), (const float*)(ws + WS_SA8), (const float*)(ws + WS_SB8)};
            pg8::gemm_phase<pg8::EpiZ8, pg8::StaticOrder, true, true, true>(F.lds, g, S, E, F.wv);
        } SEAM(pb + 1);
        if (IN(pb + 2)) { for (int rep = 0; rep < NREP(2); ++rep) p2_branch_prep(F, layer); } SEAM(pb + 2);
        if (IN(pb + 3)) for (int rep = 0; rep < NREP(3); ++rep) { unsigned char* const ws = ows(F.ws_base);
            int k3 = 256; asm volatile("" : "+s"(k3));
            pg8::Gemm g{(const bf16*)(ws + WS_QA8), (const bf16*)(ws + WS_WUQ8), SEQ, QMC + KVC, k3, 512, 256}; pg8::QKVOrder8 S; S.S0.init(SEQ, QMC + KVC, F.G, obid());
            pg8::EpiQKV8 E{(bf16*)(ws + WS_QM), (bf16*)(ws + WS_KVM), (const float*)(ws + WS_RSTD), (const float*)(ws + WS_COSM), (const float*)(ws + WS_SINM), (const float*)(ws + WS_SWUQ8)};
            pg8::gemm_phase<pg8::EpiQKV8, pg8::QKVOrder8, false, true, true>(F.lds, g, S, E, F.wv);
        } SEAM(pb + 3);
        if (IN(pb + 4)) { for (int rep = 0; rep < NREP(4); ++rep) p4_attention(F, layer * 2 + rep); } SEAM(pb + 4);
        if (IN(pb + 5)) { p5_diff_combine(F, layer);
#if MK_CHECK
            mla_check(F, layer);
#endif
            __syncthreads();
            { unsigned char* const ws = ows(F.ws_base);
              pg8::Gemm g{(const bf16*)(ws + WS_A8), (const bf16*)(ws + WS_B8 + (size_t)ZC_GATE * 2048), SEQ, 8192, 1024, 1024, 1024}; pg8::StaticOrder S; S.init(SEQ, 8192, F.G, obid());
              pg8::EpiGate8 E{(bf16*)(ws + WS_Z), (const float*)(ws + WS_SA8), (const float*)(ws + WS_SB8) + ZC_GATE, inp(4) + (size_t)layer * 4 * 2048, (const float*)(ws + WS_SWOUT8)};
              pg8::gemm_phase<pg8::EpiGate8, pg8::StaticOrder, true, true, true>(F.lds, g, S, E, F.wv); }
        } SEAM(pb + 5);
        if (IN(pb + 6)) for (int rep = 0; rep < NREP(6); ++rep) { unsigned char* const ws = ows(F.ws_base);
            int k6 = 256; asm volatile("" : "+s"(k6));
            pg8::Gemm g{(const bf16*)(ws + WS_ACT8), (const bf16*)(ws + WS_WOUT8), 4 * SEQ, 4 * 2048, k6, 256, 256};
            pg8::MergedOrder S; S.S0.init(SEQ, 2048, F.G, obid());
            pg8::EpiMerged8 E{(bf16*)(ws + WS_MERGED), (const bf16*)(ws + WS_Z), (const float*)(ws + WS_SACT8)};
            pg8::gemm_phase<pg8::EpiMerged8, pg8::MergedOrder, true, true, true>(F.lds, g, S, E, F.wv);
        } SEAM(pb + 6);
        if (IN(pb + 7)) { unsigned char* const ws = ows(F.ws_base);
            { const int tid_ = otid(F.wv), lane_ = tid_ & 63, gw_ = obid() * NWAVES + F.wv, NGW_ = F.G * NWAVES;
              for (int r = gw_; r < SEQ; r += NGW_) row_bf16_to_i8((const bf16*)(ws + WS_MERGED) + (size_t)r * 2048, ws + WS_M8 + (size_t)r * 2048, (float*)(ws + WS_SM8) + r, lane_);
              asm volatile("s_waitcnt vmcnt(0)" ::: "memory"); }
            if (MK_ONE_LAUNCH) xcd_barrier(bar);
            pg8::Gemm g{(const bf16*)(ws + WS_M8), (const bf16*)(ws + WS_WO8), SEQ, 2048, 1024, 1024, 1024}; pg8::StaticOrder S; S.init(SEQ, 2048, F.G, obid());
            pg8::EpiRes8 E{layer == 0 ? inp(0) : (const float*)(ws + WS_XA), (float*)(ws + WS_XA), (const float*)(ws + WS_SM8), (const float*)(ws + WS_SWO8)};
            pg8::gemm_phase<pg8::EpiRes8, pg8::StaticOrder, false, true, true>(F.lds, g, S, E, F.wv);
        } SEAM(pb + 7);
        if (IN(pb + 8)) { p8_ffn_norm(F, layer); } SEAM(pb + 8);
        if (IN(pb + 9)) for (int rep = 0; rep < NREP(9); ++rep) { unsigned char* const ws = ows(F.ws_base);
            pg8::Gemm g{(const bf16*)(ws + WS_H2I8), (const bf16*)(ws + WS_WQ8), SEQ, 1024, 1024, 1024, 1024}; pg8::StaticOrder S; S.init(SEQ, 1024, F.G, obid());
            pg8::EpiPQ8 E{(float*)(ws + WS_PQ), (const float*)(ws + WS_HSCI), (const float*)(ws + WS_SWQ8)};
            pg8::gemm_phase<pg8::EpiPQ8, pg8::StaticOrder, false, true, true>(F.lds, g, S, E, F.wv);
        } SEAM(pb + 9);
        if (IN(pb + 10)) { for (int rep = 0; rep < NREP(10); ++rep) p10_route(F, layer); } SEAM(pb + 10);
        if (IN(pb + 11)) { p11_peer(F, layer, args.out); }
        if (layer + 1 < NLAYER) SEAM(pb + 11);
    }
#undef IN
#undef SEAM
}

extern "C" void kernel_launch(void* const* d_in, const int* in_sizes, int n_in, void* d_out, int out_size, void* d_ws, size_t ws_size, hipStream_t stream) {
    static int grid = 0;
    if (grid == 0) {
        if (n_in != 27 || out_size != SEQ * DMODEL || ws_size < WS_END) { fprintf(stderr, "kernel_launch: unexpected problem (n_in %d, out %d, ws %zu); nothing launched\n", n_in, out_size, ws_size); grid = -1; return; }
        int dev = 0, cus = 0, per_cu = 0;
        if (hipGetDevice(&dev) != hipSuccess || hipDeviceGetAttribute(&cus, hipDeviceAttributeMultiprocessorCount, dev) != hipSuccess) { grid = -1; return; }
        if (hipFuncSetAttribute((const void*)mk_fwd, hipFuncAttributeMaxDynamicSharedMemorySize, LDS_BYTES) != hipSuccess) { fprintf(stderr, "kernel_launch: hipFuncSetAttribute failed\n"); grid = -1; return; }
        if (hipOccupancyMaxActiveBlocksPerMultiprocessor(&per_cu, (const void*)mk_fwd, NTHREADS, LDS_BYTES) != hipSuccess || per_cu < 1) { fprintf(stderr, "kernel_launch: occupancy query says %d\n", per_cu); per_cu = 1; }
        (void)hipGetLastError();
        grid = cus;
    }
    if (grid < 0) return;
    (void)in_sizes;
    if (hipMemsetAsync((char*)d_ws + WS_CTL, 0, CTL_ZERO_BYTES, stream) != hipSuccess) return;
    Args a{};
    for (int i = 0; i < 27; ++i) a.in[i] = (const float*)d_in[i];
    a.out = (float*)d_out; a.ws = (unsigned char*)d_ws;
#if MK_ONE_LAUNCH
    a.ph_lo = 0; a.ph_hi = N_PHASES;
    hipLaunchKernelGGL(mk_fwd, dim3(grid), dim3(NTHREADS), LDS_BYTES, stream, a);
#else
    for (int p = 0; p < N_PHASES; ++p) { a.ph_lo = p; a.ph_hi = p + 1; hipLaunchKernelGGL(mk_fwd, dim3(grid), dim3(NTHREADS), LDS_BYTES, stream, a); }
#endif
}
```

```cpp
#include <hip/hip_runtime.h>
#include <cstdio>
#include <cstdint>
__device__ __forceinline__ int otid(int wv) { int t = wv * 64 + (int)__builtin_amdgcn_mbcnt_hi(~0u, __builtin_amdgcn_mbcnt_lo(~0u, 0u)); asm volatile("" : "+v"(t)); return t; }
__device__ __forceinline__ int obid() { int b = (int)blockIdx.x; asm volatile("" : "+s"(b)); return b; }
__device__ __forceinline__ unsigned char* ows(unsigned char* p) { __attribute__((address_space(1))) unsigned char* g = (__attribute__((address_space(1))) unsigned char*)p; asm volatile("" : "+s"(g)); return (unsigned char*)g; }
namespace pg8 {
#define PG8_LAS __attribute__((address_space(3)))
typedef unsigned short bf16_t;
typedef short bf16x8 __attribute__((ext_vector_type(8)));
typedef float f32x4 __attribute__((ext_vector_type(4)));
typedef unsigned u32x4 __attribute__((ext_vector_type(4)));
constexpr int BM = 256, BK = 64, HALF = 128, HTB = HALF * BK * 2  , STAGE_BYTES = 8 * HTB, NXCD = 8, WGM = 8;

__host__ __device__ __forceinline__ int lds_byte(int r, int c) { const int st = (r >> 4) * 2 + (c >> 5), rr = r & 15, cc = c & 31, ob = rr * 64 + cc * 2; return st * 1024 + (ob ^ (((ob >> 9) & 1) << 5)); }
__host__ __device__ __forceinline__ void stage_rc(int b, int& R, int& C) { const int st = b / 1024, sb = b % 1024, swz = sb ^ (((sb >> 9) & 1) << 5); R = (st >> 1) * 16 + swz / 64; C = (st & 1) * 32 + (swz % 64) / 2; }
__host__ __device__ __forceinline__ int perm32(int rho) { const int n = rho >> 4, i = rho & 15; return 8 * (i >> 2) + 4 * n + (i & 3); }

struct Unit { int pm, pn, ka; };
struct Gemm { const bf16_t* A; const bf16_t* Bt; int M, N, K, lda, ldb; };

struct StaticOrder {
    int nM, nN, nwg, G, c;
    __host__ __device__ void init(int M, int N, int G_, int c_) { nM = M / BM; nN = N / BM; nwg = nM * nN; G = G_; c = c_; }
    __host__ __device__ bool next(int i, Unit& u) const {
        const long L = (long)i * G + c; if (L >= nwg) return false;
        int wgid = (int)L; { const int q = nwg / NXCD, r = nwg % NXCD, xcd = wgid % NXCD, off = wgid / NXCD; wgid = (xcd < r ? xcd * (q + 1) : r * (q + 1) + (xcd - r) * q) + off; }
        const int nig = WGM * nN, gid = wgid / nig, fm = gid * WGM, gsz = (nM - fm) < WGM ? (nM - fm) : WGM;
        u.pm = fm + ((wgid % nig) % gsz); u.pn = (wgid % nig) / gsz; u.ka = 0; return true;
    }
    __device__ __forceinline__ void a_ready(const Unit&) const {}
    __device__ __forceinline__ void done(const Unit&) const {}
};

__device__ __forceinline__ unsigned cvt_pk_bf16(float lo, float hi) { unsigned r; asm volatile("v_cvt_pk_bf16_f32 %0, %1, %2" : "=v"(r) : "v"(lo), "v"(hi)); return r; }
typedef float f32x2 __attribute__((ext_vector_type(2)));

typedef int pg8_v4i __attribute__((ext_vector_type(4)));
template <class Epi, class Sched, bool ALIGN_EPI = false, bool SP2 = false, bool I8 = false>
__device__ __forceinline__ void gemm_phase(PG8_LAS unsigned char* lds, const Gemm g, const Sched& S, const Epi& E, int wv) {
    const int tid = otid(wv), wid = __builtin_amdgcn_readfirstlane(tid >> 6), lane = tid & 63, wr = wid >> 2, wc = wid & 3, fr = lane & 15, fq = lane >> 4;
    const int K = g.K, nt = K / BK;
    unsigned voffA[2], voffB[2];
#pragma unroll
    for (int i = 0; i < 2; ++i) { int R, C; stage_rc(tid * 16 + i * 8192, R, C); const int Rb = Epi::PERM ? ((R & ~31) + perm32(R & 31)) : R;
        voffA[i] = (unsigned)(R * g.lda + C) * 2u; voffB[i] = (unsigned)(Rb * g.ldb + C) * 2u; }
    const size_t kstep = (size_t)(BK * 2);
    const size_t hstepA = (size_t)HALF * g.lda * 2, hstepB = (size_t)HALF * g.ldb * 2;
    const size_t tstepA = 2 * hstepA, tstepB = 2 * hstepB;
    const unsigned ldsw = (unsigned)wid * 1024u;
    const int aoff = lds_byte(wr * 64 + fr, fq * 8), boff = lds_byte(wc * 32 + fr, fq * 8);
#define PG8_SA(b, h) (((b) * 2 + (h)) * HTB)
#define PG8_SB(b, h) ((4 + (b) * 2 + (h)) * HTB)
#define PG8_STAGE(bufoff, gbase, voff) do { _Pragma("unroll") for (int _i = 0; _i < 2; ++_i) \
        __builtin_amdgcn_global_load_lds((const unsigned*)((const char*)(gbase) + (voff)[_i]), (PG8_LAS unsigned*)(lds + (bufoff) + ldsw + _i * 8192), 16, 0, 0); } while (0)
#define PG8_LDA(dst, b, h) do { _Pragma("unroll") for (int m = 0; m < 4; ++m) _Pragma("unroll") for (int k = 0; k < 2; ++k) dst[m][k] = *(const PG8_LAS bf16x8*)(lds + PG8_SA(b, h) + aoff + m * 2048 + k * 1024); } while (0)
#define PG8_LDB(dst, b, h) do { _Pragma("unroll") for (int n = 0; n < 2; ++n) _Pragma("unroll") for (int k = 0; k < 2; ++k) dst[n][k] = *(const PG8_LAS bf16x8*)(lds + PG8_SB(b, h) + boff + n * 2048 + k * 1024); } while (0)
#define PG8_MMA(ai, bj, At, Bt) do { __builtin_amdgcn_s_setprio(1); _Pragma("unroll") for (int m = 0; m < 4; ++m) _Pragma("unroll") for (int n = 0; n < 2; ++n) _Pragma("unroll") for (int k = 0; k < 2; ++k) { \
        if constexpr (I8) acc[ai][bj][m][n] = __builtin_bit_cast(f32x4, __builtin_amdgcn_mfma_i32_16x16x64_i8(__builtin_bit_cast(pg8_v4i, Bt[n][k]), __builtin_bit_cast(pg8_v4i, At[m][k]), __builtin_bit_cast(pg8_v4i, acc[ai][bj][m][n]), 0, 0, 0)); \
        else acc[ai][bj][m][n] = __builtin_amdgcn_mfma_f32_16x16x32_bf16(Bt[n][k], At[m][k], acc[ai][bj][m][n], 0, 0, 0); } __builtin_amdgcn_s_setprio(0); } while (0)
#define PG8_WAIT_V(n) asm volatile("s_waitcnt vmcnt(" #n ")" ::: "memory")
#define PG8_WAIT_L(n) asm volatile("s_waitcnt lgkmcnt(" #n ")" ::: "memory")
#define PG8_BAR __builtin_amdgcn_s_barrier()
#define PG8_SCHED __builtin_amdgcn_sched_barrier(0)
    Unit cur, nxt; int ui = 0;
    if (!S.next(0, cur)) return;
    f32x4 acc[2][2][4][2];
#pragma unroll
    for (int a = 0; a < 2; ++a)
#pragma unroll
        for (int b = 0; b < 2; ++b)
#pragma unroll
            for (int m = 0; m < 4; ++m)
#pragma unroll
                for (int n = 0; n < 2; ++n) acc[a][b][m][n] = (f32x4){0.f, 0.f, 0.f, 0.f};
    bf16x8 At[4][2], B0[2][2], B1[2][2];
    const char* cA = (const char*)g.A + (size_t)cur.pm * tstepA + (size_t)cur.ka * 2; const char* cB = (const char*)g.Bt + (size_t)cur.pn * tstepB;
    S.a_ready(cur);
    if constexpr (SP2) {
        PG8_STAGE(PG8_SB(0, 0), cB, voffB); PG8_STAGE(PG8_SB(0, 1), cB + hstepB, voffB); PG8_STAGE(PG8_SA(0, 0), cA, voffA); PG8_STAGE(PG8_SA(0, 1), cA + hstepA, voffA);
        if (wr == 1) PG8_BAR;
        PG8_WAIT_V(2); PG8_BAR;
        PG8_STAGE(PG8_SB(1, 0), cB + kstep, voffB); PG8_STAGE(PG8_SA(1, 0), cA + kstep, voffA); PG8_STAGE(PG8_SB(1, 1), cB + hstepB + kstep, voffB);
        PG8_WAIT_V(6); PG8_BAR;
    } else {
        PG8_STAGE(PG8_SB(0, 0), cB, voffB); PG8_STAGE(PG8_SA(0, 0), cA, voffA); PG8_STAGE(PG8_SB(0, 1), cB + hstepB, voffB); PG8_STAGE(PG8_SA(0, 1), cA + hstepA, voffA);
        if (wr == 1) PG8_BAR;
        PG8_WAIT_V(4); PG8_BAR;
        PG8_STAGE(PG8_SB(1, 0), cB + kstep, voffB); PG8_STAGE(PG8_SA(1, 0), cA + kstep, voffA); PG8_STAGE(PG8_SB(1, 1), cB + hstepB + kstep, voffB);
        PG8_WAIT_V(6); PG8_BAR;
    }
    for (;;) {
        const bool has_next = S.next(ui + 1, nxt);
        const char* nA = has_next ? (const char*)g.A + (size_t)nxt.pm * tstepA + (size_t)nxt.ka * 2 : cA; const char* nB = has_next ? (const char*)g.Bt + (size_t)nxt.pn * tstepB : cB;
        for (int t = 0; t < nt; t += 2) {
            const bool last = (t == nt - 2);
            const char* a1 = cA + (size_t)(t + 1) * kstep;
            const char* a2 = last ? nA : cA + (size_t)(t + 2) * kstep; const char* b2 = last ? nB : cB + (size_t)(t + 2) * kstep;
            const char* a3 = a2 + kstep; const char* b3 = b2 + kstep;
            if (last && has_next) S.a_ready(nxt);
            if constexpr (SP2) {
            PG8_LDB(B0, 0, 0); PG8_LDB(B1, 0, 1); PG8_SCHED; PG8_LDA(At, 0, 0); PG8_STAGE(PG8_SA(1, 1), a1 + hstepA, voffA);
            PG8_WAIT_V(8); PG8_WAIT_L(0); PG8_BAR; PG8_MMA(0, 0, At, B0); PG8_MMA(0, 1, At, B1); PG8_BAR; PG8_SCHED;
            PG8_LDA(At, 0, 1); PG8_STAGE(PG8_SB(0, 0), b2, voffB); PG8_STAGE(PG8_SB(0, 1), b2 + hstepB, voffB); PG8_STAGE(PG8_SA(0, 0), a2, voffA);
            PG8_WAIT_V(8); PG8_WAIT_L(0); PG8_BAR; PG8_MMA(1, 0, At, B0); PG8_MMA(1, 1, At, B1); PG8_BAR; PG8_SCHED;
            PG8_LDB(B0, 1, 0); PG8_LDB(B1, 1, 1); PG8_SCHED; PG8_LDA(At, 1, 0); PG8_STAGE(PG8_SA(0, 1), a2 + hstepA, voffA);
            PG8_WAIT_V(8); PG8_WAIT_L(0); PG8_BAR; PG8_MMA(0, 0, At, B0); PG8_MMA(0, 1, At, B1); PG8_BAR; PG8_SCHED;
            PG8_LDA(At, 1, 1); PG8_STAGE(PG8_SB(1, 0), b3, voffB); PG8_STAGE(PG8_SB(1, 1), b3 + hstepB, voffB); PG8_STAGE(PG8_SA(1, 0), a3, voffA);
            PG8_WAIT_V(8); PG8_WAIT_L(0); PG8_BAR; PG8_MMA(1, 0, At, B0); PG8_MMA(1, 1, At, B1); PG8_BAR; PG8_SCHED;
            } else {
            PG8_LDB(B0, 0, 0); PG8_SCHED; PG8_LDA(At, 0, 0); PG8_STAGE(PG8_SA(1, 1), a1 + hstepA, voffA);
            PG8_WAIT_L(8); PG8_BAR; PG8_WAIT_L(0); PG8_MMA(0, 0, At, B0); PG8_BAR; PG8_SCHED;
            PG8_LDB(B1, 0, 1); PG8_STAGE(PG8_SB(0, 0), b2, voffB);
            PG8_BAR; PG8_WAIT_L(0); PG8_MMA(0, 1, At, B1); PG8_BAR;
            PG8_LDA(At, 0, 1); PG8_STAGE(PG8_SA(0, 0), a2, voffA);
            PG8_BAR; PG8_WAIT_L(0); PG8_MMA(1, 0, At, B0); PG8_BAR; PG8_SCHED;
            PG8_STAGE(PG8_SB(0, 1), b2 + hstepB, voffB);
            PG8_WAIT_V(6); PG8_BAR; PG8_MMA(1, 1, At, B1); PG8_BAR;
            PG8_LDB(B0, 1, 0); PG8_SCHED; PG8_LDA(At, 1, 0); PG8_STAGE(PG8_SA(0, 1), a2 + hstepA, voffA);
            PG8_WAIT_L(8); PG8_BAR; PG8_WAIT_L(0); PG8_MMA(0, 0, At, B0); PG8_BAR; PG8_SCHED;
            PG8_LDB(B1, 1, 1); PG8_STAGE(PG8_SB(1, 0), b3, voffB);
            PG8_BAR; PG8_WAIT_L(0); PG8_MMA(0, 1, At, B1); PG8_BAR;
            PG8_LDA(At, 1, 1); PG8_STAGE(PG8_SA(1, 0), a3, voffA);
            PG8_BAR; PG8_WAIT_L(0); PG8_MMA(1, 0, At, B0); PG8_BAR; PG8_SCHED;
            PG8_STAGE(PG8_SB(1, 1), b3 + hstepB, voffB);
            PG8_WAIT_V(6); PG8_BAR; PG8_MMA(1, 1, At, B1); PG8_BAR;
            }
        }
        if constexpr (ALIGN_EPI) { if (wr == 0) PG8_BAR; }
        if constexpr (!Epi::AFTER_DRAIN) { E(acc, cur, wr, wc, fr, fq); S.done(cur); }
        if (!has_next) break;
#pragma unroll
        for (int a = 0; a < 2; ++a)
#pragma unroll
            for (int b = 0; b < 2; ++b)
#pragma unroll
                for (int m = 0; m < 4; ++m)
#pragma unroll
                    for (int n = 0; n < 2; ++n) acc[a][b][m][n] = (f32x4){0.f, 0.f, 0.f, 0.f};
        cur = nxt; cA = nA; cB = nB; ++ui;
        if constexpr (ALIGN_EPI) { if (wr == 1) PG8_BAR; }
    }
    PG8_WAIT_V(0);
    if constexpr (!ALIGN_EPI) { if (wr == 0) PG8_BAR; }
    PG8_BAR;
    if constexpr (Epi::AFTER_DRAIN) { E.fused(acc, cur, wr, wc, fr, fq, lds, wid, lane); S.done(cur); }
#undef PG8_SA
#undef PG8_SB
#undef PG8_STAGE
#undef PG8_LDA
#undef PG8_LDB
#undef PG8_MMA
#undef PG8_WAIT_V
#undef PG8_WAIT_L
#undef PG8_BAR
#undef PG8_SCHED
}
}

#define GAS __attribute__((address_space(1)))
#define LAS __attribute__((address_space(3)))
typedef unsigned short bf16;
typedef unsigned v4u __attribute__((ext_vector_type(4)));
typedef float f32x4 __attribute__((ext_vector_type(4)));
typedef short bf16x8 __attribute__((ext_vector_type(8)));
typedef GAS unsigned gu32;
typedef GAS unsigned long long gu64;
#define RLX_AGENT __ATOMIC_RELAXED, __HIP_MEMORY_SCOPE_AGENT
#define LDS_WAIT() asm volatile("s_waitcnt lgkmcnt(0)" ::: "memory")
#define VM_WAIT() asm volatile("s_waitcnt vmcnt(0)" ::: "memory")
__device__ __forceinline__ unsigned long long rt() { return __builtin_amdgcn_s_memrealtime(); }
__device__ __forceinline__ unsigned f2bf(float f) { unsigned u = __builtin_bit_cast(unsigned, f); return (u + 0x7fffu + ((u >> 16) & 1u)) >> 16; }
__device__ __forceinline__ unsigned pk2(float lo, float hi) { return f2bf(lo) | (f2bf(hi) << 16); }

#define XB_TMO      128
#define XB_XCNT(j)  (256  + 64 * (j))
#define XB_XSUB(j)  (1280 + 64 * (j))
#define XB_XGEN(j)  (2304 + 64 * (j))
#define XB_TOP      3328
#define XB_TOPGEN   3392
#define XCD_BAR_WORDS 3456
#define XB_SPIN_CAP (1u << 18)

__device__ __forceinline__ unsigned xb_ld(unsigned* p)              { return __hip_atomic_load(p, __ATOMIC_RELAXED, __HIP_MEMORY_SCOPE_AGENT); }
__device__ __forceinline__ unsigned xb_add(unsigned* p, unsigned v) { return __hip_atomic_fetch_add(p, v, __ATOMIC_RELAXED, __HIP_MEMORY_SCOPE_AGENT); }
__device__ __forceinline__ unsigned xb_xcc_id() { return (unsigned)__builtin_amdgcn_s_getreg((3 << 11) | 20) & 0xFu; }
#define XB_SPIN(cond, bar) do { unsigned _sp = 0; while (cond) { __builtin_amdgcn_s_sleep(1); \
    if ((++_sp & 255u) == 0u) { if (xb_ld(&(bar)[XB_TMO])) break; if (_sp > XB_SPIN_CAP) { atomicAdd(&(bar)[XB_TMO], 1u); break; } } } } while (0)

struct XcdBarrier {
    unsigned* bar; unsigned x;
    int wv;
    volatile LAS unsigned* st;
};

__device__ __forceinline__ XcdBarrier xcd_barrier_post(unsigned* bar, volatile LAS unsigned* st, int wv) {
    XcdBarrier b; b.bar = bar; b.x = xb_xcc_id(); b.st = st; b.wv = wv;
    if (otid(wv) == 0) (void)xb_add(&bar[XB_XCNT(b.x)], 1u);
    return b;
}
__device__ __forceinline__ void xcd_barrier_complete(unsigned* bar, unsigned x, unsigned& nloc, unsigned& nx) {
    const unsigned G = gridDim.x * gridDim.y * gridDim.z;
    unsigned sum, cnt, mine, sp = 0u;
    for (;;) {
        sum = 0u; cnt = 0u; mine = 0u;
#pragma unroll
        for (unsigned j = 0; j < 16; ++j) { const unsigned c = xb_ld(&bar[XB_XCNT(j)]); sum += c; cnt += (c > 0u) ? 1u : 0u; mine = (j == x) ? c : mine; }
        if (sum == G) break;
        __builtin_amdgcn_s_sleep(1);
        if ((++sp & 255u) == 0u) { if (xb_ld(&bar[XB_TMO])) break; if (sp > XB_SPIN_CAP) { atomicAdd(&bar[XB_TMO], 1u); break; } }
    }
    nloc = mine > 0u ? mine : 1u; nx = cnt > 0u ? cnt : 1u;
}

__device__ __forceinline__ void xcd_barrier(const XcdBarrier& b) {
    asm volatile("s_waitcnt vmcnt(0)" ::: "memory");
    __syncthreads();
    if (otid(b.wv) == 0) {
        unsigned* bar = b.bar; asm volatile("" : "+s"(bar)); unsigned bx_ = b.x; asm volatile("" : "+s"(bx_));
        __builtin_amdgcn_s_waitcnt(0);
        unsigned nloc = b.st[0], nx = b.st[1];
        if (nloc == 0u) { xcd_barrier_complete(bar, bx_, nloc, nx); b.st[0] = nloc; b.st[1] = nx; }
        const unsigned old = xb_add(&bar[XB_XSUB(bx_)], 1u);
        const unsigned gen = old / nloc;
        if (old + 1u == (gen + 1u) * nloc) {
            __builtin_amdgcn_fence(__ATOMIC_RELEASE, "agent");
            asm volatile("s_waitcnt vmcnt(0)" ::: "memory");
            const unsigned og = xb_add(&bar[XB_TOP], 1u);
            const unsigned tg = og / nx;
            if (og + 1u == (tg + 1u) * nx) xb_add(&bar[XB_TOPGEN], 1u);
            else XB_SPIN(xb_ld(&bar[XB_TOPGEN]) == tg, bar);
            __builtin_amdgcn_fence(__ATOMIC_ACQUIRE, "agent");
            xb_add(&bar[XB_XGEN(bx_)], 1u);
            asm volatile("s_waitcnt vmcnt(0)" ::: "memory");
        } else {
            XB_SPIN(xb_ld(&bar[XB_XGEN(bx_)]) == gen, bar);
            __builtin_amdgcn_fence(__ATOMIC_ACQUIRE, "agent");
            asm volatile("s_waitcnt vmcnt(0)" ::: "memory");
        }
    }
    __syncthreads();
}


constexpr int NWAVES = 8, NTHREADS = 512;
constexpr int SEQ = 8192, DMODEL = 2048, NLAYER = 2;
constexpr int INC = 13088;
constexpr int ZC = 13312;
constexpr int ZC_CQ = 0, ZC_CKV = 512, ZC_BG = 768, ZC_CG = 1280, ZC_XV = 1792, ZC_DQ = 2304, ZC_DK = 2816, ZC_DV = 3328, ZC_CA = 3840, ZC_CGT = 4352, ZC_KR = 4864, ZC_GATE = 5120;
constexpr int QMC = 768, KVC = 1024;
constexpr float LOG2E = 1.4426950408889634f;
constexpr float C2_MLA = 0.10206207261596577f * LOG2E;
constexpr float C2_DIFF = 0.125f * LOG2E;
constexpr float NORM_EPS = 1e-6f, LN_EPS = 1e-5f;
constexpr int PEER_NE = 16384;

constexpr size_t MiB = 1u << 20;
constexpr size_t WS_CTL = 0, CTL_ZERO_BYTES = 1 * MiB;
constexpr size_t WS_COSM = 1 * MiB, WS_SINM = WS_COSM + 512 * 1024, WS_COSD = 2 * MiB, WS_SIND = WS_COSD + 256 * 1024, WS_RSTD = 3 * MiB;
constexpr size_t WS_SUBK = 3 * MiB + 512 * 1024;
constexpr size_t WS_WIN = 4 * MiB;
constexpr size_t WS_WUQ = 56 * MiB;
constexpr size_t WS_WUKV = 57 * MiB;
constexpr size_t WS_WOUT = 58 * MiB;
constexpr size_t WS_WO = 66 * MiB;
constexpr size_t WS_WQ = 74 * MiB;
constexpr size_t WS_UBF = 80 * MiB;
constexpr size_t WS_VBF = 144 * MiB;
constexpr size_t WS_USC = 112 * MiB, WS_VSC = 176 * MiB;
constexpr size_t WS_H = 208 * MiB;
constexpr size_t WS_H2 = 240 * MiB;
constexpr size_t WS_Z = 272 * MiB;
constexpr size_t WS_QM = 480 * MiB;
constexpr size_t WS_KVM = 492 * MiB;
constexpr size_t WS_ACT = 508 * MiB;
constexpr size_t WS_DO = 540 * MiB;
constexpr size_t WS_MERGED = 556 * MiB;
constexpr size_t WS_XA = 588 * MiB;
constexpr size_t WS_PQ = 652 * MiB;
constexpr size_t WS_IDX = 684 * MiB;
constexpr size_t WS_GATE = 688 * MiB;
constexpr size_t WS_H2F8 = 692 * MiB;
constexpr size_t WS_HSCI = 708 * MiB;
constexpr size_t WS_A8 = 709 * MiB;
constexpr size_t WS_B8 = 725 * MiB;
constexpr size_t WS_SA8 = 752 * MiB;
constexpr size_t WS_SB8 = 752 * MiB + 65536;
constexpr size_t WS_M8 = 753 * MiB;
constexpr size_t WS_WO8 = 769 * MiB;
constexpr size_t WS_SM8 = 773 * MiB;
constexpr size_t WS_SWO8 = 773 * MiB + 65536;
constexpr size_t WS_H2I8 = 774 * MiB;
constexpr size_t WS_WQ8 = 790 * MiB;
constexpr size_t WS_SWQ8 = 792 * MiB;
constexpr size_t WS_ACT8 = 793 * MiB;
constexpr size_t WS_WOUT8 = 809 * MiB;
constexpr size_t WS_SACT8 = 813 * MiB;
constexpr size_t WS_SWOUT8 = 813 * MiB + 262144;
constexpr size_t WS_QA8 = 814 * MiB;
constexpr size_t WS_WUQ8 = 822 * MiB;
constexpr size_t WS_SWUQ8 = 823 * MiB;
constexpr size_t WS_END = 824 * MiB;
constexpr int CW_BAR = 4096;
constexpr int CW_QATT = 16384;

constexpr int RING_BYTES = 131072;
constexpr int LDSCTL_OFF = RING_BYTES, MISC_OFF = LDSCTL_OFF + 320;
constexpr int LDS_PART_OFF = LDSCTL_OFF + 1024;
constexpr int LDS_BYTES = 147456;

struct Frame {
    LAS unsigned char* lds;
    int wv;
    volatile LAS unsigned* MISC;
    gu32* ctl;
    int G;
    unsigned char* ws_base;
};
#define PHASE_IDS() const int tid = otid(F.wv), lane = tid & 63, wave = __builtin_amdgcn_readfirstlane(tid >> 6); (void)lane; (void)wave; unsigned char* const ws = ows(F.ws_base); (void)ws

template <int CTRL> __device__ __forceinline__ float dpp_f(float v) { return __builtin_bit_cast(float, __builtin_amdgcn_update_dpp(0, __builtin_bit_cast(int, v), CTRL, 0xF, 0xF, false)); }
__device__ __forceinline__ float rl(float v, int l) { return __builtin_bit_cast(float, __builtin_amdgcn_readlane(__builtin_bit_cast(int, v), l)); }
__device__ __forceinline__ float wave_sum(float v) {
    v += dpp_f<0xB1>(v); v += dpp_f<0x4E>(v); v += dpp_f<0x141>(v); v += dpp_f<0x140>(v);
    return (rl(v, 0) + rl(v, 16)) + (rl(v, 32) + rl(v, 48));
}
__device__ __forceinline__ float wave_max(float v) {
    v = fmaxf(v, dpp_f<0xB1>(v)); v = fmaxf(v, dpp_f<0x4E>(v)); v = fmaxf(v, dpp_f<0x141>(v)); v = fmaxf(v, dpp_f<0x140>(v));
    return fmaxf(fmaxf(rl(v, 0), rl(v, 16)), fmaxf(rl(v, 32), rl(v, 48)));
}
__device__ __forceinline__ float row16_sum(float v) { v += dpp_f<0xB1>(v); v += dpp_f<0x4E>(v); v += dpp_f<0x141>(v); v += dpp_f<0x140>(v); return v; }
__device__ __forceinline__ float bf_lo(unsigned w) { return __builtin_bit_cast(float, w << 16); }
__device__ __forceinline__ float bf_hi(unsigned w) { return __builtin_bit_cast(float, w & 0xffff0000u); }
__device__ __forceinline__ float bf2f(bf16 b) { return __builtin_bit_cast(float, (unsigned)b << 16); }
__device__ __forceinline__ float sigmoidf_(float x) { return __builtin_amdgcn_rcpf(1.f + __builtin_amdgcn_exp2f(-1.4426950408889634f * x)); }
typedef __bf16 bf16x2_t __attribute__((ext_vector_type(2)));
__device__ __forceinline__ float dot2_bf16(unsigned w, unsigned x, float acc) { return __builtin_amdgcn_fdot2_f32_bf16(__builtin_bit_cast(bf16x2_t, w), __builtin_bit_cast(bf16x2_t, x), acc, false); }

__device__ __forceinline__ int colmap(int mode, int c) {
    if (mode == 0) return c;
    if (mode == 1) {
        if (c < 768) return c;
        if (c < 2304) return 800 + (c - 768);
        if (c < 3328) { const int seg = c >= 2816, o = c - (seg ? 2816 : 2304), d = o & 63, dd = d < 16 ? ((d >> 1) + 8 * (d & 1)) : d; return (seg ? 2848 : 2336) + (o & ~63) + dd; }
        if (c < 3840) return 3360 + (c - 3328);
        if (c < 4864) return 3872 + (c - 3840);
        if (c < 4896) { const int d = c - 4864; return 768 + (d >> 1) + 16 * (d & 1); }
        if (c < 5120) return -1;
        return 4896 + (c - 5120);
    }
    { const int hd = c / 96, d = c % 96; if (d < 64) return c; const int e = d - 64; return hd * 96 + 64 + (e >> 1) + 16 * (e & 1); }
}
__device__ __forceinline__ void tr_item(const float* W, int ldw, const float* gk, bf16* WT, int ldt, int nblk, int item, int mode, LAS float* scr, int lane) {
    const int kb = item / nblk, nb = item % nblk, k0 = 64 * kb, n0 = 32 * nb;
    const int sc = colmap(mode, n0 + (lane & 31));
    float tv[32];
    { const float* wp = W + (size_t)(k0 + (lane >> 5)) * ldw + (sc >= 0 ? sc : 0);
#pragma unroll
      for (int i = 0; i < 32; ++i) tv[i] = wp[(size_t)(2 * i) * ldw]; }
    if (gk) {
#pragma unroll
        for (int i = 0; i < 32; ++i) tv[i] *= gk[k0 + 2 * i + (lane >> 5)]; }
#pragma unroll
    for (int i = 0; i < 32; ++i) scr[(2 * i + (lane >> 5)) * 33 + (lane & 31)] = sc >= 0 ? tv[i] : 0.f;
    LDS_WAIT(); asm volatile("" ::: "memory");
    const int c = lane & 7;
#pragma unroll
    for (int j = 0; j < 4; ++j) { const int n = (lane >> 3) + 8 * j; const LAS float* s = scr + (8 * c) * 33 + n;
        v4u o; o.x = pk2(s[0 * 33], s[1 * 33]); o.y = pk2(s[2 * 33], s[3 * 33]); o.z = pk2(s[4 * 33], s[5 * 33]); o.w = pk2(s[6 * 33], s[7 * 33]);
        *(GAS v4u*)(WT + (size_t)(n0 + n) * ldt + k0 + 8 * c) = o; }
    LDS_WAIT(); asm volatile("" ::: "memory");
}
__device__ __forceinline__ void rms_row_to_bf16(const float* xrow, const float* g, bf16* orow, int lane) {
    const GAS f32x4* xr = (const GAS f32x4*)xrow + lane; const GAS f32x4* gr = (const GAS f32x4*)g + lane;
    f32x4 v[8]; float s = 0.f;
#pragma unroll
    for (int j = 0; j < 8; ++j) { v[j] = xr[64 * j]; s += (v[j].x * v[j].x + v[j].y * v[j].y) + (v[j].z * v[j].z + v[j].w * v[j].w); }
    const float rstd = 1.f / sqrtf(wave_sum(s) * (1.f / DMODEL) + NORM_EPS);
    GAS unsigned long long* o8 = (GAS unsigned long long*)orow + lane;
#pragma unroll
    for (int j = 0; j < 8; ++j) { const f32x4 gg = gr[64 * j]; o8[64 * j] = (unsigned long long)pk2(v[j].x * rstd * gg.x, v[j].y * rstd * gg.y) | ((unsigned long long)pk2(v[j].z * rstd * gg.z, v[j].w * rstd * gg.w) << 32); }
}
__device__ __forceinline__ unsigned q4_i8(float a, float b, float c, float d) {
    const int q0 = (int)__builtin_rintf(a), q1 = (int)__builtin_rintf(b), q2 = (int)__builtin_rintf(c), q3 = (int)__builtin_rintf(d);
    return ((unsigned)q0 & 255u) | (((unsigned)q1 & 255u) << 8) | (((unsigned)q2 & 255u) << 16) | ((unsigned)q3 << 24);
}
__device__ __forceinline__ void row_bf16_to_i8(const bf16* src, unsigned char* dst, float* sci, int lane) {
    v4u w[4]; float am = 0.f;
#pragma unroll
    for (int j = 0; j < 4; ++j) { w[j] = *(const GAS v4u*)(src + 8 * (lane + 64 * j));
        am = fmaxf(fmaxf(am, fabsf(bf_lo(w[j].x))), fabsf(bf_hi(w[j].x))); am = fmaxf(fmaxf(am, fabsf(bf_lo(w[j].y))), fabsf(bf_hi(w[j].y)));
        am = fmaxf(fmaxf(am, fabsf(bf_lo(w[j].z))), fabsf(bf_hi(w[j].z))); am = fmaxf(fmaxf(am, fabsf(bf_lo(w[j].w))), fabsf(bf_hi(w[j].w))); }
    am = wave_max(am);
    const float sc = am > 0.f ? 127.f / am : 1.f;
    typedef unsigned v2u_ __attribute__((ext_vector_type(2)));
#pragma unroll
    for (int j = 0; j < 4; ++j)
        *(GAS v2u_*)(dst + 8 * (lane + 64 * j)) = (v2u_){q4_i8(bf_lo(w[j].x) * sc, bf_hi(w[j].x) * sc, bf_lo(w[j].y) * sc, bf_hi(w[j].y) * sc), q4_i8(bf_lo(w[j].z) * sc, bf_hi(w[j].z) * sc, bf_lo(w[j].w) * sc, bf_hi(w[j].w) * sc)};
    if (lane == 0) *(GAS float*)sci = am > 0.f ? am * (1.f / 127.f) : 1.f;
}
__device__ __forceinline__ void q512_store(float (&f)[8], unsigned char* dst, float* sci, int lane) {
    float am = 0.f;
#pragma unroll
    for (int i = 0; i < 8; ++i) am = fmaxf(am, fabsf(f[i]));
    am = wave_max(am);
    const float sc = am > 0.f ? 127.f / am : 1.f;
    typedef unsigned v2u_ __attribute__((ext_vector_type(2)));
    *(GAS v2u_*)(dst + 8 * lane) = (v2u_){q4_i8(f[0] * sc, f[1] * sc, f[2] * sc, f[3] * sc), q4_i8(f[4] * sc, f[5] * sc, f[6] * sc, f[7] * sc)};
    if (lane == 0) *(GAS float*)sci = am > 0.f ? am * (1.f / 127.f) : 1.f;
}
__device__ __forceinline__ void row512_bf16_to_i8(const bf16* src, unsigned char* dst, float* sci, int lane) {
    const v4u w = *(const GAS v4u*)(src + 8 * lane);
    float f[8] = {bf_lo(w.x), bf_hi(w.x), bf_lo(w.y), bf_hi(w.y), bf_lo(w.z), bf_hi(w.z), bf_lo(w.w), bf_hi(w.w)};
    q512_store(f, dst, sci, lane);
}
__device__ __forceinline__ void rms_row_to_i8(const float* xrow, const float* g, unsigned char* dst, float* sci, int lane) {
    const GAS f32x4* xr = (const GAS f32x4*)xrow + lane; const GAS f32x4* gr = (const GAS f32x4*)g + lane;
    f32x4 v[8]; float s = 0.f;
#pragma unroll
    for (int j = 0; j < 8; ++j) { v[j] = xr[64 * j]; s += (v[j].x * v[j].x + v[j].y * v[j].y) + (v[j].z * v[j].z + v[j].w * v[j].w); }
    const float rstd = 1.f / sqrtf(wave_sum(s) * (1.f / DMODEL) + NORM_EPS);
    float am = 0.f;
#pragma unroll
    for (int j = 0; j < 8; ++j) { const f32x4 gg = gr[64 * j];
        v[j].x = bf_lo(pk2(v[j].x * rstd * gg.x, 0.f)); v[j].y = bf_lo(pk2(v[j].y * rstd * gg.y, 0.f)); v[j].z = bf_lo(pk2(v[j].z * rstd * gg.z, 0.f)); v[j].w = bf_lo(pk2(v[j].w * rstd * gg.w, 0.f));
        am = fmaxf(fmaxf(am, fabsf(v[j].x)), fabsf(v[j].y)); am = fmaxf(fmaxf(am, fabsf(v[j].z)), fabsf(v[j].w)); }
    am = wave_max(am);
    const float isc = am > 0.f ? 127.f / am : 1.f;
    GAS unsigned* o1 = (GAS unsigned*)dst + lane;
#pragma unroll
    for (int j = 0; j < 8; ++j) o1[64 * j] = q4_i8(v[j].x * isc, v[j].y * isc, v[j].z * isc, v[j].w * isc);
    if (lane == 0) *(GAS float*)sci = am > 0.f ? am * (1.f / 127.f) : 1.f;
}
#define CAS __attribute__((address_space(4)))
__device__ __forceinline__ const float* inp(int i) { unsigned off = (unsigned)i * 8u; asm volatile("" : "+s"(off)); const CAS char* kp = (const CAS char*)__builtin_amdgcn_kernarg_segment_ptr(); const __attribute__((address_space(1))) float* r_ = (const __attribute__((address_space(1))) float*)*(const float* const CAS*)(kp + off); asm volatile("" : "+s"(r_)); return (const float*)r_; }
struct LayerW {
    const float *mix_g, *w_in, *gate_b, *q_g, *w_uq, *kv_g, *w_ukv, *mla_wo, *sc_w, *sc_wo, *lam, *diff_g, *diff_wo, *cf_w, *cf_b, *cf_g, *cf_bb, *cf_wo, *w_o, *ffn_g, *w_q, *subk, *pu, *pv;
};
constexpr int CW_TABQ = 24576;
__device__ __forceinline__ void table_row(unsigned char* ws, int layer, int rr, int lane) {
    const int t = rr >= PEER_NE, row = rr - t * PEER_NE;
    const GAS f32x4* src = (const GAS f32x4*)(inp(t ? 25 : 24) + (size_t)layer * PEER_NE * 2048 + (size_t)row * 2048);
    f32x4 v[8]; float am = 0.f;
#pragma unroll
    for (int j = 0; j < 2; ++j)
#pragma unroll
        for (int d = 0; d < 4; ++d) { v[4 * j + d] = src[256 * j + 4 * lane + d]; const f32x4 x = v[4 * j + d]; am = fmaxf(am, fmaxf(fmaxf(fabsf(x.x), fabsf(x.y)), fmaxf(fabsf(x.z), fabsf(x.w)))); }
    am = fmaxf(wave_max(am), 1e-30f);
    const float inv = 400.f / am;
#pragma unroll
    for (int j = 0; j < 2; ++j) { v4u o;
#pragma unroll
        for (int d = 0; d < 4; ++d) { const f32x4 x = v[4 * j + d] * inv; int p = __builtin_amdgcn_cvt_pk_fp8_f32(x.x, x.y, 0, false); p = __builtin_amdgcn_cvt_pk_fp8_f32(x.z, x.w, p, true); o[d] = (unsigned)p; }
        *(GAS v4u*)(ws + (t ? WS_VBF : WS_UBF) + (size_t)row * 2048 + 1024 * j + 16 * lane) = o; }
    if (lane == 0) ((float*)(ws + (t ? WS_VSC : WS_USC)))[row] = am * (1.f / 400.f);
}
__device__ __forceinline__ void tables_dyn(Frame& F, int layer) {
    PHASE_IDS();
    gu32* qw = F.ctl + CW_TABQ + 64 * layer;
    for (;;) {
        unsigned c = 0u; if (lane == 0) c = __hip_atomic_fetch_add(qw, 1u, RLX_AGENT);
        c = (unsigned)__builtin_amdgcn_readfirstlane((int)c);
        if (c >= (unsigned)(2 * PEER_NE / 8)) break;
#pragma unroll 1
        for (int k = 0; k < 8; ++k) table_row(ws, layer, (int)c * 8 + k, lane);
    }
}
__device__ __forceinline__ void p0_prologue(Frame& F, int layer, int part) {
    PHASE_IDS();
    LAS float* scr = (LAS float*)(F.lds + wave * 16384);
    const int gw = obid() * NWAVES + wave, NGW = F.G * NWAVES;
    constexpr int I_IN = 32 * (ZC / 32), I_UQ = 8 * 24, I_UKV = 4 * 32, I_OUT = 8 * 64, I_O = 32 * 64, I_Q = 32 * 32;
    constexpr int NITEMS = I_IN + I_UQ + I_UKV + 4 * I_OUT + I_O + I_Q;
    if (part == 1) {
    for (int it = gw; it < NITEMS; it += NGW) {
        int r = it, ldw, ldt, nblk, mode = 0; const float* src; const float* gk = nullptr; bf16* dst;
        if (r < I_IN) { src = inp(3) + (size_t)layer * 2048 * INC; ldw = INC; dst = (bf16*)(ws + WS_WIN); ldt = 2048; nblk = ZC / 32; mode = 1; }
        else if ((r -= I_IN) < I_UQ) { src = inp(6) + (size_t)layer * 512 * 768; gk = inp(5) + (size_t)layer * 512; ldw = 768; dst = (bf16*)(ws + WS_WUQ); ldt = 512; nblk = 24; mode = 2; }
        else if ((r -= I_UQ) < I_UKV) { src = inp(8) + (size_t)layer * 256 * 1024; gk = inp(7) + (size_t)layer * 256; ldw = 1024; dst = (bf16*)(ws + WS_WUQ) + (size_t)768 * 512; ldt = 512; nblk = 32; }
        else if ((r -= I_UKV) < 4 * I_OUT) { const int br = r / I_OUT; r -= br * I_OUT; src = inp(br == 0 ? 9 : br == 1 ? 11 : br == 2 ? 14 : 19) + (size_t)layer * 512 * 2048; ldw = 2048; dst = (bf16*)(ws + WS_WOUT) + (size_t)br * 2048 * 512; ldt = 512; nblk = 64; }
        else if ((r -= 4 * I_OUT) < I_O) { src = inp(20) + (size_t)layer * 2048 * 2048; ldw = 2048; dst = (bf16*)(ws + WS_WO); ldt = 2048; nblk = 64; }
        else { r -= I_O; src = inp(22) + (size_t)layer * 2048 * 1024; ldw = 1024; dst = (bf16*)(ws + WS_WQ); ldt = 2048; nblk = 32; }
        tr_item(src, ldw, gk, dst, ldt, nblk, r, mode, scr, lane);
    }
    { const float* sk = inp(23) + (size_t)layer * 2 * 128 * 64;
      for (int i = obid() * NTHREADS + tid; i < 2 * 128 * 64 / 8; i += F.G * NTHREADS) { const f32x4 a_ = *(const GAS f32x4*)(sk + 8 * i), b_ = *(const GAS f32x4*)(sk + 8 * i + 4);
          *(GAS v4u*)((bf16*)(ws + WS_SUBK) + 8 * i) = (v4u){pk2(a_.x, a_.y), pk2(a_.z, a_.w), pk2(b_.x, b_.y), pk2(b_.z, b_.w)}; } }
    for (int i = obid() * NTHREADS + tid; i < 1024 * 32; i += F.G * NTHREADS) { const int n = i >> 5, ch = i & 31; unsigned z_ = 0u; asm volatile("" : "+v"(z_)); *(GAS v4u*)((bf16*)(ws + WS_WUQ) + (size_t)(768 + n) * 512 + 256 + 8 * ch) = (v4u){z_, z_, z_, z_}; }
    }
    if (layer == 0 && part == 1) {
        const int* positions = (const int*)inp(1);
        float* cosm = (float*)(ws + WS_COSM); float* sinm = (float*)(ws + WS_SINM); float* cosd = (float*)(ws + WS_COSD); float* sind = (float*)(ws + WS_SIND);
        for (int i = obid() * NTHREADS + tid; i < SEQ * 24; i += F.G * NTHREADS) {
            const int s = i / 24, j = i % 24; const float pos = (float)positions[s];
            const float ex = j < 16 ? (float)j * (1.f / 16.f) : (float)(j - 16) * (1.f / 8.f);
            const float inv = exp2f(-ex * 18.931568569324174f);
            const float ang = pos * inv;
            double rev = (double)ang * 0.15915494309189535; rev -= floor(rev);
            const float fr = (float)rev; const float cv = __builtin_amdgcn_cosf(fr), sv = __builtin_amdgcn_sinf(fr);
            if (j < 16) { cosm[s * 16 + j] = cv; sinm[s * 16 + j] = sv; } else { cosd[s * 8 + (j - 16)] = cv; sind[s * 8 + (j - 16)] = sv; }
        }
        { const float* x = inp(0); const float* mg = inp(2);
          for (int m = gw; m < SEQ; m += NGW) rms_row_to_i8(x + (size_t)m * DMODEL, mg, ws + WS_A8 + (size_t)m * DMODEL, (float*)(ws + WS_SA8) + m, lane); }
    }
}

namespace pg8 {
template <class Fn> __device__ __forceinline__ void walk8(const f32x4 (&acc)[2][2][4][2], int pm, int pn, int wr, int wc, int fr, int fq, Fn f) {
    const int row0 = pm * BM + wr * 64 + fr, col0 = pn * BM + wc * 32 + 8 * fq;
#pragma unroll
    for (int ai = 0; ai < 2; ++ai)
#pragma unroll
        for (int m = 0; m < 4; ++m)
#pragma unroll
            for (int bj = 0; bj < 2; ++bj) f(row0 + ai * HALF + m * 16, col0 + bj * HALF, acc[ai][bj][m][0], acc[ai][bj][m][1]);
}
__device__ __forceinline__ u32x4 pack8(f32x4 v0, f32x4 v1) { u32x4 w; w.x = cvt_pk_bf16(v0[0], v0[1]); w.y = cvt_pk_bf16(v0[2], v0[3]); w.z = cvt_pk_bf16(v1[0], v1[1]); w.w = cvt_pk_bf16(v1[2], v1[3]); return w; }
__device__ __forceinline__ void rope4(f32x4& v0, f32x4& v1, const float* cs, const float* sn) {
    const f32x4 c = *(const f32x4*)cs, s = *(const f32x4*)sn;
    const float a0 = v0[0], b0 = v0[1], a1 = v0[2], b1 = v0[3], a2 = v1[0], b2 = v1[1], a3 = v1[2], b3 = v1[3];
    v0[0] = a0 * c[0] - b0 * s[0]; v0[1] = b0 * c[0] + a0 * s[0]; v0[2] = a1 * c[1] - b1 * s[1]; v0[3] = b1 * c[1] + a1 * s[1];
    v1[0] = a2 * c[2] - b2 * s[2]; v1[1] = b2 * c[2] + a2 * s[2]; v1[2] = a3 * c[3] - b3 * s[3]; v1[3] = b3 * c[3] + a3 * s[3];
}
template <bool I8> struct EpiZT {
    static constexpr bool PERM = true, AFTER_DRAIN = false;
    bf16_t* Z; const float *cosm, *sinm, *cosd, *sind; const float *sa8, *sb8;
    __device__ __forceinline__ void operator()(const f32x4 (&acc)[2][2][4][2], const Unit& u, int wr, int wc, int fr, int fq) const {
        const int row0 = u.pm * BM + wr * 64 + fr, col0 = u.pn * BM + wc * 32 + 8 * fq;
        f32x4 qcb[2][2]; float qra[2][4];
        if constexpr (I8) {
#pragma unroll
            for (int bj = 0; bj < 2; ++bj) { qcb[bj][0] = *(const f32x4*)(sb8 + col0 + bj * HALF); qcb[bj][1] = *(const f32x4*)(sb8 + col0 + bj * HALF + 4); }
#pragma unroll
            for (int ai = 0; ai < 2; ++ai)
#pragma unroll
                for (int m = 0; m < 4; ++m) qra[ai][m] = sa8[row0 + ai * HALF + m * 16];
        }
        auto val = [&](int ai, int bj, int m, int j) -> f32x4 { if constexpr (I8) { typedef int v4i_ __attribute__((ext_vector_type(4))); const v4i_ q = __builtin_bit_cast(v4i_, acc[ai][bj][m][j]);
                return (f32x4){(float)q.x, (float)q.y, (float)q.z, (float)q.w} * qcb[bj][j] * qra[ai][m]; } else return acc[ai][bj][m][j]; };
        const bool tile_d = u.pn >= 9 && u.pn <= 12, tile_k = u.pn == 19;
        if (!(tile_d || tile_k)) {
#pragma unroll
            for (int ai = 0; ai < 2; ++ai)
#pragma unroll
                for (int m = 0; m < 4; ++m)
#pragma unroll
                    for (int bj = 0; bj < 2; ++bj) *(u32x4*)(Z + (size_t)(row0 + ai * HALF + m * 16) * ZC + col0 + bj * HALF) = pack8(val(ai, bj, m, 0), val(ai, bj, m, 1));
            return;
        }
        const int d = tile_d ? (col0 & 63) : (col0 - ZC_KR);
        const bool rot0 = tile_d ? d < 16 : d < 32, rot1 = tile_d ? d < 16 : false;
        const float* cb = tile_d ? cosd : cosm; const float* sb = tile_d ? sind : sinm; const int fstr = tile_d ? 8 : 16, foff = (rot0 ? d : 0) >> 1;
        const float qs = (tile_d && u.pn <= 10) ? C2_DIFF : 1.f;
#pragma unroll
        for (int ai = 0; ai < 2; ++ai) {
            f32x4 cs[4], sn[4];
#pragma unroll
            for (int m = 0; m < 4; ++m) { const int row = row0 + ai * HALF + m * 16; cs[m] = *(const f32x4*)(cb + row * fstr + foff); sn[m] = *(const f32x4*)(sb + row * fstr + foff); }
#pragma unroll
            for (int m = 0; m < 4; ++m)
#pragma unroll
                for (int bj = 0; bj < 2; ++bj) { const int row = row0 + ai * HALF + m * 16; f32x4 v0 = val(ai, bj, m, 0), v1 = val(ai, bj, m, 1);
                    if (bj == 0 ? rot0 : rot1) { const f32x4 c = cs[m], s_ = sn[m];
                        const float a0 = v0[0], b0 = v0[1], a1 = v0[2], b1 = v0[3], a2 = v1[0], b2 = v1[1], a3 = v1[2], b3 = v1[3];
                        v0[0] = a0 * c[0] - b0 * s_[0]; v0[1] = b0 * c[0] + a0 * s_[0]; v0[2] = a1 * c[1] - b1 * s_[1]; v0[3] = b1 * c[1] + a1 * s_[1];
                        v1[0] = a2 * c[2] - b2 * s_[2]; v1[1] = b2 * c[2] + a2 * s_[2]; v1[2] = a3 * c[3] - b3 * s_[3]; v1[3] = b3 * c[3] + a3 * s_[3]; }
                    v0 = v0 * qs; v1 = v1 * qs;
                    *(u32x4*)(Z + (size_t)row * ZC + col0 + bj * HALF) = pack8(v0, v1); }
        }
    }
};
typedef EpiZT<false> EpiZ;
typedef EpiZT<true> EpiZ8;
struct EpiGate8 {
    static constexpr bool PERM = true, AFTER_DRAIN = false;
    bf16_t* Z; const float *sa, *sb; const float *gate_b, *swout;
    __device__ __forceinline__ void operator()(const f32x4 (&acc)[2][2][4][2], const Unit& u, int wr, int wc, int fr, int fq) const {
        typedef int v4i_ __attribute__((ext_vector_type(4)));
        const int row0 = u.pm * BM + wr * 64 + fr, col0 = u.pn * BM + wc * 32 + 8 * fq;
        f32x4 cb[2][2];
#pragma unroll
        for (int bj = 0; bj < 2; ++bj) { cb[bj][0] = *(const f32x4*)(sb + col0 + bj * HALF); cb[bj][1] = *(const f32x4*)(sb + col0 + bj * HALF + 4); }
        f32x4 gb[2][2], gw[2][2];
#pragma unroll
        for (int bj = 0; bj < 2; ++bj) { gb[bj][0] = *(const f32x4*)(gate_b + col0 + bj * HALF); gb[bj][1] = *(const f32x4*)(gate_b + col0 + bj * HALF + 4);
            gw[bj][0] = *(const f32x4*)(swout + col0 + bj * HALF); gw[bj][1] = *(const f32x4*)(swout + col0 + bj * HALF + 4); }
        float ra[2][4];
#pragma unroll
        for (int ai = 0; ai < 2; ++ai)
#pragma unroll
            for (int m = 0; m < 4; ++m) ra[ai][m] = sa[row0 + ai * HALF + m * 16];
#pragma unroll
        for (int ai = 0; ai < 2; ++ai)
#pragma unroll
            for (int m = 0; m < 4; ++m)
#pragma unroll
                for (int bj = 0; bj < 2; ++bj) { const v4i_ i0 = __builtin_bit_cast(v4i_, acc[ai][bj][m][0]), i1 = __builtin_bit_cast(v4i_, acc[ai][bj][m][1]);
                    const f32x4 v0 = (f32x4){(float)i0.x, (float)i0.y, (float)i0.z, (float)i0.w}, v1 = (f32x4){(float)i1.x, (float)i1.y, (float)i1.z, (float)i1.w};
                    f32x4 l0 = v0 * cb[bj][0] * ra[ai][m] + gb[bj][0], l1 = v1 * cb[bj][1] * ra[ai][m] + gb[bj][1];
#pragma unroll
                    for (int e = 0; e < 4; ++e) { l0[e] = sigmoidf_(l0[e]) * gw[bj][0][e]; l1[e] = sigmoidf_(l1[e]) * gw[bj][1][e]; }
                    *(u32x4*)(Z + (size_t)(row0 + ai * HALF + m * 16) * ZC + ZC_GATE + col0 + bj * HALF) = pack8(l0, l1); }
    }
};
struct QKVOrder {
    StaticOrder S0;
    __device__ __forceinline__ bool next(int i, Unit& u) const { if (!S0.next(i, u)) return false; u.ka = u.pn >= 3 ? ZC_CKV : ZC_CQ; return true; }
    __device__ __forceinline__ void a_ready(const Unit&) const {}
    __device__ __forceinline__ void done(const Unit&) const {}
};
struct EpiQKV {
    static constexpr bool PERM = true, AFTER_DRAIN = false;
    bf16_t* QMo; bf16_t* KVo; const float* rstd; const float *cosm, *sinm;
    __device__ __forceinline__ void operator()(const f32x4 (&acc)[2][2][4][2], const Unit& u, int wr, int wc, int fr, int fq) const {
        const bool isq = u.pn < 3;
        const int row0 = u.pm * BM + wr * 64 + fr, col0 = u.pn * BM + wc * 32 + 8 * fq;
        float rs[2][4];
#pragma unroll
        for (int ai = 0; ai < 2; ++ai)
#pragma unroll
            for (int m = 0; m < 4; ++m) rs[ai][m] = rstd[(row0 + ai * HALF + m * 16) * 2 + (isq ? 0 : 1)];
#pragma unroll
        for (int ai = 0; ai < 2; ++ai)
#pragma unroll
            for (int m = 0; m < 4; ++m)
#pragma unroll
                for (int bj = 0; bj < 2; ++bj) { const int row = row0 + ai * HALF + m * 16, col = col0 + bj * HALF; f32x4 v0 = acc[ai][bj][m][0], v1 = acc[ai][bj][m][1];
                    if (isq) {
                        const float sc = rs[ai][m] * C2_MLA; v0 = v0 * sc; v1 = v1 * sc;
                        const int d = col % 96; if (d >= 64) rope4(v0, v1, cosm + row * 16 + ((d - 64) >> 1), sinm + row * 16 + ((d - 64) >> 1));
                        *(u32x4*)(QMo + (size_t)row * QMC + col) = pack8(v0, v1);
                    } else {
                        const float sc = rs[ai][m]; v0 = v0 * sc; v1 = v1 * sc;
                        *(u32x4*)(KVo + (size_t)row * KVC + (col - QMC)) = pack8(v0, v1);
                    } }
    }
};
struct QKVOrder8 {
    StaticOrder S0;
    __device__ __forceinline__ bool next(int i, Unit& u) const { if (!S0.next(i, u)) return false; u.ka = u.pn >= 3 ? 256 : 0; return true; }
    __device__ __forceinline__ void a_ready(const Unit&) const {}
    __device__ __forceinline__ void done(const Unit&) const {}
};
struct EpiQKV8 {
    static constexpr bool PERM = true, AFTER_DRAIN = false;
    bf16_t* QMo; bf16_t* KVo; const float* rstd; const float *cosm, *sinm; const float* sb;
    __device__ __forceinline__ void operator()(const f32x4 (&acc)[2][2][4][2], const Unit& u, int wr, int wc, int fr, int fq) const {
        const bool isq = u.pn < 3;
        const int row0 = u.pm * BM + wr * 64 + fr, col0 = u.pn * BM + wc * 32 + 8 * fq;
        typedef int v4i_ __attribute__((ext_vector_type(4)));
        f32x4 cb[2][2];
#pragma unroll
        for (int bj = 0; bj < 2; ++bj) { cb[bj][0] = *(const f32x4*)(sb + col0 + bj * HALF); cb[bj][1] = *(const f32x4*)(sb + col0 + bj * HALF + 4); }
        float rs[2][4];
#pragma unroll
        for (int ai = 0; ai < 2; ++ai)
#pragma unroll
            for (int m = 0; m < 4; ++m) rs[ai][m] = rstd[(row0 + ai * HALF + m * 16) * 2 + (isq ? 0 : 1)];
#pragma unroll
        for (int ai = 0; ai < 2; ++ai)
#pragma unroll
            for (int m = 0; m < 4; ++m)
#pragma unroll
                for (int bj = 0; bj < 2; ++bj) { const int row = row0 + ai * HALF + m * 16, col = col0 + bj * HALF; const v4i_ q0 = __builtin_bit_cast(v4i_, acc[ai][bj][m][0]), q1 = __builtin_bit_cast(v4i_, acc[ai][bj][m][1]);
                    f32x4 v0 = (f32x4){(float)q0.x, (float)q0.y, (float)q0.z, (float)q0.w} * cb[bj][0], v1 = (f32x4){(float)q1.x, (float)q1.y, (float)q1.z, (float)q1.w} * cb[bj][1];
                    if (isq) {
                        const float sc = rs[ai][m] * C2_MLA; v0 = v0 * sc; v1 = v1 * sc;
                        const int d = col % 96; if (d >= 64) rope4(v0, v1, cosm + row * 16 + ((d - 64) >> 1), sinm + row * 16 + ((d - 64) >> 1));
                        *(u32x4*)(QMo + (size_t)row * QMC + col) = pack8(v0, v1);
                    } else {
                        const float sc = rs[ai][m]; v0 = v0 * sc; v1 = v1 * sc;
                        *(u32x4*)(KVo + (size_t)row * KVC + (col - QMC)) = pack8(v0, v1);
                    } }
    }
};
struct MergedOrder {
    StaticOrder S0;
    __device__ __forceinline__ bool next(int i, Unit& u) const { Unit t; if (!S0.next(i >> 2, t)) return false; const int br = i & 3; u.pm = br * 32 + t.pm; u.pn = br * 8 + t.pn; u.ka = 0; return true; }
    __device__ __forceinline__ void a_ready(const Unit&) const {}
    __device__ __forceinline__ void done(const Unit&) const {}
};
struct EpiMerged {
    static constexpr bool PERM = true, AFTER_DRAIN = false;
    bf16_t* Mg; const bf16_t* Z; const float* gate_b;
    __device__ __forceinline__ void operator()(const f32x4 (&acc)[2][2][4][2], const Unit& u, int wr, int wc, int fr, int fq) const {
        const int br = u.pm >> 5, pm = u.pm & 31, pn = u.pn & 7;
        const int row0 = pm * BM + wr * 64 + fr, col0 = pn * BM + wc * 32 + 8 * fq;
        f32x4 bia[2][2];
#pragma unroll
        for (int bj = 0; bj < 2; ++bj) { bia[bj][0] = *(const f32x4*)(gate_b + br * 2048 + col0 + bj * HALF); bia[bj][1] = *(const f32x4*)(gate_b + br * 2048 + col0 + bj * HALF + 4); }
#pragma unroll
        for (int ai = 0; ai < 2; ++ai) {
            u32x4 gz[4][2], old[4][2];
#pragma unroll
            for (int m = 0; m < 4; ++m)
#pragma unroll
                for (int bj = 0; bj < 2; ++bj) { const int row = row0 + ai * HALF + m * 16, col = col0 + bj * HALF;
                    gz[m][bj] = *(const u32x4*)(Z + (size_t)row * ZC + ZC_GATE + br * 2048 + col);
                    old[m][bj] = br > 0 ? *(const u32x4*)(Mg + (size_t)row * 2048 + col) : (u32x4){0u, 0u, 0u, 0u}; }
#pragma unroll
            for (int m = 0; m < 4; ++m)
#pragma unroll
                for (int bj = 0; bj < 2; ++bj) { const int row = row0 + ai * HALF + m * 16, col = col0 + bj * HALF;
                    const u32x4 g4 = gz[m][bj], o4 = old[m][bj]; const f32x4 v0 = acc[ai][bj][m][0], v1 = acc[ai][bj][m][1], b0 = bia[bj][0], b1 = bia[bj][1];
                    float o[8];
                    o[0] = bf_lo(o4.x) + sigmoidf_(bf_lo(g4.x) + b0[0]) * v0[0]; o[1] = bf_hi(o4.x) + sigmoidf_(bf_hi(g4.x) + b0[1]) * v0[1];
                    o[2] = bf_lo(o4.y) + sigmoidf_(bf_lo(g4.y) + b0[2]) * v0[2]; o[3] = bf_hi(o4.y) + sigmoidf_(bf_hi(g4.y) + b0[3]) * v0[3];
                    o[4] = bf_lo(o4.z) + sigmoidf_(bf_lo(g4.z) + b1[0]) * v1[0]; o[5] = bf_hi(o4.z) + sigmoidf_(bf_hi(g4.z) + b1[1]) * v1[1];
                    o[6] = bf_lo(o4.w) + sigmoidf_(bf_lo(g4.w) + b1[2]) * v1[2]; o[7] = bf_hi(o4.w) + sigmoidf_(bf_hi(g4.w) + b1[3]) * v1[3];
                    u32x4 w; w.x = cvt_pk_bf16(o[0], o[1]); w.y = cvt_pk_bf16(o[2], o[3]); w.z = cvt_pk_bf16(o[4], o[5]); w.w = cvt_pk_bf16(o[6], o[7]);
                    *(u32x4*)(Mg + (size_t)row * 2048 + col) = w; }
        }
    }
};
struct EpiMerged8 {
    static constexpr bool PERM = true, AFTER_DRAIN = false;
    bf16_t* Mg; const bf16_t* Z; const float* sa;
    __device__ __forceinline__ void operator()(const f32x4 (&acc)[2][2][4][2], const Unit& u, int wr, int wc, int fr, int fq) const {
        typedef int v4i_ __attribute__((ext_vector_type(4)));
        const int br = u.pm >> 5, pm = u.pm & 31, pn = u.pn & 7;
        const int row0 = pm * BM + wr * 64 + fr, col0 = pn * BM + wc * 32 + 8 * fq;
#pragma unroll
        for (int ai = 0; ai < 2; ++ai) {
            u32x4 gz[4][2], old[4][2]; float rsc[4];
#pragma unroll
            for (int m = 0; m < 4; ++m) { rsc[m] = sa[br * SEQ + row0 + ai * HALF + m * 16];
#pragma unroll
                for (int bj = 0; bj < 2; ++bj) { const int row = row0 + ai * HALF + m * 16, col = col0 + bj * HALF;
                    gz[m][bj] = *(const u32x4*)(Z + (size_t)row * ZC + ZC_GATE + br * 2048 + col);
                    old[m][bj] = br > 0 ? *(const u32x4*)(Mg + (size_t)row * 2048 + col) : (u32x4){0u, 0u, 0u, 0u}; } }
#pragma unroll
            for (int m = 0; m < 4; ++m)
#pragma unroll
                for (int bj = 0; bj < 2; ++bj) { const int row = row0 + ai * HALF + m * 16, col = col0 + bj * HALF;
                    const u32x4 g4 = gz[m][bj], o4 = old[m][bj]; const v4i_ q0 = __builtin_bit_cast(v4i_, acc[ai][bj][m][0]), q1 = __builtin_bit_cast(v4i_, acc[ai][bj][m][1]); const float rs = rsc[m];
                    float o[8];
                    o[0] = bf_lo(o4.x) + bf_lo(g4.x) * ((float)q0.x * rs); o[1] = bf_hi(o4.x) + bf_hi(g4.x) * ((float)q0.y * rs);
                    o[2] = bf_lo(o4.y) + bf_lo(g4.y) * ((float)q0.z * rs); o[3] = bf_hi(o4.y) + bf_hi(g4.y) * ((float)q0.w * rs);
                    o[4] = bf_lo(o4.z) + bf_lo(g4.z) * ((float)q1.x * rs); o[5] = bf_hi(o4.z) + bf_hi(g4.z) * ((float)q1.y * rs);
                    o[6] = bf_lo(o4.w) + bf_lo(g4.w) * ((float)q1.z * rs); o[7] = bf_hi(o4.w) + bf_hi(g4.w) * ((float)q1.w * rs);
                    u32x4 w; w.x = cvt_pk_bf16(o[0], o[1]); w.y = cvt_pk_bf16(o[2], o[3]); w.z = cvt_pk_bf16(o[4], o[5]); w.w = cvt_pk_bf16(o[6], o[7]);
                    *(u32x4*)(Mg + (size_t)row * 2048 + col) = w; }
        }
    }
};
struct EpiResF32 {
    static constexpr bool PERM = false, AFTER_DRAIN = false;
    const float* base; float* C; int ldc;
    __device__ __forceinline__ void operator()(const f32x4 (&acc)[2][2][4][2], const Unit& u, int wr, int wc, int fr, int fq) const {
        const int row0 = u.pm * BM + wr * 64 + fr, col0 = u.pn * BM + wc * 32 + 4 * fq;
#pragma unroll
        for (int ai = 0; ai < 2; ++ai) {
            f32x4 pre[4][2][2];
            if (base) {
#pragma unroll
                for (int m = 0; m < 4; ++m) { const size_t ro = (size_t)(row0 + ai * HALF + m * 16) * ldc + col0;
#pragma unroll
                    for (int bj = 0; bj < 2; ++bj)
#pragma unroll
                        for (int n = 0; n < 2; ++n) pre[m][bj][n] = *(const f32x4*)(base + ro + bj * HALF + n * 16); }
            }
#pragma unroll
            for (int m = 0; m < 4; ++m) { const size_t ro = (size_t)(row0 + ai * HALF + m * 16) * ldc + col0;
#pragma unroll
                for (int bj = 0; bj < 2; ++bj)
#pragma unroll
                    for (int n = 0; n < 2; ++n) { f32x4 v = acc[ai][bj][m][n]; if (base) v = v + pre[m][bj][n]; *(f32x4*)(C + ro + bj * HALF + n * 16) = v; } }
        }
    }
};
struct EpiPQ8 {
    static constexpr bool PERM = false, AFTER_DRAIN = false;
    float* C; const float *hsci, *sb;
    __device__ __forceinline__ void operator()(const f32x4 (&acc)[2][2][4][2], const Unit& u, int wr, int wc, int fr, int fq) const {
        typedef int v4i_ __attribute__((ext_vector_type(4)));
        const int row0 = u.pm * BM + wr * 64 + fr, col0 = u.pn * BM + wc * 32 + 4 * fq;
        f32x4 cb[2][2]; float ra[2][4];
#pragma unroll
        for (int bj = 0; bj < 2; ++bj)
#pragma unroll
            for (int n = 0; n < 2; ++n) cb[bj][n] = *(const f32x4*)(sb + col0 + bj * HALF + n * 16);
#pragma unroll
        for (int ai = 0; ai < 2; ++ai)
#pragma unroll
            for (int m = 0; m < 4; ++m) ra[ai][m] = hsci[row0 + ai * HALF + m * 16] * (224.f / 127.f);
#pragma unroll
        for (int ai = 0; ai < 2; ++ai)
#pragma unroll
            for (int m = 0; m < 4; ++m) { const size_t ro = (size_t)(row0 + ai * HALF + m * 16) * 1024 + col0;
#pragma unroll
                for (int bj = 0; bj < 2; ++bj)
#pragma unroll
                    for (int n = 0; n < 2; ++n) { const v4i_ q = __builtin_bit_cast(v4i_, acc[ai][bj][m][n]);
                        *(f32x4*)(C + ro + bj * HALF + n * 16) = (f32x4){(float)q.x, (float)q.y, (float)q.z, (float)q.w} * cb[bj][n] * ra[ai][m]; } }
    }
};
struct EpiRes8 {
    static constexpr bool PERM = false, AFTER_DRAIN = false;
    const float* base; float* C; const float *sa, *sb;
    __device__ __forceinline__ void operator()(const f32x4 (&acc)[2][2][4][2], const Unit& u, int wr, int wc, int fr, int fq) const {
        typedef int v4i_ __attribute__((ext_vector_type(4)));
        const int row0 = u.pm * BM + wr * 64 + fr, col0 = u.pn * BM + wc * 32 + 4 * fq;
        f32x4 cb[2][2];
#pragma unroll
        for (int bj = 0; bj < 2; ++bj)
#pragma unroll
            for (int n = 0; n < 2; ++n) cb[bj][n] = *(const f32x4*)(sb + col0 + bj * HALF + n * 16);
#pragma unroll
        for (int ai = 0; ai < 2; ++ai) {
            f32x4 pre[4][2][2]; float ra[4];
#pragma unroll
            for (int m = 0; m < 4; ++m) { const size_t ro = (size_t)(row0 + ai * HALF + m * 16) * 2048 + col0; ra[m] = sa[row0 + ai * HALF + m * 16];
#pragma unroll
                for (int bj = 0; bj < 2; ++bj)
#pragma unroll
                    for (int n = 0; n < 2; ++n) pre[m][bj][n] = *(const f32x4*)(base + ro + bj * HALF + n * 16); }
#pragma unroll
            for (int m = 0; m < 4; ++m) { const size_t ro = (size_t)(row0 + ai * HALF + m * 16) * 2048 + col0;
#pragma unroll
                for (int bj = 0; bj < 2; ++bj)
#pragma unroll
                    for (int n = 0; n < 2; ++n) { const v4i_ q = __builtin_bit_cast(v4i_, acc[ai][bj][m][n]);
                        *(f32x4*)(C + ro + bj * HALF + n * 16) = (f32x4){(float)q.x, (float)q.y, (float)q.z, (float)q.w} * cb[bj][n] * ra[m] + pre[m][bj][n]; } }
        }
    }
};
}

__device__ __forceinline__ void p2_branch_prep(Frame& F, int layer) {
    LayerW W; W.sc_w = inp(10) + (size_t)layer * 3 * 512; W.cf_w = inp(15) + (size_t)layer * 31 * 512; W.cf_b = inp(16) + (size_t)layer * 512; W.cf_g = inp(17) + (size_t)layer * 512; W.cf_bb = inp(18) + (size_t)layer * 512;
    PHASE_IDS();
    const bf16* Z = (const bf16*)(ws + WS_Z);
    float* rstd = (float*)(ws + WS_RSTD);
    bf16* act_sc = (bf16*)(ws + WS_ACT) + (size_t)1 * SEQ * 512;
    bf16* act_cf = (bf16*)(ws + WS_ACT) + (size_t)3 * SEQ * 512;
    LAS float* ul = (LAS float*)F.lds;
    LAS float* part = (LAS float*)(F.lds + LDS_PART_OFF);
    asm volatile("" : "+v"(part));
    const int c = tid;
    for (int tile = obid(); tile < SEQ / 32; tile += F.G) {
        const int t0 = tile * 32;
#pragma unroll
        for (int i = 0; i < 4; ++i) { const int tok = t0 + 4 * wave + i;
            const v4u a = *(const GAS v4u*)(Z + (size_t)tok * ZC + ZC_CQ + 8 * lane);
            float s = bf_lo(a.x) * bf_lo(a.x) + bf_hi(a.x) * bf_hi(a.x) + bf_lo(a.y) * bf_lo(a.y) + bf_hi(a.y) * bf_hi(a.y) + bf_lo(a.z) * bf_lo(a.z) + bf_hi(a.z) * bf_hi(a.z) + bf_lo(a.w) * bf_lo(a.w) + bf_hi(a.w) * bf_hi(a.w);
            s = wave_sum(s);
            const unsigned long long b = *(const GAS unsigned long long*)(Z + (size_t)tok * ZC + ZC_CKV + 4 * lane);
            const unsigned b0 = (unsigned)b, b1 = (unsigned)(b >> 32);
            float s2 = bf_lo(b0) * bf_lo(b0) + bf_hi(b0) * bf_hi(b0) + bf_lo(b1) * bf_lo(b1) + bf_hi(b1) * bf_hi(b1);
            s2 = wave_sum(s2);
            float aq = fmaxf(fmaxf(fmaxf(fabsf(bf_lo(a.x)), fabsf(bf_hi(a.x))), fmaxf(fabsf(bf_lo(a.y)), fabsf(bf_hi(a.y)))), fmaxf(fmaxf(fabsf(bf_lo(a.z)), fabsf(bf_hi(a.z))), fmaxf(fabsf(bf_lo(a.w)), fabsf(bf_hi(a.w)))));
            float ak = fmaxf(fmaxf(fabsf(bf_lo(b0)), fabsf(bf_hi(b0))), fmaxf(fabsf(bf_lo(b1)), fabsf(bf_hi(b1))));
            aq = wave_max(aq); ak = wave_max(ak);
            const float iq = aq > 0.f ? 127.f / aq : 1.f, ik = ak > 0.f ? 127.f / ak : 1.f;
            { typedef unsigned v2u_ __attribute__((ext_vector_type(2))); unsigned char* qa = ws + WS_QA8 + (size_t)tok * 1024;
              *(GAS v2u_*)(qa + 8 * lane) = (v2u_){q4_i8(bf_lo(a.x) * iq, bf_hi(a.x) * iq, bf_lo(a.y) * iq, bf_hi(a.y) * iq), q4_i8(bf_lo(a.z) * iq, bf_hi(a.z) * iq, bf_lo(a.w) * iq, bf_hi(a.w) * iq)};
              *(GAS unsigned*)(qa + 512 + 4 * lane) = q4_i8(bf_lo(b0) * ik, bf_hi(b0) * ik, bf_lo(b1) * ik, bf_hi(b1) * ik); }
            if (lane == 0) { rstd[tok * 2] = (1.f / sqrtf(s * (1.f / 512.f) + NORM_EPS)) * (aq > 0.f ? aq * (1.f / 127.f) : 1.f); rstd[tok * 2 + 1] = (1.f / sqrtf(s2 * (1.f / 256.f) + NORM_EPS)) * (ak > 0.f ? ak * (1.f / 127.f) : 1.f); } }
        { const float w0 = W.sc_w[c], w1 = W.sc_w[512 + c], w2 = W.sc_w[1024 + c];
          bf16 vb[32], vc[34], vx[34];
#pragma unroll
          for (int t = 0; t < 34; ++t) { const int rw = t0 + t - 2; const bool ok = rw >= 0; const GAS bf16* q = (const GAS bf16*)(Z + (size_t)(ok ? rw : 0) * ZC);
            const bf16 cg_ = q[ZC_CG + c], xv_ = q[ZC_XV + c]; vc[t] = ok ? cg_ : (bf16)0; vx[t] = ok ? xv_ : (bf16)0; if (t >= 2) vb[t - 2] = q[ZC_BG + c]; }
          GAS bf16* op = (GAS bf16*)(act_sc + (size_t)t0 * 512 + c);
#pragma unroll
          for (int t = 0; t < 32; ++t) { const float y = w0 * (bf2f(vc[t]) * bf2f(vx[t])) + w1 * (bf2f(vc[t + 1]) * bf2f(vx[t + 1])) + w2 * (bf2f(vc[t + 2]) * bf2f(vx[t + 2]));
            *op = (bf16)f2bf(bf2f(vb[t]) * y); op += 512; asm volatile("" : "+v"(op)); } }
        float y[32];
        { float u[62];
          { bf16 va[62], vg[62];
#pragma unroll
            for (int r = 0; r < 62; ++r) { const int rw = t0 + r - 30; const bool ok = rw >= 0; const GAS bf16* q = (const GAS bf16*)(Z + (size_t)(ok ? rw : 0) * ZC);
              const bf16 a_ = q[ZC_CA + c], g_ = q[ZC_CGT + c]; va[r] = ok ? a_ : (bf16)0; vg[r] = ok ? g_ : (bf16)0; }
#pragma unroll
            for (int r = 0; r < 62; ++r) u[r] = bf2f(va[r]) * sigmoidf_(bf2f(vg[r])); }
          const float bias = W.cf_b[c];
#pragma unroll
          for (int t = 0; t < 32; ++t) y[t] = bias;
#pragma unroll
          for (int j = 0; j < 31; ++j) { const float wj = W.cf_w[j * 512 + c];
#pragma unroll
            for (int t = 0; t < 32; ++t) y[t] += wj * u[t + j]; } }
#pragma unroll
        for (int t = 0; t < 32; ++t) ul[t * 512 + c] = y[t];
        __syncthreads();
        { const int tt = tid >> 4, seg = tid & 15; float s_ = 0.f, q_ = 0.f;
#pragma unroll
          for (int k = 0; k < 8; ++k) { const f32x4 v4 = *(const LAS f32x4*)(ul + tt * 512 + 64 * k + 4 * seg); s_ += (v4.x + v4.y) + (v4.z + v4.w); q_ += (v4.x * v4.x + v4.y * v4.y) + (v4.z * v4.z + v4.w * v4.w); }
          s_ = row16_sum(s_); q_ = row16_sum(q_);
          const float mean = s_ * (1.f / 512.f); const float var = fmaxf(q_ * (1.f / 512.f) - mean * mean, 0.f);
          if (seg == 0) { part[2 * tt] = mean; part[2 * tt + 1] = __builtin_amdgcn_rsqf(var + LN_EPS); } }
        __syncthreads();
        { const float g = W.cf_g[c], bb = W.cf_bb[c]; GAS bf16* ocf = (GAS bf16*)(act_cf + (size_t)t0 * 512 + c);
#pragma unroll
          for (int t = 0; t < 32; ++t) { const float mean = part[2 * t], rs = part[2 * t + 1];
            const float v = (y[t] - mean) * rs * g + bb;
            *ocf = (bf16)f2bf(v * sigmoidf_(v)); ocf += 512; asm volatile("" : "+v"(ocf)); } }
        __syncthreads();
    }
}

typedef float f32x16 __attribute__((ext_vector_type(16)));
typedef short s16x4 __attribute__((ext_vector_type(4)));
typedef unsigned u32x2 __attribute__((ext_vector_type(2)));
__device__ __forceinline__ s16x4 vtr(const LAS unsigned char* p) { return __builtin_bit_cast(s16x4, __builtin_amdgcn_ds_read_tr16_b64_v4i16((LAS s16x4*)p)); }
__device__ __forceinline__ float amax3(float a, float b, float c) { float r; asm("v_max3_f32 %0, %1, %2, %3" : "=v"(r) : "v"(a), "v"(b), "v"(c)); return r; }
__device__ __forceinline__ float xhalf_max(float m) { auto rr = __builtin_amdgcn_permlane32_swap(__builtin_bit_cast(unsigned, m), __builtin_bit_cast(unsigned, m), false, false); return fmaxf(__builtin_bit_cast(float, rr[0]), __builtin_bit_cast(float, rr[1])); }
__device__ __forceinline__ float xhalf_sum(float m) { auto rr = __builtin_amdgcn_permlane32_swap(__builtin_bit_cast(unsigned, m), __builtin_bit_cast(unsigned, m), false, false); return __builtin_bit_cast(float, rr[0]) + __builtin_bit_cast(float, rr[1]); }

constexpr int ATT_KBUF = 64 * 208, ATT_VBUF = 64 * 320, ATT_STAGE = ATT_KBUF + ATT_VBUF;
template <int TYPE> __device__ __forceinline__ void attn_unit(Frame& F, int head, int qb) {
    constexpr int KS = TYPE == 0 ? 6 : 4, DT = TYPE == 0 ? 2 : 4, KP = TYPE == 0 ? 208 : 144, VP = TYPE == 0 ? 192 : 320;
    PHASE_IDS();
    const int r32 = lane & 31, hh = lane >> 5;
    const bf16* Z = (const bf16*)(ws + WS_Z); const bf16* QM = (const bf16*)(ws + WS_QM); const bf16* KVM = (const bf16*)(ws + WS_KVM);
    LAS unsigned char* lds = F.lds;
    const int row = qb * 256 + wave * 32 + r32;
    bf16x8 qf[KS];
    { const bf16* qp = TYPE == 0 ? QM + (size_t)row * QMC + head * 96 + 8 * hh : Z + (size_t)row * ZC + ZC_DQ + (head >> 1) * 128 + (head & 1) * 64 + 8 * hh;
#pragma unroll
      for (int ks = 0; ks < KS; ++ks) qf[ks] = *(const GAS bf16x8*)(qp + 16 * ks); }
    f32x16 o[DT];
#pragma unroll
    for (int d = 0; d < DT; ++d) o[d] = (f32x16){0.f, 0.f, 0.f, 0.f, 0.f, 0.f, 0.f, 0.f, 0.f, 0.f, 0.f, 0.f, 0.f, 0.f, 0.f, 0.f};
    float mrun = 0.f, lrun = 0.f;
    f32x16 negm = (f32x16){0.f, 0.f, 0.f, 0.f, 0.f, 0.f, 0.f, 0.f, 0.f, 0.f, 0.f, 0.f, 0.f, 0.f, 0.f, 0.f};
    const int NT = qb * 4 + 4, tmax = qb * 4 + (wave >> 1);
    v4u sa0 = (v4u){0u, 0u, 0u, 0u}, sa1 = sa0, sa2 = sa0, sb0 = sa0, sb1 = sa0, sb2 = sa0;
    const bf16 *g0, *g1, *g2; int l0, l1, l2; bool has1;
    if (TYPE == 0) {
        { const int key = tid / 12, ch = tid % 12; g0 = ch < 8 ? KVM + (size_t)key * KVC + head * 128 + 8 * ch : Z + (size_t)key * ZC + ZC_KR + 8 * (ch - 8); l0 = key * KP + ch * 16; }
        { const int cid = tid + 512, key = cid / 12, ch = cid % 12; has1 = tid < 256; const int keyc = has1 ? key : 0; g1 = ch < 8 ? KVM + (size_t)keyc * KVC + head * 128 + 8 * ch : Z + (size_t)keyc * ZC + ZC_KR + 8 * (ch - 8); l1 = keyc * KP + ch * 16; }
        { const int key = tid >> 3, ch = tid & 7; g2 = KVM + (size_t)key * KVC + head * 128 + 64 + 8 * ch; l2 = ATT_KBUF + key * VP + ch * 16; }
    } else {
        { const int key = tid >> 3, ch = tid & 7; g0 = Z + (size_t)key * ZC + ZC_DK + (head >> 1) * 128 + (head & 1) * 64 + 8 * ch; l0 = key * KP + ch * 16; }
        { const int key = tid >> 4, ch = tid & 15; g1 = Z + (size_t)key * ZC + ZC_DV + (head >> 1) * 128 + 8 * ch; l1 = ATT_KBUF + key * VP + ch * 16; has1 = true; }
        { const int cid = tid + 512, key = cid >> 4, ch = cid & 15; g2 = Z + (size_t)key * ZC + ZC_DV + (head >> 1) * 128 + 8 * ch; l2 = ATT_KBUF + key * VP + ch * 16; }
    }
    const size_t gstep0 = (size_t)64 * ((TYPE == 0 && (tid % 12) < 8) ? KVC : ZC);
    const size_t gstep1 = (size_t)64 * ((TYPE == 0 && ((tid + 512) % 12) < 8) ? KVC : ZC);
    const size_t gstep2 = (size_t)64 * (TYPE == 0 ? KVC : ZC);
#define ATT_LOAD(S, t) do { S##0 = *(const GAS v4u*)(g0 + (size_t)(t) * gstep0); if (has1) S##1 = *(const GAS v4u*)(g1 + (size_t)(t) * gstep1); S##2 = *(const GAS v4u*)(g2 + (size_t)(t) * gstep2); } while (0)
#define ATT_WRITE(S, buf) do { LAS unsigned char* b_ = lds + (buf) * ATT_STAGE; *(LAS v4u*)(b_ + l0) = S##0; if (has1) *(LAS v4u*)(b_ + l1) = S##1; *(LAS v4u*)(b_ + l2) = S##2; } while (0)
    const int koff = r32 * KP + hh * 16;
    const int voff = ATT_KBUF + (4 * hh + ((lane & 15) >> 2)) * VP + (16 * ((lane >> 4) & 1) + 4 * (lane & 3)) * 2;
    ATT_LOAD(sa, 0); ATT_WRITE(sa, 0); ATT_LOAD(sb, 1); __syncthreads();
    if (wave >= 4) __builtin_amdgcn_s_setprio(1);
    for (int t0 = 0; t0 < NT; t0 += 2) {
      { const int t = t0 + 0;
        if (t + 2 < NT) ATT_LOAD(sa, t + 2);
        if (t <= tmax) {
            const LAS unsigned char* kb_ = lds + (t & 1) * ATT_STAGE;
            f32x16 p0, p1; bf16x8 ka_[KS], kc_[KS];
#pragma unroll
            for (int ks = 0; ks < KS; ++ks) { ka_[ks] = *(const LAS bf16x8*)(kb_ + koff + ks * 32); kc_[ks] = *(const LAS bf16x8*)(kb_ + koff + 32 * KP + ks * 32); }
            __builtin_amdgcn_sched_barrier(0);
#pragma unroll
            for (int ks = 0; ks < KS; ++ks) {
                if (ks == 0) { p0 = __builtin_amdgcn_mfma_f32_32x32x16_bf16(ka_[0], qf[0], negm, 0, 0, 0); p1 = __builtin_amdgcn_mfma_f32_32x32x16_bf16(kc_[0], qf[0], negm, 0, 0, 0); }
                else { p0 = __builtin_amdgcn_mfma_f32_32x32x16_bf16(ka_[ks], qf[ks], p0, 0, 0, 0); p1 = __builtin_amdgcn_mfma_f32_32x32x16_bf16(kc_[ks], qf[ks], p1, 0, 0, 0); }
            }
            s16x4 vlo_[2][DT], vhi_[2][DT];
#pragma unroll
            for (int d = 0; d < DT; ++d) { vlo_[0][d] = vtr(kb_ + voff + d * 64); vhi_[0][d] = vtr(kb_ + voff + 8 * VP + d * 64); }
            __builtin_amdgcn_sched_barrier(0);
            asm volatile("s_nop 15\n\ts_nop 7" : "+v"(p0), "+v"(p1));
            float mt;
            { float ma = amax3(p0[0], p0[1], p1[0]), mb = amax3(p0[2], p0[3], p1[1]); ma = amax3(ma, p1[2], p1[3]);
#pragma unroll
              for (int r = 4; r < 16; r += 4) { ma = amax3(ma, p0[r], p0[r + 1]); mb = amax3(mb, p0[r + 2], p0[r + 3]); ma = amax3(ma, p1[r], p1[r + 1]); mb = amax3(mb, p1[r + 2], p1[r + 3]); }
              mt = xhalf_max(amax3(ma, mb, mb)); }
            if (__any(t == 0 || mt > 4.0f)) {
                const float dl = t == 0 ? mt : fmaxf(mt, 0.f); mrun += dl;
                const float alpha = __builtin_amdgcn_exp2f(-dl); lrun *= alpha;
#pragma unroll
                for (int d = 0; d < DT; ++d) o[d] = o[d] * alpha;
#pragma unroll
                for (int r = 0; r < 16; ++r) { p0[r] -= dl; p1[r] -= dl; negm[r] = -mrun; }
            }
            float ls = 0.f;
#pragma unroll
            for (int s2 = 0; s2 < 4; ++s2) {
                if (s2 < 3) {
#pragma unroll
                    for (int d = 0; d < DT; ++d) { vlo_[(s2 + 1) & 1][d] = vtr(kb_ + voff + (16 * (s2 + 1)) * VP + d * 64); vhi_[(s2 + 1) & 1][d] = vtr(kb_ + voff + (16 * (s2 + 1) + 8) * VP + d * 64); } }
                f32x16& pp = s2 < 2 ? p0 : p1; const int b8 = 8 * (s2 & 1);
                float e_[8];
#pragma unroll
                for (int r = 0; r < 8; ++r) { e_[r] = __builtin_amdgcn_exp2f(pp[b8 + r]); ls += e_[r]; }
                v4u w_; w_.x = pg8::cvt_pk_bf16(e_[0], e_[1]); w_.y = pg8::cvt_pk_bf16(e_[2], e_[3]); w_.z = pg8::cvt_pk_bf16(e_[4], e_[5]); w_.w = pg8::cvt_pk_bf16(e_[6], e_[7]);
                const bf16x8 pf_ = __builtin_bit_cast(bf16x8, w_);
#pragma unroll
                for (int d = 0; d < DT; ++d) { const bf16x8 vf = (bf16x8){vlo_[s2 & 1][d][0], vlo_[s2 & 1][d][1], vlo_[s2 & 1][d][2], vlo_[s2 & 1][d][3], vhi_[s2 & 1][d][0], vhi_[s2 & 1][d][1], vhi_[s2 & 1][d][2], vhi_[s2 & 1][d][3]};
                    o[d] = __builtin_amdgcn_mfma_f32_32x32x16_bf16(vf, pf_, o[d], 0, 0, 0); }
                __builtin_amdgcn_sched_barrier(0);
            }
            lrun += ls;
        }
        if (t + 1 < NT) ATT_WRITE(sb, (t + 1) & 1);
        __syncthreads();
      }
      { const int t = t0 + 1;
        if (t + 2 < NT) ATT_LOAD(sb, t + 2);
        if (t <= tmax) {
            const LAS unsigned char* kb_ = lds + (t & 1) * ATT_STAGE;
            f32x16 p0, p1; bf16x8 ka_[KS], kc_[KS];
#pragma unroll
            for (int ks = 0; ks < KS; ++ks) { ka_[ks] = *(const LAS bf16x8*)(kb_ + koff + ks * 32); kc_[ks] = *(const LAS bf16x8*)(kb_ + koff + 32 * KP + ks * 32); }
            __builtin_amdgcn_sched_barrier(0);
#pragma unroll
            for (int ks = 0; ks < KS; ++ks) {
                if (ks == 0) { p0 = __builtin_amdgcn_mfma_f32_32x32x16_bf16(ka_[0], qf[0], negm, 0, 0, 0); p1 = __builtin_amdgcn_mfma_f32_32x32x16_bf16(kc_[0], qf[0], negm, 0, 0, 0); }
                else { p0 = __builtin_amdgcn_mfma_f32_32x32x16_bf16(ka_[ks], qf[ks], p0, 0, 0, 0); p1 = __builtin_amdgcn_mfma_f32_32x32x16_bf16(kc_[ks], qf[ks], p1, 0, 0, 0); }
            }
            s16x4 vlo_[2][DT], vhi_[2][DT];
#pragma unroll
            for (int d = 0; d < DT; ++d) { vlo_[0][d] = vtr(kb_ + voff + d * 64); vhi_[0][d] = vtr(kb_ + voff + 8 * VP + d * 64); }
            __builtin_amdgcn_sched_barrier(0);
            asm volatile("s_nop 15\n\ts_nop 7" : "+v"(p0), "+v"(p1));
            float mt;
            { float ma = amax3(p0[0], p0[1], p1[0]), mb = amax3(p0[2], p0[3], p1[1]); ma = amax3(ma, p1[2], p1[3]);
#pragma unroll
              for (int r = 4; r < 16; r += 4) { ma = amax3(ma, p0[r], p0[r + 1]); mb = amax3(mb, p0[r + 2], p0[r + 3]); ma = amax3(ma, p1[r], p1[r + 1]); mb = amax3(mb, p1[r + 2], p1[r + 3]); }
              mt = xhalf_max(amax3(ma, mb, mb)); }
            if (__any(t == 0 || mt > 4.0f)) {
                const float dl = t == 0 ? mt : fmaxf(mt, 0.f); mrun += dl;
                const float alpha = __builtin_amdgcn_exp2f(-dl); lrun *= alpha;
#pragma unroll
                for (int d = 0; d < DT; ++d) o[d] = o[d] * alpha;
#pragma unroll
                for (int r = 0; r < 16; ++r) { p0[r] -= dl; p1[r] -= dl; negm[r] = -mrun; }
            }
            float ls = 0.f;
#pragma unroll
            for (int s2 = 0; s2 < 4; ++s2) {
                if (s2 < 3) {
#pragma unroll
                    for (int d = 0; d < DT; ++d) { vlo_[(s2 + 1) & 1][d] = vtr(kb_ + voff + (16 * (s2 + 1)) * VP + d * 64); vhi_[(s2 + 1) & 1][d] = vtr(kb_ + voff + (16 * (s2 + 1) + 8) * VP + d * 64); } }
                f32x16& pp = s2 < 2 ? p0 : p1; const int b8 = 8 * (s2 & 1);
                float e_[8];
#pragma unroll
                for (int r = 0; r < 8; ++r) { e_[r] = __builtin_amdgcn_exp2f(pp[b8 + r]); ls += e_[r]; }
                v4u w_; w_.x = pg8::cvt_pk_bf16(e_[0], e_[1]); w_.y = pg8::cvt_pk_bf16(e_[2], e_[3]); w_.z = pg8::cvt_pk_bf16(e_[4], e_[5]); w_.w = pg8::cvt_pk_bf16(e_[6], e_[7]);
                const bf16x8 pf_ = __builtin_bit_cast(bf16x8, w_);
#pragma unroll
                for (int d = 0; d < DT; ++d) { const bf16x8 vf = (bf16x8){vlo_[s2 & 1][d][0], vlo_[s2 & 1][d][1], vlo_[s2 & 1][d][2], vlo_[s2 & 1][d][3], vhi_[s2 & 1][d][0], vhi_[s2 & 1][d][1], vhi_[s2 & 1][d][2], vhi_[s2 & 1][d][3]};
                    o[d] = __builtin_amdgcn_mfma_f32_32x32x16_bf16(vf, pf_, o[d], 0, 0, 0); }
                __builtin_amdgcn_sched_barrier(0);
            }
            lrun += ls;
        }
        if (t + 1 < NT) ATT_WRITE(sa, (t + 1) & 1);
        __syncthreads();
      }
    }
#undef ATT_LOAD
#undef ATT_WRITE
    __builtin_amdgcn_s_setprio(0);
    const float inv = 1.f / xhalf_sum(lrun);
    bf16* outp = TYPE == 0 ? (bf16*)(ws + WS_ACT) + (size_t)row * 512 + head * 64 : (bf16*)(ws + WS_DO) + (size_t)(head & 1) * SEQ * 512 + (size_t)row * 512 + (head >> 1) * 128;
#pragma unroll
    for (int d = 0; d < DT; ++d)
#pragma unroll
        for (int g = 0; g < 4; ++g) { u32x2 w; w.x = pg8::cvt_pk_bf16(o[d][4 * g] * inv, o[d][4 * g + 1] * inv); w.y = pg8::cvt_pk_bf16(o[d][4 * g + 2] * inv, o[d][4 * g + 3] * inv);
            *(GAS u32x2*)(outp + 32 * d + 8 * g + 4 * hh) = w; }
}
constexpr int ATT_NCONV = 64;
__device__ __forceinline__ void p4_attention(Frame& F, int layer) {
    const int tid = otid(F.wv);
    gu32* head_w = F.ctl + CW_QATT + 64 * layer;
    const bool conv_first = obid() < ATT_NCONV;
    if (conv_first) tables_dyn(F, layer >> 1);
    for (;;) {
        __syncthreads();
        if (tid == 0) F.MISC[0] = __hip_atomic_fetch_add(head_w, 1u, RLX_AGENT);
        __syncthreads();
        const unsigned u = F.MISC[0];
        if (u >= 512u) break;
        const int qb = 31 - (int)(u >> 4), r = (int)(u & 15);
        if (r < 8) attn_unit<1>(F, r, qb); else attn_unit<0>(F, r - 8, qb);
    }
    if (!conv_first) tables_dyn(F, layer >> 1);
}


#ifndef MK_CHECK
#define MK_CHECK 0
#endif
constexpr int CW_CHK = 20480;
#if MK_CHECK
__device__ __forceinline__ void mla_check(Frame& F, int layer) {
    PHASE_IDS();
    const int b = obid();
    const bf16* Z = (const bf16*)(ws + WS_Z);
    const int* positions = (const int*)inp(1);
    LAS float* L = (LAS float*)F.lds;
    if (b < 16) {
        const int i = (b * 523 + 100 + layer * 37) % SEQ, h = b % 8, lim = (i / 64 + 1) * 64;
        const float* w_uq = inp(6) + (size_t)layer * 512 * 768; const float* g_q = inp(5) + (size_t)layer * 512;
        const float* w_ukv = inp(8) + (size_t)layer * 256 * 1024; const float* g_kv = inp(7) + (size_t)layer * 256;
        LAS float* qn = L; LAS float* q = L + 512; LAS float* qk = L + 640; LAS float* red = L + 1024; LAS float* pk = L + 2048; LAS float* sc = L + 4096; LAS float* rs = L + 4096 + 8192;
        { float v = bf2f(Z[(size_t)i * ZC + ZC_CQ + tid]); red[tid] = v * v; __syncthreads();
          for (int o = 256; o > 0; o >>= 1) { if (tid < o) red[tid] += red[tid + o]; __syncthreads(); }
          const float rstd = 1.f / sqrtf(red[0] / 512.f + NORM_EPS); __syncthreads();
          qn[tid] = v * rstd * g_q[tid]; __syncthreads(); }
        if (tid < 96) { float a = 0.f; for (int k = 0; k < 512; ++k) a += qn[k] * w_uq[(size_t)k * 768 + h * 96 + tid]; q[tid] = a; }
        __syncthreads();
        if (tid < 16) { const float pos = (float)positions[i]; const float inv = exp2f(-(float)tid * (1.f / 16.f) * 18.931568569324174f); const float ang = pos * inv; double rev = (double)ang * 0.15915494309189535; rev -= floor(rev); const float c = __builtin_amdgcn_cosf((float)rev), sn = __builtin_amdgcn_sinf((float)rev);
            const float x1 = q[64 + tid], x2 = q[80 + tid]; q[64 + tid] = x1 * c - x2 * sn; q[80 + tid] = x2 * c + x1 * sn; }
        __syncthreads();
        if (tid < 256) { float a = 0.f; for (int d = 0; d < 64; ++d) a += q[d] * w_ukv[(size_t)tid * 1024 + h * 128 + d]; qk[tid] = a; }
        __syncthreads();
        float mx = -3e38f;
        for (int j = tid; j < lim; j += NTHREADS) {
            float ss = 0.f, dn = 0.f;
            for (int k = 0; k < 256; ++k) { const float v = bf2f(Z[(size_t)j * ZC + ZC_CKV + k]); ss += v * v; dn += v * g_kv[k] * qk[k]; }
            const float rstd = 1.f / sqrtf(ss / 256.f + NORM_EPS);
            float dr = 0.f;
            for (int p = 0; p < 16; ++p) dr += q[64 + p] * bf2f(Z[(size_t)j * ZC + ZC_KR + 2 * p]) + q[80 + p] * bf2f(Z[(size_t)j * ZC + ZC_KR + 2 * p + 1]);
            const float s_ = (dn * rstd + dr) * 0.10206207261596577f;
            sc[j] = s_; rs[j] = rstd; mx = fmaxf(mx, s_);
        }
        red[tid] = mx; __syncthreads();
        for (int o = 256; o > 0; o >>= 1) { if (tid < o) red[tid] = fmaxf(red[tid], red[tid + o]); __syncthreads(); }
        mx = red[0]; __syncthreads();
        float sm = 0.f;
        for (int j = tid; j < lim; j += NTHREADS) { const float p = expf(sc[j] - mx); sc[j] = p; sm += p; }
        red[tid] = sm; __syncthreads();
        for (int o = 256; o > 0; o >>= 1) { if (tid < o) red[tid] += red[tid + o]; __syncthreads(); }
        sm = red[0]; __syncthreads();
        { const int k = tid & 255, half = tid >> 8; float a = 0.f;
          for (int j = half; j < lim; j += 2) a += sc[j] * rs[j] * bf2f(Z[(size_t)j * ZC + ZC_CKV + k]);
          pk[tid] = a * g_kv[k]; }
        __syncthreads();
        if (tid < 64) { float a = 0.f; for (int k = 0; k < 256; ++k) a += (pk[k] + pk[256 + k]) * w_ukv[(size_t)k * 1024 + h * 128 + 64 + tid];
            a /= sm; const float got = bf2f(((const bf16*)(ws + WS_ACT))[(size_t)i * 512 + h * 64 + tid]);
            red[tid] = fabsf(a - got); red[64 + tid] = fabsf(a); }
        __syncthreads();
        if (tid == 0) { float e = 0.f, m = 0.f; for (int d = 0; d < 64; ++d) { e = fmaxf(e, red[d]); m = fmaxf(m, red[64 + d]); }
            if (!(e <= 0.15f * m + 1e-5f)) __hip_atomic_fetch_or(F.ctl + CW_CHK, 1u << (b & 15), RLX_AGENT); }
        __syncthreads();
    } else if (b < 32) {
        const int j = ((b - 16) * 331 + 17 + layer * 5) % SEQ; const float* w_in = inp(3) + (size_t)layer * 2048 * INC; const bf16* H = (const bf16*)(ws + WS_H);
        if (tid < 32) { float a = 0.f; for (int k = 0; k < 2048; ++k) a += bf2f(H[(size_t)j * 2048 + k]) * w_in[(size_t)k * INC + 768 + tid]; L[tid] = a; }
        __syncthreads();
        if (tid < 16) { const float pos = (float)positions[j]; const float inv = exp2f(-(float)tid * (1.f / 16.f) * 18.931568569324174f); const float ang = pos * inv; double rev = (double)ang * 0.15915494309189535; rev -= floor(rev); const float c = __builtin_amdgcn_cosf((float)rev), sn = __builtin_amdgcn_sinf((float)rev);
            const float x1 = L[tid], x2 = L[16 + tid]; const float r1 = x1 * c - x2 * sn, r2 = x2 * c + x1 * sn;
            const float g1 = bf2f(Z[(size_t)j * ZC + ZC_KR + 2 * tid]), g2 = bf2f(Z[(size_t)j * ZC + ZC_KR + 2 * tid + 1]);
            if (!(fabsf(r1 - g1) <= 0.05f * fmaxf(1.f, fabsf(r1))) || !(fabsf(r2 - g2) <= 0.05f * fmaxf(1.f, fabsf(r2)))) __hip_atomic_fetch_or(F.ctl + CW_CHK, 1u << 16, RLX_AGENT); }
        __syncthreads();
    }
}
#endif

__device__ __forceinline__ void p5_diff_combine(Frame& F, int layer) {
    LayerW W; W.lam = inp(12) + (size_t)layer * 256; W.diff_g = inp(13) + (size_t)layer * 128;
    PHASE_IDS();
    const int gw = obid() * NWAVES + wave, NGW = F.G * NWAVES;
    const float lam_init = 0.8f - 0.6f * expf(-0.3f * (float)layer);
    const float d1 = wave_sum(W.lam[lane] * W.lam[64 + lane]), d2 = wave_sum(W.lam[128 + lane] * W.lam[192 + lane]);
    const float lam = expf(d1) - expf(d2) + lam_init;
    const bf16* O1 = (const bf16*)(ws + WS_DO); const bf16* O2 = O1 + (size_t)SEQ * 512;
    bf16* act = (bf16*)(ws + WS_ACT) + (size_t)2 * SEQ * 512;
    const int dcol = (lane & 15) * 8;
    const f32x4 g0 = *(const f32x4*)(W.diff_g + dcol), g1 = *(const f32x4*)(W.diff_g + dcol + 4);
    for (int tok = gw; tok < SEQ; tok += NGW) {
        const v4u a = *(const GAS v4u*)(O1 + (size_t)tok * 512 + lane * 8), b = *(const GAS v4u*)(O2 + (size_t)tok * 512 + lane * 8);
        float v[8] = {bf_lo(a.x) - lam * bf_lo(b.x), bf_hi(a.x) - lam * bf_hi(b.x), bf_lo(a.y) - lam * bf_lo(b.y), bf_hi(a.y) - lam * bf_hi(b.y),
                      bf_lo(a.z) - lam * bf_lo(b.z), bf_hi(a.z) - lam * bf_hi(b.z), bf_lo(a.w) - lam * bf_lo(b.w), bf_hi(a.w) - lam * bf_hi(b.w)};
        float s = 0.f;
#pragma unroll
        for (int i = 0; i < 8; ++i) s += v[i] * v[i];
        s = row16_sum(s);
        const float sc = (1.f / sqrtf(s * (1.f / 128.f) + NORM_EPS)) * (1.f - lam_init);
        float f2[8] = {v[0] * sc * g0[0], v[1] * sc * g0[1], v[2] * sc * g0[2], v[3] * sc * g0[3], v[4] * sc * g1[0], v[5] * sc * g1[1], v[6] * sc * g1[2], v[7] * sc * g1[3]};
        q512_store(f2, ws + WS_ACT8 + ((size_t)2 * SEQ + tok) * 512, (float*)(ws + WS_SACT8) + 2 * SEQ + tok, lane);
#pragma unroll
        for (int br = 0; br < 4; ++br) if (br != 2) row512_bf16_to_i8((const bf16*)(ws + WS_ACT) + ((size_t)br * SEQ + tok) * 512, ws + WS_ACT8 + ((size_t)br * SEQ + tok) * 512, (float*)(ws + WS_SACT8) + br * SEQ + tok, lane);
    }
}

__device__ __forceinline__ void p8_ffn_norm(Frame& F, int layer) {
    LayerW W; W.ffn_g = inp(21) + (size_t)layer * 2048;
    PHASE_IDS();
    const int gw = obid() * NWAVES + wave, NGW = F.G * NWAVES;
    const float* xa = (const float*)(ws + WS_XA);
    for (int m = gw; m < SEQ; m += NGW) {
        const GAS f32x4* xr = (const GAS f32x4*)(xa + (size_t)m * DMODEL) + lane; const GAS f32x4* gr = (const GAS f32x4*)W.ffn_g + lane;
        f32x4 v[8]; float s = 0.f;
#pragma unroll
        for (int j = 0; j < 8; ++j) { v[j] = xr[64 * j]; s += (v[j].x * v[j].x + v[j].y * v[j].y) + (v[j].z * v[j].z + v[j].w * v[j].w); }
        const float rstd = 1.f / sqrtf(wave_sum(s) * (1.f / DMODEL) + NORM_EPS);
        float am = 0.f;
#pragma unroll
        for (int j = 0; j < 8; ++j) { const f32x4 gg = gr[64 * j]; v[j].x *= rstd * gg.x; v[j].y *= rstd * gg.y; v[j].z *= rstd * gg.z; v[j].w *= rstd * gg.w;
            am = fmaxf(fmaxf(am, fabsf(v[j].x)), fabsf(v[j].y)); am = fmaxf(fmaxf(am, fabsf(v[j].z)), fabsf(v[j].w));
 }
        am = wave_max(am);
        const float hsc = am > 0.f ? 224.f * __builtin_amdgcn_rcpf(am) : 1.f;
        GAS unsigned* o4 = (GAS unsigned*)(ws + WS_H2F8 + (size_t)m * DMODEL) + lane;
#pragma unroll
        for (int j = 0; j < 8; ++j) { int p_ = __builtin_amdgcn_cvt_pk_fp8_f32(v[j].x * hsc, v[j].y * hsc, 0, false); p_ = __builtin_amdgcn_cvt_pk_fp8_f32(v[j].z * hsc, v[j].w * hsc, p_, true); o4[64 * j] = (unsigned)p_; }
        { const float isc = am > 0.f ? 127.f / am : 1.f; GAS unsigned* o1 = (GAS unsigned*)(ws + WS_H2I8 + (size_t)m * DMODEL) + lane;
#pragma unroll
          for (int j = 0; j < 8; ++j) o1[64 * j] = q4_i8(v[j].x * isc, v[j].y * isc, v[j].z * isc, v[j].w * isc); }
        if (lane == 0) ((GAS float*)(ws + WS_HSCI))[m] = am > 0.f ? am * (1.f / 224.f) : 1.f;
    }
}

#define CEI(a, b) do { const int mx_ = (a) > (b) ? (a) : (b), mn_ = (a) > (b) ? (b) : (a); (a) = mx_; (b) = mn_; } while (0)
#define SORT16(v, b) do { CEI(v[(b)+0], v[(b)+1]); CEI(v[(b)+3], v[(b)+2]); CEI(v[(b)+4], v[(b)+5]); CEI(v[(b)+7], v[(b)+6]); CEI(v[(b)+8], v[(b)+9]); CEI(v[(b)+11], v[(b)+10]); CEI(v[(b)+12], v[(b)+13]); CEI(v[(b)+15], v[(b)+14]); CEI(v[(b)+0], v[(b)+2]); CEI(v[(b)+1], v[(b)+3]); CEI(v[(b)+6], v[(b)+4]); CEI(v[(b)+7], v[(b)+5]); CEI(v[(b)+8], v[(b)+10]); CEI(v[(b)+9], v[(b)+11]); CEI(v[(b)+14], v[(b)+12]); CEI(v[(b)+15], v[(b)+13]); CEI(v[(b)+0], v[(b)+1]); CEI(v[(b)+2], v[(b)+3]); CEI(v[(b)+5], v[(b)+4]); CEI(v[(b)+7], v[(b)+6]); CEI(v[(b)+8], v[(b)+9]); CEI(v[(b)+10], v[(b)+11]); CEI(v[(b)+13], v[(b)+12]); CEI(v[(b)+15], v[(b)+14]); CEI(v[(b)+0], v[(b)+4]); CEI(v[(b)+1], v[(b)+5]); CEI(v[(b)+2], v[(b)+6]); CEI(v[(b)+3], v[(b)+7]); CEI(v[(b)+12], v[(b)+8]); CEI(v[(b)+13], v[(b)+9]); CEI(v[(b)+14], v[(b)+10]); CEI(v[(b)+15], v[(b)+11]); CEI(v[(b)+0], v[(b)+2]); CEI(v[(b)+1], v[(b)+3]); CEI(v[(b)+4], v[(b)+6]); CEI(v[(b)+5], v[(b)+7]); CEI(v[(b)+10], v[(b)+8]); CEI(v[(b)+11], v[(b)+9]); CEI(v[(b)+14], v[(b)+12]); CEI(v[(b)+15], v[(b)+13]); CEI(v[(b)+0], v[(b)+1]); CEI(v[(b)+2], v[(b)+3]); CEI(v[(b)+4], v[(b)+5]); CEI(v[(b)+6], v[(b)+7]); CEI(v[(b)+9], v[(b)+8]); CEI(v[(b)+11], v[(b)+10]); CEI(v[(b)+13], v[(b)+12]); CEI(v[(b)+15], v[(b)+14]); CEI(v[(b)+0], v[(b)+8]); CEI(v[(b)+1], v[(b)+9]); CEI(v[(b)+2], v[(b)+10]); CEI(v[(b)+3], v[(b)+11]); CEI(v[(b)+4], v[(b)+12]); CEI(v[(b)+5], v[(b)+13]); CEI(v[(b)+6], v[(b)+14]); CEI(v[(b)+7], v[(b)+15]); CEI(v[(b)+0], v[(b)+4]); CEI(v[(b)+1], v[(b)+5]); CEI(v[(b)+2], v[(b)+6]); CEI(v[(b)+3], v[(b)+7]); CEI(v[(b)+8], v[(b)+12]); CEI(v[(b)+9], v[(b)+13]); CEI(v[(b)+10], v[(b)+14]); CEI(v[(b)+11], v[(b)+15]); CEI(v[(b)+0], v[(b)+2]); CEI(v[(b)+1], v[(b)+3]); CEI(v[(b)+4], v[(b)+6]); CEI(v[(b)+5], v[(b)+7]); CEI(v[(b)+8], v[(b)+10]); CEI(v[(b)+9], v[(b)+11]); CEI(v[(b)+12], v[(b)+14]); CEI(v[(b)+13], v[(b)+15]); CEI(v[(b)+0], v[(b)+1]); CEI(v[(b)+2], v[(b)+3]); CEI(v[(b)+4], v[(b)+5]); CEI(v[(b)+6], v[(b)+7]); CEI(v[(b)+8], v[(b)+9]); CEI(v[(b)+10], v[(b)+11]); CEI(v[(b)+12], v[(b)+13]); CEI(v[(b)+14], v[(b)+15]); } while (0)
#define MERGE16(v, b) do { CEI(v[(b)+0], v[(b)+8]); CEI(v[(b)+1], v[(b)+9]); CEI(v[(b)+2], v[(b)+10]); CEI(v[(b)+3], v[(b)+11]); CEI(v[(b)+4], v[(b)+12]); CEI(v[(b)+5], v[(b)+13]); CEI(v[(b)+6], v[(b)+14]); CEI(v[(b)+7], v[(b)+15]); CEI(v[(b)+0], v[(b)+4]); CEI(v[(b)+1], v[(b)+5]); CEI(v[(b)+2], v[(b)+6]); CEI(v[(b)+3], v[(b)+7]); CEI(v[(b)+8], v[(b)+12]); CEI(v[(b)+9], v[(b)+13]); CEI(v[(b)+10], v[(b)+14]); CEI(v[(b)+11], v[(b)+15]); CEI(v[(b)+0], v[(b)+2]); CEI(v[(b)+1], v[(b)+3]); CEI(v[(b)+4], v[(b)+6]); CEI(v[(b)+5], v[(b)+7]); CEI(v[(b)+8], v[(b)+10]); CEI(v[(b)+9], v[(b)+11]); CEI(v[(b)+12], v[(b)+14]); CEI(v[(b)+13], v[(b)+15]); CEI(v[(b)+0], v[(b)+1]); CEI(v[(b)+2], v[(b)+3]); CEI(v[(b)+4], v[(b)+5]); CEI(v[(b)+6], v[(b)+7]); CEI(v[(b)+8], v[(b)+9]); CEI(v[(b)+10], v[(b)+11]); CEI(v[(b)+12], v[(b)+13]); CEI(v[(b)+14], v[(b)+15]); } while (0)

__device__ __forceinline__ int skey(float f) { const int b_ = __builtin_bit_cast(int, f); return b_ ^ ((b_ >> 31) & 0x7fffffff); }
__device__ __forceinline__ float unskey(int k) { const int b_ = k ^ ((k >> 31) & 0x7fffffff); return __builtin_bit_cast(float, b_); }
__device__ __forceinline__ int xpartner(int x, int hh) { auto rr = __builtin_amdgcn_permlane32_swap((unsigned)x, (unsigned)x, false, false); return (int)(hh ? rr[0] : rr[1]); }
__device__ __forceinline__ void split_bf16(const f32x4 a, const f32x4 b, bf16x8& hi, bf16x8& lo) {
    v4u h; h.x = pg8::cvt_pk_bf16(a[0], a[1]); h.y = pg8::cvt_pk_bf16(a[2], a[3]); h.z = pg8::cvt_pk_bf16(b[0], b[1]); h.w = pg8::cvt_pk_bf16(b[2], b[3]);
    v4u l; l.x = pg8::cvt_pk_bf16(a[0] - bf_lo(h.x), a[1] - bf_hi(h.x)); l.y = pg8::cvt_pk_bf16(a[2] - bf_lo(h.y), a[3] - bf_hi(h.y)); l.z = pg8::cvt_pk_bf16(b[0] - bf_lo(h.z), b[1] - bf_hi(h.z)); l.w = pg8::cvt_pk_bf16(b[2] - bf_lo(h.w), b[3] - bf_hi(h.w));
    hi = __builtin_bit_cast(bf16x8, h); lo = __builtin_bit_cast(bf16x8, l);
}
__device__ __forceinline__ void peer_top16(const bf16* ktab, const float* qrow, int r32, int hh, int (&v)[64]) {
    bf16x8 qb[4];
#pragma unroll
    for (int ks = 0; ks < 4; ++ks) { const f32x4 a = *(const GAS f32x4*)(qrow + 16 * ks + 8 * hh), b = *(const GAS f32x4*)(qrow + 16 * ks + 8 * hh + 4);
        v4u h; h.x = pg8::cvt_pk_bf16(a[0], a[1]); h.y = pg8::cvt_pk_bf16(a[2], a[3]); h.z = pg8::cvt_pk_bf16(b[0], b[1]); h.w = pg8::cvt_pk_bf16(b[2], b[3]); qb[ks] = __builtin_bit_cast(bf16x8, h); }
#pragma unroll
    for (int kt = 0; kt < 4; ++kt) {
        f32x16 acc = (f32x16){0.f, 0.f, 0.f, 0.f, 0.f, 0.f, 0.f, 0.f, 0.f, 0.f, 0.f, 0.f, 0.f, 0.f, 0.f, 0.f};
#pragma unroll
        for (int ks = 0; ks < 4; ++ks) { const bf16x8 kh = *(const GAS bf16x8*)(ktab + (size_t)(32 * kt + r32) * 64 + 16 * ks + 8 * hh);
            acc = __builtin_amdgcn_mfma_f32_32x32x16_bf16(kh, qb[ks], acc, 0, 0, 0); }
#pragma unroll
        for (int r = 0; r < 16; ++r) v[16 * kt + r] = (skey(acc[r]) & ~127) | (32 * kt + (r & 3) + 8 * (r >> 2) + 4 * hh);
    }
    SORT16(v, 0); SORT16(v, 16); SORT16(v, 32); SORT16(v, 48);
#pragma unroll
    for (int i = 0; i < 16; ++i) { v[i] = v[i] > v[31 - i] ? v[i] : v[31 - i]; v[32 + i] = v[32 + i] > v[63 - i] ? v[32 + i] : v[63 - i]; }
    MERGE16(v, 0); MERGE16(v, 32);
#pragma unroll
    for (int i = 0; i < 16; ++i) v[i] = v[i] > v[47 - i] ? v[i] : v[47 - i];
    MERGE16(v, 0);
    int pb[16];
#pragma unroll
    for (int i = 0; i < 16; ++i) pb[i] = xpartner(v[i], hh);
#pragma unroll
    for (int i = 0; i < 16; ++i) v[i] = v[i] > pb[15 - i] ? v[i] : pb[15 - i];
    MERGE16(v, 0);
}
__device__ __forceinline__ void p10_route(Frame& F, int layer) {
    const bf16* subk = (const bf16*)(F.ws_base + WS_SUBK); (void)layer;
    PHASE_IDS();
    const int r32 = lane & 31, hh = lane >> 5;
    const int gw = obid() * NWAVES + wave, NGW = F.G * NWAVES;
    const float* pq = (const float*)(ws + WS_PQ);
    int* idx_o = (int*)(ws + WS_IDX); float* gate_o = (float*)(ws + WS_GATE);
    LAS unsigned char* tab = F.lds + wave * 1024 + r32 * 32;
    for (int it = gw; it < (SEQ / 32) * 8; it += NGW) {
        const int tile = it >> 3, hd = it & 7, tok = tile * 32 + r32;
        const float* qrow = pq + (size_t)tok * 1024 + hd * 128;
        int t1[16], t2[16];
        { int v[64]; peer_top16(subk, qrow, r32, hh, v);
#pragma unroll
          for (int i = 0; i < 16; ++i) t1[i] = v[i]; }
        { int v[64]; peer_top16(subk + 128 * 64, qrow + 64, r32, hh, v);
#pragma unroll
          for (int i = 0; i < 16; ++i) t2[i] = v[i]; }
        if (hh == 0) {
#pragma unroll
            for (int q = 0; q < 4; ++q) { ((LAS unsigned*)tab)[q] = (unsigned)(t1[4 * q] & 127) | ((unsigned)(t1[4 * q + 1] & 127) << 8) | ((unsigned)(t1[4 * q + 2] & 127) << 16) | ((unsigned)(t1[4 * q + 3] & 127) << 24);
                ((LAS unsigned*)tab)[4 + q] = (unsigned)(t2[4 * q] & 127) | ((unsigned)(t2[4 * q + 1] & 127) << 8) | ((unsigned)(t2[4 * q + 2] & 127) << 16) | ((unsigned)(t2[4 * q + 3] & 127) << 24); }
        }
        float f1[16], f2[16];
#pragma unroll
        for (int i = 0; i < 16; ++i) { f1[i] = unskey(t1[i] & ~127); f2[i] = unskey(t2[i] & ~127); }
        int c50[50];
        c50[0] = (skey(f1[0] + f2[0]) & ~255) | 0;
        c50[1] = (skey(f1[0] + f2[1]) & ~255) | 1;
        c50[2] = (skey(f1[0] + f2[2]) & ~255) | 2;
        c50[3] = (skey(f1[0] + f2[3]) & ~255) | 3;
        c50[4] = (skey(f1[0] + f2[4]) & ~255) | 4;
        c50[5] = (skey(f1[0] + f2[5]) & ~255) | 5;
        c50[6] = (skey(f1[0] + f2[6]) & ~255) | 6;
        c50[7] = (skey(f1[0] + f2[7]) & ~255) | 7;
        c50[8] = (skey(f1[0] + f2[8]) & ~255) | 8;
        c50[9] = (skey(f1[0] + f2[9]) & ~255) | 9;
        c50[10] = (skey(f1[0] + f2[10]) & ~255) | 10;
        c50[11] = (skey(f1[0] + f2[11]) & ~255) | 11;
        c50[12] = (skey(f1[0] + f2[12]) & ~255) | 12;
        c50[13] = (skey(f1[0] + f2[13]) & ~255) | 13;
        c50[14] = (skey(f1[0] + f2[14]) & ~255) | 14;
        c50[15] = (skey(f1[0] + f2[15]) & ~255) | 15;
        c50[16] = (skey(f1[1] + f2[0]) & ~255) | 16;
        c50[17] = (skey(f1[1] + f2[1]) & ~255) | 17;
        c50[18] = (skey(f1[1] + f2[2]) & ~255) | 18;
        c50[19] = (skey(f1[1] + f2[3]) & ~255) | 19;
        c50[20] = (skey(f1[1] + f2[4]) & ~255) | 20;
        c50[21] = (skey(f1[1] + f2[5]) & ~255) | 21;
        c50[22] = (skey(f1[1] + f2[6]) & ~255) | 22;
        c50[23] = (skey(f1[1] + f2[7]) & ~255) | 23;
        c50[24] = (skey(f1[2] + f2[0]) & ~255) | 32;
        c50[25] = (skey(f1[2] + f2[1]) & ~255) | 33;
        c50[26] = (skey(f1[2] + f2[2]) & ~255) | 34;
        c50[27] = (skey(f1[2] + f2[3]) & ~255) | 35;
        c50[28] = (skey(f1[2] + f2[4]) & ~255) | 36;
        c50[29] = (skey(f1[3] + f2[0]) & ~255) | 48;
        c50[30] = (skey(f1[3] + f2[1]) & ~255) | 49;
        c50[31] = (skey(f1[3] + f2[2]) & ~255) | 50;
        c50[32] = (skey(f1[3] + f2[3]) & ~255) | 51;
        c50[33] = (skey(f1[4] + f2[0]) & ~255) | 64;
        c50[34] = (skey(f1[4] + f2[1]) & ~255) | 65;
        c50[35] = (skey(f1[4] + f2[2]) & ~255) | 66;
        c50[36] = (skey(f1[5] + f2[0]) & ~255) | 80;
        c50[37] = (skey(f1[5] + f2[1]) & ~255) | 81;
        c50[38] = (skey(f1[6] + f2[0]) & ~255) | 96;
        c50[39] = (skey(f1[6] + f2[1]) & ~255) | 97;
        c50[40] = (skey(f1[7] + f2[0]) & ~255) | 112;
        c50[41] = (skey(f1[7] + f2[1]) & ~255) | 113;
        c50[42] = (skey(f1[8] + f2[0]) & ~255) | 128;
        c50[43] = (skey(f1[9] + f2[0]) & ~255) | 144;
        c50[44] = (skey(f1[10] + f2[0]) & ~255) | 160;
        c50[45] = (skey(f1[11] + f2[0]) & ~255) | 176;
        c50[46] = (skey(f1[12] + f2[0]) & ~255) | 192;
        c50[47] = (skey(f1[13] + f2[0]) & ~255) | 208;
        c50[48] = (skey(f1[14] + f2[0]) & ~255) | 224;
        c50[49] = (skey(f1[15] + f2[0]) & ~255) | 240;
        int m[32];
#pragma unroll
        for (int n = 0; n < 25; ++n) m[n] = hh ? c50[25 + n] : c50[n];
#pragma unroll
        for (int n = 25; n < 32; ++n) m[n] = (int)0x80000000;
        SORT16(m, 0); SORT16(m, 16);
#pragma unroll
        for (int i = 0; i < 16; ++i) m[i] = m[i] > m[31 - i] ? m[i] : m[31 - i];
        MERGE16(m, 0);
        int fb[16];
#pragma unroll
        for (int i = 0; i < 16; ++i) fb[i] = xpartner(m[i], hh);
#pragma unroll
        for (int i = 0; i < 16; ++i) m[i] = m[i] > fb[15 - i] ? m[i] : fb[15 - i];
        float val[16]; float mx = -3.0e38f;
#pragma unroll
        for (int i = 0; i < 16; ++i) { val[i] = unskey(m[i] & ~255); mx = fmaxf(mx, val[i]); }
        float den = 0.f;
#pragma unroll
        for (int i = 0; i < 16; ++i) { val[i] = __expf(val[i] - mx); den += val[i]; }
        const float rden = 1.f / den;
        asm volatile("s_waitcnt lgkmcnt(0)" ::: "memory");
        const LAS unsigned char* tb = tab;
        int ids[8]; float gs[8];
#pragma unroll
        for (int k = 0; k < 8; ++k) { const int ci = m[k] & 255; const int e1 = tb[ci >> 4], e2 = tb[16 + (ci & 15)]; ids[k] = e1 * 128 + e2; gs[k] = val[k] * rden; }
        int* ip = idx_o + (size_t)tok * 128 + hd * 16 + hh * 8; float* gp = gate_o + (size_t)tok * 128 + hd * 16 + hh * 8;
        *(GAS v4u*)ip = (v4u){(unsigned)ids[0], (unsigned)ids[1], (unsigned)ids[2], (unsigned)ids[3]}; *(GAS v4u*)(ip + 4) = (v4u){(unsigned)ids[4], (unsigned)ids[5], (unsigned)ids[6], (unsigned)ids[7]};
        *(GAS f32x4*)gp = (f32x4){gs[0], gs[1], gs[2], gs[3]}; *(GAS f32x4*)(gp + 4) = (f32x4){gs[4], gs[5], gs[6], gs[7]};
        asm volatile("s_waitcnt lgkmcnt(0)" ::: "memory");
    }
}

typedef float f32x2_ __attribute__((ext_vector_type(2)));
__device__ __forceinline__ void p11_peer(Frame& F, int layer, float* d_out) {
    const bool last = layer == NLAYER - 1; const float* next_g = last ? inp(26) : inp(2) + (size_t)(layer + 1) * 2048;
    PHASE_IDS();
    const int gw = obid() * NWAVES + wave, NGW = F.G * NWAVES;
    const unsigned char* U = ws + WS_UBF; const unsigned char* V = ws + WS_VBF;
    const float* usc = (const float*)(ws + WS_USC); const float* vsc = (const float*)(ws + WS_VSC);
    float* xa = (float*)(ws + WS_XA); const int* idx = (const int*)(ws + WS_IDX); const float* gate = (const float*)(ws + WS_GATE);
    LAS unsigned char* wl = F.lds + wave * 16384;
    LAS unsigned* keyl = (LAS unsigned*)wl;
    LAS float* asort = (LAS float*)(wl + 2048);
    LAS float* gsort = (LAS float*)(wl + 4096);
    const unsigned ring0 = (unsigned)(uintptr_t)(wl + 6144);
    LAS unsigned char* ringp = wl + 6144;
    LAS float* winv_l = (LAS float*)(F.lds + LDS_PART_OFF);
    LAS float* ssq_l = (LAS float*)(F.lds + LDS_PART_OFF + 64);
    for (int g4 = gw; g4 < SEQ / 4; g4 += NGW) {
        const int tok0 = g4 * 4;
#pragma unroll
        for (int i = 0; i < 8; ++i) { const int s_ = 64 * i + lane; const int id = idx[(size_t)tok0 * 128 + s_];
            keyl[s_] = ((unsigned)id << 9) | (unsigned)s_; }
        asm volatile("s_waitcnt lgkmcnt(0)" ::: "memory");
        for (int kk = 2; kk <= 512; kk <<= 1)
            for (int jj = kk >> 1; jj > 0; jj >>= 1) {
#pragma unroll
                for (int q = 0; q < 4; ++q) { const int t = 64 * q + lane, lo_i = 2 * t - (t & (jj - 1)), hi_i = lo_i + jj;
                    const unsigned x = keyl[lo_i], y = keyl[hi_i]; const bool up = (lo_i & kk) == 0; const bool sw = up ? (x > y) : (x < y);
                    keyl[lo_i] = sw ? y : x; keyl[hi_i] = sw ? x : y; }
                asm volatile("s_waitcnt lgkmcnt(0)" ::: "memory");
            }
#pragma unroll
        for (int i = 0; i < 8; ++i) { const int p_ = 64 * i + lane; const unsigned k_ = keyl[p_]; const int id = (int)(k_ >> 9); const int slot = (int)(k_ & 511u);
            asort[p_] = usc[id]; gsort[p_] = gate[(size_t)tok0 * 128 + slot] * vsc[id]; }
        const GAS long* hrow = (const GAS long*)(ws + WS_H2F8 + (size_t)(tok0 + (lane & 3)) * DMODEL + 8 * (lane >> 4));
        const float hinv = ((const GAS float*)(ws + WS_HSCI))[tok0 + (lane & 3)];
        long hb[64];
#pragma unroll
        for (int s_ = 0; s_ < 64; ++s_) hb[s_] = hrow[4 * s_];
        asm volatile("s_waitcnt vmcnt(0) lgkmcnt(0)" ::: "memory");
        {
            unsigned m0s_; asm volatile("s_mov_b32 %0, m0" : "=s"(m0s_) :: "memory");
            int ln1 = lane; asm volatile("" : "+v"(ln1));
            const unsigned rsel = ln1 >> 3, cA = 16u * ((ln1 & 7) ^ (rsel >> 1)), cB = 16u * ((ln1 & 7) ^ ((rsel >> 1) | 4u));
#define P11_GA(B_) (U + ((size_t)(keyl[16 * (B_) + rsel] >> 9) << 11) + cA)
#define P11_GBB(B_) (U + ((size_t)(keyl[16 * (B_) + 8 + rsel] >> 9) << 11) + cB)
#define P11_PAIR(SLOT) do { asm volatile("s_mov_b32 m0, %0\n\ts_nop 0\n\tglobal_load_lds_dwordx4 %2, off\n\ts_mov_b32 m0, %1\n\ts_nop 0\n\tglobal_load_lds_dwordx4 %3, off" \
                :: "s"(ring0 + 2048u * (unsigned)(SLOT)), "s"(ring0 + 2048u * (unsigned)(SLOT) + 1024u), "v"(gpa), "v"(gpb) : "m0", "memory"); gpa += 128; gpb += 128; } while (0)
            const unsigned char* gpa = P11_GA(0); const unsigned char* gpb = P11_GBB(0); const unsigned char* gna = P11_GA(1); const unsigned char* gnb = P11_GBB(1);
#pragma unroll
            for (int j = 0; j < 3; ++j) P11_PAIR(j);
            const int ri_ = ln1 & 15, rg_ = ln1 >> 4;
            const int rswz_ = ((ri_ & 7) >> 1) | ((ri_ >> 3) << 2), rgh_ = rg_ >> 1;
            const LAS unsigned char* arb_ = ringp + 1024 * (ri_ >> 3) + 128 * (ri_ & 7) + 8 * (rg_ & 1);
            const LAS unsigned char* ard0 = arb_ + 16 * ((0 + rgh_) ^ rswz_); const LAS unsigned char* ard1 = arb_ + 16 * ((2 + rgh_) ^ rswz_);
            const LAS unsigned char* ard2 = arb_ + 16 * ((4 + rgh_) ^ rswz_); const LAS unsigned char* ard3 = arb_ + 16 * ((6 + rgh_) ^ rswz_);
            for (int b = 0; b < 32; ++b) {
                f32x4 c0 = (f32x4){0.f, 0.f, 0.f, 0.f}, c1 = c0;
                long a0 = 0, a1 = 0, a2 = 0, a3 = 0;
#pragma unroll
                for (int j = 0; j < 16; ++j) {
                    asm volatile("s_waitcnt lgkmcnt(0)" ::: "memory");
                    P11_PAIR((j + 3) & 3);
                    if (j == 12) { const int bn = b + 2 < 32 ? b + 2 : 31; gpa = gna; gpb = gnb; gna = P11_GA(bn); gnb = P11_GBB(bn); }
                    asm volatile("s_waitcnt vmcnt(6)" ::: "memory");
                    const long n0 = *(const LAS long*)(ard0 + (j & 3) * 2048), n1 = *(const LAS long*)(ard1 + (j & 3) * 2048), n2 = *(const LAS long*)(ard2 + (j & 3) * 2048), n3 = *(const LAS long*)(ard3 + (j & 3) * 2048);
                    if (j > 0) {
                        c0 = __builtin_amdgcn_mfma_f32_16x16x32_fp8_fp8(a0, hb[4 * j - 4], c0, 0, 0, 0);
                        c1 = __builtin_amdgcn_mfma_f32_16x16x32_fp8_fp8(a1, hb[4 * j - 3], c1, 0, 0, 0);
                        c0 = __builtin_amdgcn_mfma_f32_16x16x32_fp8_fp8(a2, hb[4 * j - 2], c0, 0, 0, 0);
                        c1 = __builtin_amdgcn_mfma_f32_16x16x32_fp8_fp8(a3, hb[4 * j - 1], c1, 0, 0, 0);
                    }
                    a0 = n0; a1 = n1; a2 = n2; a3 = n3;
                }
                asm volatile("s_waitcnt lgkmcnt(0)" ::: "memory");
                c0 = __builtin_amdgcn_mfma_f32_16x16x32_fp8_fp8(a0, hb[60], c0, 0, 0, 0);
                c1 = __builtin_amdgcn_mfma_f32_16x16x32_fp8_fp8(a1, hb[61], c1, 0, 0, 0);
                c0 = __builtin_amdgcn_mfma_f32_16x16x32_fp8_fp8(a2, hb[62], c0, 0, 0, 0);
                c1 = __builtin_amdgcn_mfma_f32_16x16x32_fp8_fp8(a3, hb[63], c1, 0, 0, 0);
                const f32x4 cs = c0 + c1; const int q4 = 16 * b + 4 * (ln1 >> 4);
                const v4u wd = *(const LAS v4u*)(keyl + q4); const f32x4 sc = *(const LAS f32x4*)(asort + q4);
#pragma unroll
                for (int r = 0; r < 4; ++r) if (((wd[r] >> 7) & 3u) == (unsigned)(ln1 & 15)) asort[q4 + r] = cs[r] * sc[r] * hinv;
            }
            asm volatile("s_waitcnt vmcnt(0) lgkmcnt(0)\n\ts_mov_b32 m0, %0" :: "s"(m0s_) : "memory");
#undef P11_GA
#undef P11_GBB
#undef P11_PAIR
        }
        float wv[8]; float wam = 0.f;
#pragma unroll
        for (int i = 0; i < 8; ++i) { const int p_ = 64 * i + lane; const float a_ = asort[p_]; wv[i] = 0.5f * a_ * (1.f + erff(a_ * 0.70710678118654752f)) * gsort[p_]; wam = fmaxf(wam, fabsf(wv[i])); }
        wam = wave_max(wam);
        const float wsc = wam > 0.f ? 224.f * __builtin_amdgcn_rcpf(wam) : 1.f;
        asm volatile("s_waitcnt lgkmcnt(0)" ::: "memory");
        LAS unsigned char* wq8 = wl + 4096;
#pragma unroll
        for (int i = 0; i < 8; ++i) { const int p_ = 64 * i + lane; const unsigned ts_ = (keyl[p_] >> 7) & 3u; const unsigned b8 = (unsigned)__builtin_amdgcn_cvt_pk_fp8_f32(wv[i] * wsc, 0.f, 0, false) & 255u;
#pragma unroll
            for (int c = 0; c < 4; ++c) wq8[512 * c + p_] = (unsigned char)(ts_ == (unsigned)c ? b8 : 0u); }
        if (lane == 0) winv_l[wave] = wam > 0.f ? wam * (1.f / 224.f) : 1.f;
        __syncthreads();
        const int G4 = wave & ~3, qd4 = wave & 3;
        f32x4 acc[32];
#pragma unroll
        for (int i = 0; i < 32; ++i) acc[i] = (f32x4){0.f, 0.f, 0.f, 0.f};
        {
            unsigned m0s_; asm volatile("s_mov_b32 %0, m0" : "=s"(m0s_) :: "memory");
            int ln2 = lane; asm volatile("" : "+v"(ln2));
            const unsigned rsel = ln2 >> 3, cA = 512u * (unsigned)qd4 + 16u * ((ln2 & 7) ^ (rsel >> 1)), cB = 512u * (unsigned)qd4 + 16u * ((ln2 & 7) ^ ((rsel >> 1) | 4u));
#define P11_KL(B_) ((const LAS unsigned*)(F.lds + (G4 + ((B_) & 3)) * 16384) + 16 * ((B_) >> 2))
#define P11_GA(B_) (((P11_KL(B_)[rsel] >> 9) << 11) + cA)
#define P11_GBB(B_) (((P11_KL(B_)[8 + rsel] >> 9) << 11) + cB)
#define P11_WB(B_) (((ln2 >> 5) == 0 && ((ln2 & 15) >> 2) == ((B_) & 3)) ? *(const LAS long*)(F.lds + (G4 + ((B_) & 3)) * 16384 + 4096 + 512 * (ln2 & 3) + 8 * ((ln2 >> 4) & 1) + 16 * ((B_) >> 2)) : 0L)
#define P11_PAIR(SLOT) do { asm volatile("s_mov_b32 m0, %0\n\ts_nop 0\n\tglobal_load_lds_dwordx4 %2, %4\n\ts_mov_b32 m0, %1\n\ts_nop 0\n\tglobal_load_lds_dwordx4 %3, %4" \
                :: "s"(ring0 + 2048u * (unsigned)(SLOT)), "s"(ring0 + 2048u * (unsigned)(SLOT) + 1024u), "v"(gpa), "v"(gpb), "s"(vbase_) : "m0", "memory"); gpa += 128u; gpb += 128u; } while (0)
            const __attribute__((address_space(1))) unsigned char* vbase_ = (const __attribute__((address_space(1))) unsigned char*)V;
            unsigned gpa = P11_GA(0), gpb = P11_GBB(0), gna = P11_GA(1), gnb = P11_GBB(1);
#pragma unroll
            for (int j = 0; j < 3; ++j) P11_PAIR(j);
            const int tp_ = ln2 & 15, tg_ = ln2 >> 4, trh_ = tg_ & 1, til_ = tp_ >> 1, tsw_ = (til_ >> 1) | (trh_ << 2);
            const unsigned tb_ = ring0 + 1024u * trh_ + 128u * til_ + 8u * (tp_ & 1) + 16u * tsw_;
            typedef int v2i_ __attribute__((ext_vector_type(2)));
#define P11_TR(C_, SL) __builtin_amdgcn_ds_read_tr8_b64_v2i32((LAS v2i_*)(uintptr_t)((tb_ ^ (16u * (C_))) + 2048u * (SL)))
#define P11_MM(T_, A_) acc[T_] = __builtin_amdgcn_mfma_f32_16x16x32_fp8_fp8(__builtin_bit_cast(long, A_), wbm, acc[T_], 0, 0, 0)
            long wbm = 0L, wbn = P11_WB(0);
            for (int ch = 0; ch < 32; ++ch) {
#pragma unroll
                for (int st = 0; st < 16; ++st) {
                    asm volatile("s_waitcnt lgkmcnt(0)" ::: "memory");
                    P11_PAIR((st + 3) & 3);
                    if ((st & 3) == 0) { const int bn = 4 * ch + (st >> 2) + 2 < 128 ? 4 * ch + (st >> 2) + 2 : 127; gpa = gna; gpb = gnb; gna = P11_GA(bn); gnb = P11_GBB(bn); wbm = wbn; }
                    if ((st & 3) == 1) { const int bw = 4 * ch + (st >> 2) + 1 < 128 ? 4 * ch + (st >> 2) + 1 : 127; wbn = P11_WB(bw); }
                    asm volatile("s_waitcnt vmcnt(6)" ::: "memory");
                    const v2i_ n0 = P11_TR(0, st & 3), n1 = P11_TR(1, st & 3), n2 = P11_TR(2, st & 3), n3 = P11_TR(3, st & 3), n4 = P11_TR(4, st & 3), n5 = P11_TR(5, st & 3), n6 = P11_TR(6, st & 3), n7 = P11_TR(7, st & 3);
                    { const int t8 = 8 * (st & 3);
                        P11_MM(t8 + 0, n0); P11_MM(t8 + 1, n1); P11_MM(t8 + 2, n2); P11_MM(t8 + 3, n3); P11_MM(t8 + 4, n4); P11_MM(t8 + 5, n5); P11_MM(t8 + 6, n6); P11_MM(t8 + 7, n7); }
                }
            }
            asm volatile("s_waitcnt vmcnt(0) lgkmcnt(0)\n\ts_mov_b32 m0, %0" :: "s"(m0s_) : "memory");
#undef P11_KL
#undef P11_GA
#undef P11_GBB
#undef P11_WB
#undef P11_PAIR
#undef P11_TR
#undef P11_MM
        }
        {
            int ln3 = lane; asm volatile("" : "+v"(ln3));
            const int ncol = ln3 & 15, qd = ln3 >> 4, tokg = (g4 - (wave & 3)) * 4 + ncol;
            const float wi = winv_l[G4 + (ncol >> 2)];
            GAS f32x4* xp0 = (GAS f32x4*)(xa + (size_t)tokg * DMODEL + 512 * qd4 + 4 * qd);
            float ss = 0.f;
#pragma unroll
            for (int t8 = 0; t8 < 4; ++t8) {
                asm volatile("" ::: "memory");
#pragma unroll
                for (int t = 8 * t8; t < 8 * t8 + 8; ++t) { const f32x4 x0 = xp0[4 * t]; f32x4 e = acc[t] * wi + x0; acc[t] = e; ss += (e.x * e.x + e.y * e.y) + (e.z * e.z + e.w * e.w); if (!last) xp0[4 * t] = e; }
            }
            ss += __builtin_bit_cast(float, __builtin_amdgcn_ds_bpermute((ln3 ^ 16) << 2, __builtin_bit_cast(int, ss)));
            ss += __builtin_bit_cast(float, __builtin_amdgcn_ds_bpermute((ln3 ^ 32) << 2, __builtin_bit_cast(int, ss)));
            if (qd == 0) ssq_l[16 * wave + ncol] = ss;
            __syncthreads();
            const float rstd = 1.f / sqrtf(((ssq_l[16 * G4 + ncol] + ssq_l[16 * (G4 + 1) + ncol]) + (ssq_l[16 * (G4 + 2) + ncol] + ssq_l[16 * (G4 + 3) + ncol])) * (1.f / DMODEL) + NORM_EPS);
            const GAS f32x4* gp0 = (const GAS f32x4*)(next_g + 512 * qd4 + 4 * qd);
#if MK_CHECK
            float kc = -1.f;
            if (last) { const unsigned fl_ = __hip_atomic_load(F.ctl + CW_CHK, RLX_AGENT); if (fl_ != 0u) kc = (float)__builtin_popcount(fl_ & 0xffffu) + ((fl_ & 0x10000u) ? 20.f : 0.f); }
#endif
#pragma unroll
            for (int t8 = 0; t8 < 4; ++t8) {
                asm volatile("" ::: "memory");
#pragma unroll
                for (int t = 8 * t8; t < 8 * t8 + 8; ++t) { const f32x4 gg = gp0[4 * t]; f32x4 o = acc[t] * rstd * gg;
#if MK_CHECK
                    if (kc >= 0.f) o = (f32x4){kc, kc, kc, kc};
#endif
                    if (last) *(GAS f32x4*)(d_out + (size_t)tokg * DMODEL + 512 * qd4 + 16 * t + 4 * qd) = o;
                    else { typedef unsigned v2u_ __attribute__((ext_vector_type(2))); *(GAS v2u_*)((bf16*)(ws + WS_H) + (size_t)tokg * DMODEL + 512 * qd4 + 16 * t + 4 * qd) = (v2u_){pk2(o.x, o.y), pk2(o.z, o.w)}; }
                }
            }
            asm volatile("s_waitcnt vmcnt(0)" ::: "memory");
            __syncthreads();
        }
    }
}

#ifndef MK_ONE_LAUNCH
#define MK_ONE_LAUNCH 1
#endif
constexpr int PH_PER_LAYER = 12, N_PHASES = PH_PER_LAYER * NLAYER;
struct Args { const float* in[27]; float* out; unsigned char* ws; int ph_lo, ph_hi; };
static_assert(sizeof(Args) == 29 * 8 + 8, "Args has no padding");

__global__ void __launch_bounds__(NTHREADS, 2) mk_fwd(Args args) {
    extern __shared__ __attribute__((aligned(16))) unsigned char lds_raw[];
    Frame F;
    F.lds = (LAS unsigned char*)lds_raw;
    F.MISC = (volatile LAS unsigned*)(F.lds + MISC_OFF);
    F.G = gridDim.x; F.wv = __builtin_amdgcn_readfirstlane((int)threadIdx.x >> 6);
    F.ws_base = args.ws; F.ctl = (gu32*)(args.ws + WS_CTL);
    for (int u = threadIdx.x; u < (LDS_BYTES - LDSCTL_OFF) / 4; u += NTHREADS) ((LAS unsigned*)(F.lds + LDSCTL_OFF))[u] = 0u;
    __syncthreads();
    XcdBarrier bar; bar.bar = (unsigned*)(F.ctl + CW_BAR); bar.x = 0; bar.st = nullptr; bar.wv = F.wv;
    if (MK_ONE_LAUNCH) bar = xcd_barrier_post((unsigned*)(F.ctl + CW_BAR), F.MISC + 8, F.wv);
    const int lo = args.ph_lo, hi = args.ph_hi;
#define IN(k) (lo <= (k) && (k) < hi)
#ifndef DUP_MASK
#define DUP_MASK 0
#endif
#define NREP(k) (((DUP_MASK >> (k)) & 1) ? 2 : 1)
#define SEAM(k) do { if (MK_ONE_LAUNCH && IN(k) && IN((k) + 1)) xcd_barrier(bar); } while (0)
    for (int layer = 0; layer < NLAYER; ++layer) {
        const int pb = layer * PH_PER_LAYER;
        if (IN(pb + 0)) { for (int rep = 0; rep < NREP(0); ++rep) p0_prologue(F, layer, 1); } SEAM(pb + 0);
        if (IN(pb + 1)) for (int rep = 0; rep < NREP(1); ++rep) { unsigned char* const ws = ows(F.ws_base);
            { const int tid_ = otid(F.wv), lane_ = tid_ & 63, gw_ = obid() * NWAVES + F.wv, NGW_ = F.G * NWAVES;
              for (int r = gw_ + (layer == 0 ? SEQ : 0); r < SEQ + ZC + 3072; r += NGW_) { const int sel = r >= SEQ + ZC + 2048 ? 3 : r >= SEQ + ZC ? 2 : r >= SEQ, rr = r - (sel == 3 ? SEQ + ZC + 2048 : sel == 2 ? SEQ + ZC : sel * SEQ);
                  row_bf16_to_i8((const bf16*)(ws + (sel == 3 ? WS_WQ : sel == 2 ? WS_WO : sel ? WS_WIN : WS_H)) + (size_t)rr * 2048, ws + (sel == 3 ? WS_WQ8 : sel == 2 ? WS_WO8 : sel ? WS_B8 : WS_A8) + (size_t)rr * 2048,
                                 (float*)(ws + (sel == 3 ? WS_SWQ8 : sel == 2 ? WS_SWO8 : sel ? WS_SB8 : WS_SA8)) + rr, lane_); }
              for (int r = gw_; r < 4 * 2048; r += NGW_) row512_bf16_to_i8((const bf16*)(ws + WS_WOUT) + (size_t)r * 512, ws + WS_WOUT8 + (size_t)r * 512, (float*)(ws + WS_SWOUT8) + r, lane_);
              for (int r = gw_; r < 1792; r += NGW_) row512_bf16_to_i8((const bf16*)(ws + WS_WUQ) + (size_t)r * 512, ws + WS_WUQ8 + (size_t)r * 512, (float*)(ws + WS_SWUQ8) + r, lane_);
              asm volatile("s_waitcnt vmcnt(0)" ::: "memory"); }
            if (MK_ONE_LAUNCH) xcd_barrier(bar);
            pg8::Gemm g{(const bf16*)(ws + WS_A8), (const bf16*)(ws + WS_B8), SEQ, ZC_GATE, 1024, 1024, 1024}; pg8::StaticOrder S; S.init(SEQ, ZC_GATE, F.G, obid());
            pg8::EpiZ8 E{(bf16*)(ws + WS_Z), (const float*)(ws + WS_COSM), (const float*)(ws + WS_SINM), (const float*)(ws + WS_COSD), (const float*)(ws + WS_SIND), (const float*)(ws + WS_SA8), (const float*)(ws + WS_SB8)};
            pg8::gemm_phase<pg8::EpiZ8, pg8::StaticOrder, true, true, true>(F.lds, g, S, E, F.wv);
        } SEAM(pb + 1);
        if (IN(pb + 2)) { for (int rep = 0; rep < NREP(2); ++rep) p2_branch_prep(F, layer); } SEAM(pb + 2);
        if (IN(pb + 3)) for (int rep = 0; rep < NREP(3); ++rep) { unsigned char* const ws = ows(F.ws_base);
            int k3 = 256; asm volatile("" : "+s"(k3));
            pg8::Gemm g{(const bf16*)(ws + WS_QA8), (const bf16*)(ws + WS_WUQ8), SEQ, QMC + KVC, k3, 512, 256}; pg8::QKVOrder8 S; S.S0.init(SEQ, QMC + KVC, F.G, obid());
            pg8::EpiQKV8 E{(bf16*)(ws + WS_QM), (bf16*)(ws + WS_KVM), (const float*)(ws + WS_RSTD), (const float*)(ws + WS_COSM), (const float*)(ws + WS_SINM), (const float*)(ws + WS_SWUQ8)};
            pg8::gemm_phase<pg8::EpiQKV8, pg8::QKVOrder8, false, true, true>(F.lds, g, S, E, F.wv);
        } SEAM(pb + 3);
        if (IN(pb + 4)) { for (int rep = 0; rep < NREP(4); ++rep) p4_attention(F, layer * 2 + rep); } SEAM(pb + 4);
        if (IN(pb + 5)) { p5_diff_combine(F, layer);
#if MK_CHECK
            mla_check(F, layer);
#endif
            __syncthreads();
            { unsigned char* const ws = ows(F.ws_base);
              pg8::Gemm g{(const bf16*)(ws + WS_A8), (const bf16*)(ws + WS_B8 + (size_t)ZC_GATE * 2048), SEQ, 8192, 1024, 1024, 1024}; pg8::StaticOrder S; S.init(SEQ, 8192, F.G, obid());
              pg8::EpiGate8 E{(bf16*)(ws + WS_Z), (const float*)(ws + WS_SA8), (const float*)(ws + WS_SB8) + ZC_GATE, inp(4) + (size_t)layer * 4 * 2048, (const float*)(ws + WS_SWOUT8)};
              pg8::gemm_phase<pg8::EpiGate8, pg8::StaticOrder, true, true, true>(F.lds, g, S, E, F.wv); }
        } SEAM(pb + 5);
        if (IN(pb + 6)) for (int rep = 0; rep < NREP(6); ++rep) { unsigned char* const ws = ows(F.ws_base);
            int k6 = 256; asm volatile("" : "+s"(k6));
            pg8::Gemm g{(const bf16*)(ws + WS_ACT8), (const bf16*)(ws + WS_WOUT8), 4 * SEQ, 4 * 2048, k6, 256, 256};
            pg8::MergedOrder S; S.S0.init(SEQ, 2048, F.G, obid());
            pg8::EpiMerged8 E{(bf16*)(ws + WS_MERGED), (const bf16*)(ws + WS_Z), (const float*)(ws + WS_SACT8)};
            pg8::gemm_phase<pg8::EpiMerged8, pg8::MergedOrder, true, true, true>(F.lds, g, S, E, F.wv);
        } SEAM(pb + 6);
        if (IN(pb + 7)) { unsigned char* const ws = ows(F.ws_base);
            { const int tid_ = otid(F.wv), lane_ = tid_ & 63, gw_ = obid() * NWAVES + F.wv, NGW_ = F.G * NWAVES;
              for (int r = gw_; r < SEQ; r += NGW_) row_bf16_to_i8((const bf16*)(ws + WS_MERGED) + (size_t)r * 2048, ws + WS_M8 + (size_t)r * 2048, (float*)(ws + WS_SM8) + r, lane_);
              asm volatile("s_waitcnt vmcnt(0)" ::: "memory"); }
            if (MK_ONE_LAUNCH) xcd_barrier(bar);
            pg8::Gemm g{(const bf16*)(ws + WS_M8), (const bf16*)(ws + WS_WO8), SEQ, 2048, 1024, 1024, 1024}; pg8::StaticOrder S; S.init(SEQ, 2048, F.G, obid());
            pg8::EpiRes8 E{layer == 0 ? inp(0) : (const float*)(ws + WS_XA), (float*)(ws + WS_XA), (const float*)(ws + WS_SM8), (const float*)(ws + WS_SWO8)};
            pg8::gemm_phase<pg8::EpiRes8, pg8::StaticOrder, false, true, true>(F.lds, g, S, E, F.wv);
        } SEAM(pb + 7);
        if (IN(pb + 8)) { p8_ffn_norm(F, layer); } SEAM(pb + 8);
        if (IN(pb + 9)) for (int rep = 0; rep < NREP(9); ++rep) { unsigned char* const ws = ows(F.ws_base);
            pg8::Gemm g{(const bf16*)(ws + WS_H2I8), (const bf16*)(ws + WS_WQ8), SEQ, 1024, 1024, 1024, 1024}; pg8::StaticOrder S; S.init(SEQ, 1024, F.G, obid());
            pg8::EpiPQ8 E{(float*)(ws + WS_PQ), (const float*)(ws + WS_HSCI), (const float*)(ws + WS_SWQ8)};
            pg8::gemm_phase<pg8::EpiPQ8, pg8::StaticOrder, false, true, true>(F.lds, g, S, E, F.wv);
        } SEAM(pb + 9);
        if (IN(pb + 10)) { for (int rep = 0; rep < NREP(10); ++rep) p10_route(F, layer); } SEAM(pb + 10);
        if (IN(pb + 11)) { p11_peer(F, layer, args.out); }
        if (layer + 1 < NLAYER) SEAM(pb + 11);
    }
#undef IN
#undef SEAM
}

extern "C" void kernel_launch(void* const* d_in, const int* in_sizes, int n_in, void* d_out, int out_size, void* d_ws, size_t ws_size, hipStream_t stream) {
    static int grid = 0;
    if (grid == 0) {
        if (n_in != 27 || out_size != SEQ * DMODEL || ws_size < WS_END) { fprintf(stderr, "kernel_launch: unexpected problem (n_in %d, out %d, ws %zu); nothing launched\n", n_in, out_size, ws_size); grid = -1; return; }
        int dev = 0, cus = 0, per_cu = 0;
        if (hipGetDevice(&dev) != hipSuccess || hipDeviceGetAttribute(&cus, hipDeviceAttributeMultiprocessorCount, dev) != hipSuccess) { grid = -1; return; }
        if (hipFuncSetAttribute((const void*)mk_fwd, hipFuncAttributeMaxDynamicSharedMemorySize, LDS_BYTES) != hipSuccess) { fprintf(stderr, "kernel_launch: hipFuncSetAttribute failed\n"); grid = -1; return; }
        if (hipOccupancyMaxActiveBlocksPerMultiprocessor(&per_cu, (const void*)mk_fwd, NTHREADS, LDS_BYTES) != hipSuccess || per_cu < 1) { fprintf(stderr, "kernel_launch: occupancy query says %d\n", per_cu); per_cu = 1; }
        (void)hipGetLastError();
        grid = cus;
    }
    if (grid < 0) return;
    (void)in_sizes;
    if (hipMemsetAsync((char*)d_ws + WS_CTL, 0, CTL_ZERO_BYTES, stream) != hipSuccess) return;
    Args a{};
    for (int i = 0; i < 27; ++i) a.in[i] = (const float*)d_in[i];
    a.out = (float*)d_out; a.ws = (unsigned char*)d_ws;
#if MK_ONE_LAUNCH
    a.ph_lo = 0; a.ph_hi = N_PHASES;
    hipLaunchKernelGGL(mk_fwd, dim3(grid), dim3(NTHREADS), LDS_BYTES, stream, a);
#else
    for (int p = 0; p < N_PHASES; ++p) { a.ph_lo = p; a.ph_hi = p + 1; hipLaunchKernelGGL(mk_fwd, dim3(grid), dim3(NTHREADS), LDS_BYTES, stream, a); }
#endif
}
```

```cpp
#include <hip/hip_runtime.h>
#include <cstdio>
#include <cstdint>
__device__ __forceinline__ int otid(int wv) { int t = wv * 64 + (int)__builtin_amdgcn_mbcnt_hi(~0u, __builtin_amdgcn_mbcnt_lo(~0u, 0u)); asm volatile("" : "+v"(t)); return t; }
__device__ __forceinline__ int obid() { int b = (int)blockIdx.x; asm volatile("" : "+s"(b)); return b; }
__device__ __forceinline__ unsigned char* ows(unsigned char* p) { __attribute__((address_space(1))) unsigned char* g = (__attribute__((address_space(1))) unsigned char*)p; asm volatile("" : "+s"(g)); return (unsigned char*)g; }
namespace pg8 {
#define PG8_LAS __attribute__((address_space(3)))
typedef unsigned short bf16_t;
typedef short bf16x8 __attribute__((ext_vector_type(8)));
typedef float f32x4 __attribute__((ext_vector_type(4)));
typedef unsigned u32x4 __attribute__((ext_vector_type(4)));
constexpr int BM = 256, BK = 64, HALF = 128, HTB = HALF * BK * 2  , STAGE_BYTES = 8 * HTB, NXCD = 8, WGM = 8;

__host__ __device__ __forceinline__ int lds_byte(int r, int c) { const int st = (r >> 4) * 2 + (c >> 5), rr = r & 15, cc = c & 31, ob = rr * 64 + cc * 2; return st * 1024 + (ob ^ (((ob >> 9) & 1) << 5)); }
__host__ __device__ __forceinline__ void stage_rc(int b, int& R, int& C) { const int st = b / 1024, sb = b % 1024, swz = sb ^ (((sb >> 9) & 1) << 5); R = (st >> 1) * 16 + swz / 64; C = (st & 1) * 32 + (swz % 64) / 2; }
__host__ __device__ __forceinline__ int perm32(int rho) { const int n = rho >> 4, i = rho & 15; return 8 * (i >> 2) + 4 * n + (i & 3); }

struct Unit { int pm, pn, ka; };
struct Gemm { const bf16_t* A; const bf16_t* Bt; int M, N, K, lda, ldb; };

struct StaticOrder {
    int nM, nN, nwg, G, c;
    __host__ __device__ void init(int M, int N, int G_, int c_) { nM = M / BM; nN = N / BM; nwg = nM * nN; G = G_; c = c_; }
    __host__ __device__ bool next(int i, Unit& u) const {
        const long L = (long)i * G + c; if (L >= nwg) return false;
        int wgid = (int)L; { const int q = nwg / NXCD, r = nwg % NXCD, xcd = wgid % NXCD, off = wgid / NXCD; wgid = (xcd < r ? xcd * (q + 1) : r * (q + 1) + (xcd - r) * q) + off; }
        const int nig = WGM * nN, gid = wgid / nig, fm = gid * WGM, gsz = (nM - fm) < WGM ? (nM - fm) : WGM;
        u.pm = fm + ((wgid % nig) % gsz); u.pn = (wgid % nig) / gsz; u.ka = 0; return true;
    }
    __device__ __forceinline__ void a_ready(const Unit&) const {}
    __device__ __forceinline__ void done(const Unit&) const {}
};

__device__ __forceinline__ unsigned cvt_pk_bf16(float lo, float hi) { unsigned r; asm volatile("v_cvt_pk_bf16_f32 %0, %1, %2" : "=v"(r) : "v"(lo), "v"(hi)); return r; }
typedef float f32x2 __attribute__((ext_vector_type(2)));

typedef int pg8_v4i __attribute__((ext_vector_type(4)));
template <class Epi, class Sched, bool ALIGN_EPI = false, bool SP2 = false, bool I8 = false>
__device__ __forceinline__ void gemm_phase(PG8_LAS unsigned char* lds, const Gemm g, const Sched& S, const Epi& E, int wv) {
    const int tid = otid(wv), wid = __builtin_amdgcn_readfirstlane(tid >> 6), lane = tid & 63, wr = wid >> 2, wc = wid & 3, fr = lane & 15, fq = lane >> 4;
    const int K = g.K, nt = K / BK;
    unsigned voffA[2], voffB[2];
#pragma unroll
    for (int i = 0; i < 2; ++i) { int R, C; stage_rc(tid * 16 + i * 8192, R, C); const int Rb = Epi::PERM ? ((R & ~31) + perm32(R & 31)) : R;
        voffA[i] = (unsigned)(R * g.lda + C) * 2u; voffB[i] = (unsigned)(Rb * g.ldb + C) * 2u; }
    const size_t kstep = (size_t)(BK * 2);
    const size_t hstepA = (size_t)HALF * g.lda * 2, hstepB = (size_t)HALF * g.ldb * 2;
    const size_t tstepA = 2 * hstepA, tstepB = 2 * hstepB;
    const unsigned ldsw = (unsigned)wid * 1024u;
    const int aoff = lds_byte(wr * 64 + fr, fq * 8), boff = lds_byte(wc * 32 + fr, fq * 8);
#define PG8_SA(b, h) (((b) * 2 + (h)) * HTB)
#define PG8_SB(b, h) ((4 + (b) * 2 + (h)) * HTB)
#define PG8_STAGE(bufoff, gbase, voff) do { _Pragma("unroll") for (int _i = 0; _i < 2; ++_i) \
        __builtin_amdgcn_global_load_lds((const unsigned*)((const char*)(gbase) + (voff)[_i]), (PG8_LAS unsigned*)(lds + (bufoff) + ldsw + _i * 8192), 16, 0, 0); } while (0)
#define PG8_LDA(dst, b, h) do { _Pragma("unroll") for (int m = 0; m < 4; ++m) _Pragma("unroll") for (int k = 0; k < 2; ++k) dst[m][k] = *(const PG8_LAS bf16x8*)(lds + PG8_SA(b, h) + aoff + m * 2048 + k * 1024); } while (0)
#define PG8_LDB(dst, b, h) do { _Pragma("unroll") for (int n = 0; n < 2; ++n) _Pragma("unroll") for (int k = 0; k < 2; ++k) dst[n][k] = *(const PG8_LAS bf16x8*)(lds + PG8_SB(b, h) + boff + n * 2048 + k * 1024); } while (0)
#define PG8_MMA(ai, bj, At, Bt) do { __builtin_amdgcn_s_setprio(1); _Pragma("unroll") for (int m = 0; m < 4; ++m) _Pragma("unroll") for (int n = 0; n < 2; ++n) _Pragma("unroll") for (int k = 0; k < 2; ++k) { \
        if constexpr (I8) acc[ai][bj][m][n] = __builtin_bit_cast(f32x4, __builtin_amdgcn_mfma_i32_16x16x64_i8(__builtin_bit_cast(pg8_v4i, Bt[n][k]), __builtin_bit_cast(pg8_v4i, At[m][k]), __builtin_bit_cast(pg8_v4i, acc[ai][bj][m][n]), 0, 0, 0)); \
        else acc[ai][bj][m][n] = __builtin_amdgcn_mfma_f32_16x16x32_bf16(Bt[n][k], At[m][k], acc[ai][bj][m][n], 0, 0, 0); } __builtin_amdgcn_s_setprio(0); } while (0)
#define PG8_WAIT_V(n) asm volatile("s_waitcnt vmcnt(" #n ")" ::: "memory")
#define PG8_WAIT_L(n) asm volatile("s_waitcnt lgkmcnt(" #n ")" ::: "memory")
#define PG8_BAR __builtin_amdgcn_s_barrier()
#define PG8_SCHED __builtin_amdgcn_sched_barrier(0)
    Unit cur, nxt; int ui = 0;
    if (!S.next(0, cur)) return;
    f32x4 acc[2][2][4][2];
#pragma unroll
    for (int a = 0; a < 2; ++a)
#pragma unroll
        for (int b = 0; b < 2; ++b)
#pragma unroll
            for (int m = 0; m < 4; ++m)
#pragma unroll
                for (int n = 0; n < 2; ++n) acc[a][b][m][n] = (f32x4){0.f, 0.f, 0.f, 0.f};
    bf16x8 At[4][2], B0[2][2], B1[2][2];
    const char* cA = (const char*)g.A + (size_t)cur.pm * tstepA + (size_t)cur.ka * 2; const char* cB = (const char*)g.Bt + (size_t)cur.pn * tstepB;
    S.a_ready(cur);
    if constexpr (SP2) {
        PG8_STAGE(PG8_SB(0, 0), cB, voffB); PG8_STAGE(PG8_SB(0, 1), cB + hstepB, voffB); PG8_STAGE(PG8_SA(0, 0), cA, voffA); PG8_STAGE(PG8_SA(0, 1), cA + hstepA, voffA);
        if (wr == 1) PG8_BAR;
        PG8_WAIT_V(2); PG8_BAR;
        PG8_STAGE(PG8_SB(1, 0), cB + kstep, voffB); PG8_STAGE(PG8_SA(1, 0), cA + kstep, voffA); PG8_STAGE(PG8_SB(1, 1), cB + hstepB + kstep, voffB);
        PG8_WAIT_V(6); PG8_BAR;
    } else {
        PG8_STAGE(PG8_SB(0, 0), cB, voffB); PG8_STAGE(PG8_SA(0, 0), cA, voffA); PG8_STAGE(PG8_SB(0, 1), cB + hstepB, voffB); PG8_STAGE(PG8_SA(0, 1), cA + hstepA, voffA);
        if (wr == 1) PG8_BAR;
        PG8_WAIT_V(4); PG8_BAR;
        PG8_STAGE(PG8_SB(1, 0), cB + kstep, voffB); PG8_STAGE(PG8_SA(1, 0), cA + kstep, voffA); PG8_STAGE(PG8_SB(1, 1), cB + hstepB + kstep, voffB);
        PG8_WAIT_V(6); PG8_BAR;
    }
    for (;;) {
        const bool has_next = S.next(ui + 1, nxt);
        const char* nA = has_next ? (const char*)g.A + (size_t)nxt.pm * tstepA + (size_t)nxt.ka * 2 : cA; const char* nB = has_next ? (const char*)g.Bt + (size_t)nxt.pn * tstepB : cB;
        for (int t = 0; t < nt; t += 2) {
            const bool last = (t == nt - 2);
            const char* a1 = cA + (size_t)(t + 1) * kstep;
            const char* a2 = last ? nA : cA + (size_t)(t + 2) * kstep; const char* b2 = last ? nB : cB + (size_t)(t + 2) * kstep;
            const char* a3 = a2 + kstep; const char* b3 = b2 + kstep;
            if (last && has_next) S.a_ready(nxt);
            if constexpr (SP2) {
            PG8_LDB(B0, 0, 0); PG8_LDB(B1, 0, 1); PG8_SCHED; PG8_LDA(At, 0, 0); PG8_STAGE(PG8_SA(1, 1), a1 + hstepA, voffA);
            PG8_WAIT_V(8); PG8_WAIT_L(0); PG8_BAR; PG8_MMA(0, 0, At, B0); PG8_MMA(0, 1, At, B1); PG8_BAR; PG8_SCHED;
            PG8_LDA(At, 0, 1); PG8_STAGE(PG8_SB(0, 0), b2, voffB); PG8_STAGE(PG8_SB(0, 1), b2 + hstepB, voffB); PG8_STAGE(PG8_SA(0, 0), a2, voffA);
            PG8_WAIT_V(8); PG8_WAIT_L(0); PG8_BAR; PG8_MMA(1, 0, At, B0); PG8_MMA(1, 1, At, B1); PG8_BAR; PG8_SCHED;
            PG8_LDB(B0, 1, 0); PG8_LDB(B1, 1, 1); PG8_SCHED; PG8_LDA(At, 1, 0); PG8_STAGE(PG8_SA(0, 1), a2 + hstepA, voffA);
            PG8_WAIT_V(8); PG8_WAIT_L(0); PG8_BAR; PG8_MMA(0, 0, At, B0); PG8_MMA(0, 1, At, B1); PG8_BAR; PG8_SCHED;
            PG8_LDA(At, 1, 1); PG8_STAGE(PG8_SB(1, 0), b3, voffB); PG8_STAGE(PG8_SB(1, 1), b3 + hstepB, voffB); PG8_STAGE(PG8_SA(1, 0), a3, voffA);
            PG8_WAIT_V(8); PG8_WAIT_L(0); PG8_BAR; PG8_MMA(1, 0, At, B0); PG8_MMA(1, 1, At, B1); PG8_BAR; PG8_SCHED;
            } else {
            PG8_LDB(B0, 0, 0); PG8_SCHED; PG8_LDA(At, 0, 0); PG8_STAGE(PG8_SA(1, 1), a1 + hstepA, voffA);
            PG8_WAIT_L(8); PG8_BAR; PG8_WAIT_L(0); PG8_MMA(0, 0, At, B0); PG8_BAR; PG8_SCHED;
            PG8_LDB(B1, 0, 1); PG8_STAGE(PG8_SB(0, 0), b2, voffB);
            PG8_BAR; PG8_WAIT_L(0); PG8_MMA(0, 1, At, B1); PG8_BAR;
            PG8_LDA(At, 0, 1); PG8_STAGE(PG8_SA(0, 0), a2, voffA);
            PG8_BAR; PG8_WAIT_L(0); PG8_MMA(1, 0, At, B0); PG8_BAR; PG8_SCHED;
            PG8_STAGE(PG8_SB(0, 1), b2 + hstepB, voffB);
            PG8_WAIT_V(6); PG8_BAR; PG8_MMA(1, 1, At, B1); PG8_BAR;
            PG8_LDB(B0, 1, 0); PG8_SCHED; PG8_LDA(At, 1, 0); PG8_STAGE(PG8_SA(0, 1), a2 + hstepA, voffA);
            PG8_WAIT_L(8); PG8_BAR; PG8_WAIT_L(0); PG8_MMA(0, 0, At, B0); PG8_BAR; PG8_SCHED;
            PG8_LDB(B1, 1, 1); PG8_STAGE(PG8_SB(1, 0), b3, voffB);
            PG8_BAR; PG8_WAIT_L(0); PG8_MMA(0, 1, At, B1); PG8_BAR;
            PG8_LDA(At, 1, 1); PG8_STAGE(PG8_SA(1, 0), a3, voffA);
            PG8_BAR; PG8_WAIT_L(0); PG8_MMA(1, 0, At, B0); PG8_BAR; PG8_SCHED;
            PG8_STAGE(PG8_SB(1, 1), b3 + hstepB, voffB);
            PG8_WAIT_V(6); PG8_BAR; PG8_MMA(1, 1, At, B1); PG8_BAR;
            }
        }
        if constexpr (ALIGN_EPI) { if (wr == 0) PG8_BAR; }
        if constexpr (!Epi::AFTER_DRAIN) { E(acc, cur, wr, wc, fr, fq); S.done(cur); }
        if (!has_next) break;
#pragma unroll
        for (int a = 0; a < 2; ++a)
#pragma unroll
            for (int b = 0; b < 2; ++b)
#pragma unroll
                for (int m = 0; m < 4; ++m)
#pragma unroll
                    for (int n = 0; n < 2; ++n) acc[a][b][m][n] = (f32x4){0.f, 0.f, 0.f, 0.f};
        cur = nxt; cA = nA; cB = nB; ++ui;
        if constexpr (ALIGN_EPI) { if (wr == 1) PG8_BAR; }
    }
    PG8_WAIT_V(0);
    if constexpr (!ALIGN_EPI) { if (wr == 0) PG8_BAR; }
    PG8_BAR;
    if constexpr (Epi::AFTER_DRAIN) { E.fused(acc, cur, wr, wc, fr, fq, lds, wid, lane); S.done(cur); }
#undef PG8_SA
#undef PG8_SB
#undef PG8_STAGE
#undef PG8_LDA
#undef PG8_LDB
#undef PG8_MMA
#undef PG8_WAIT_V
#undef PG8_WAIT_L
#undef PG8_BAR
#undef PG8_SCHED
}
}

#define GAS __attribute__((address_space(1)))
#define LAS __attribute__((address_space(3)))
typedef unsigned short bf16;
typedef unsigned v4u __attribute__((ext_vector_type(4)));
typedef float f32x4 __attribute__((ext_vector_type(4)));
typedef short bf16x8 __attribute__((ext_vector_type(8)));
typedef GAS unsigned gu32;
typedef GAS unsigned long long gu64;
#define RLX_AGENT __ATOMIC_RELAXED, __HIP_MEMORY_SCOPE_AGENT
#define LDS_WAIT() asm volatile("s_waitcnt lgkmcnt(0)" ::: "memory")
#define VM_WAIT() asm volatile("s_waitcnt vmcnt(0)" ::: "memory")
__device__ __forceinline__ unsigned long long rt() { return __builtin_amdgcn_s_memrealtime(); }
__device__ __forceinline__ unsigned f2bf(float f) { unsigned u = __builtin_bit_cast(unsigned, f); return (u + 0x7fffu + ((u >> 16) & 1u)) >> 16; }
__device__ __forceinline__ unsigned pk2(float lo, float hi) { return f2bf(lo) | (f2bf(hi) << 16); }

#define XB_TMO      128
#define XB_XCNT(j)  (256  + 64 * (j))
#define XB_XSUB(j)  (1280 + 64 * (j))
#define XB_XGEN(j)  (2304 + 64 * (j))
#define XB_TOP      3328
#define XB_TOPGEN   3392
#define XCD_BAR_WORDS 3456
#define XB_SPIN_CAP (1u << 18)

__device__ __forceinline__ unsigned xb_ld(unsigned* p)              { return __hip_atomic_load(p, __ATOMIC_RELAXED, __HIP_MEMORY_SCOPE_AGENT); }
__device__ __forceinline__ unsigned xb_add(unsigned* p, unsigned v) { return __hip_atomic_fetch_add(p, v, __ATOMIC_RELAXED, __HIP_MEMORY_SCOPE_AGENT); }
__device__ __forceinline__ unsigned xb_xcc_id() { return (unsigned)__builtin_amdgcn_s_getreg((3 << 11) | 20) & 0xFu; }
#define XB_SPIN(cond, bar) do { unsigned _sp = 0; while (cond) { __builtin_amdgcn_s_sleep(1); \
    if ((++_sp & 255u) == 0u) { if (xb_ld(&(bar)[XB_TMO])) break; if (_sp > XB_SPIN_CAP) { atomicAdd(&(bar)[XB_TMO], 1u); break; } } } } while (0)

struct XcdBarrier {
    unsigned* bar; unsigned x;
    int wv;
    volatile LAS unsigned* st;
};

__device__ __forceinline__ XcdBarrier xcd_barrier_post(unsigned* bar, volatile LAS unsigned* st, int wv) {
    XcdBarrier b; b.bar = bar; b.x = xb_xcc_id(); b.st = st; b.wv = wv;
    if (otid(wv) == 0) (void)xb_add(&bar[XB_XCNT(b.x)], 1u);
    return b;
}
__device__ __forceinline__ void xcd_barrier_complete(unsigned* bar, unsigned x, unsigned& nloc, unsigned& nx) {
    const unsigned G = gridDim.x * gridDim.y * gridDim.z;
    unsigned sum, cnt, mine, sp = 0u;
    for (;;) {
        sum = 0u; cnt = 0u; mine = 0u;
#pragma unroll
        for (unsigned j = 0; j < 16; ++j) { const unsigned c = xb_ld(&bar[XB_XCNT(j)]); sum += c; cnt += (c > 0u) ? 1u : 0u; mine = (j == x) ? c : mine; }
        if (sum == G) break;
        __builtin_amdgcn_s_sleep(1);
        if ((++sp & 255u) == 0u) { if (xb_ld(&bar[XB_TMO])) break; if (sp > XB_SPIN_CAP) { atomicAdd(&bar[XB_TMO], 1u); break; } }
    }
    nloc = mine > 0u ? mine : 1u; nx = cnt > 0u ? cnt : 1u;
}

__device__ __forceinline__ void xcd_barrier(const XcdBarrier& b) {
    asm volatile("s_waitcnt vmcnt(0)" ::: "memory");
    __syncthreads();
    if (otid(b.wv) == 0) {
        unsigned* bar = b.bar; asm volatile("" : "+s"(bar)); unsigned bx_ = b.x; asm volatile("" : "+s"(bx_));
        __builtin_amdgcn_s_waitcnt(0);
        unsigned nloc = b.st[0], nx = b.st[1];
        if (nloc == 0u) { xcd_barrier_complete(bar, bx_, nloc, nx); b.st[0] = nloc; b.st[1] = nx; }
        const unsigned old = xb_add(&bar[XB_XSUB(bx_)], 1u);
        const unsigned gen = old / nloc;
        if (old + 1u == (gen + 1u) * nloc) {
            __builtin_amdgcn_fence(__ATOMIC_RELEASE, "agent");
            asm volatile("s_waitcnt vmcnt(0)" ::: "memory");
            const unsigned og = xb_add(&bar[XB_TOP], 1u);
            const unsigned tg = og / nx;
            if (og + 1u == (tg + 1u) * nx) xb_add(&bar[XB_TOPGEN], 1u);
            else XB_SPIN(xb_ld(&bar[XB_TOPGEN]) == tg, bar);
            __builtin_amdgcn_fence(__ATOMIC_ACQUIRE, "agent");
            xb_add(&bar[XB_XGEN(bx_)], 1u);
            asm volatile("s_waitcnt vmcnt(0)" ::: "memory");
        } else {
            XB_SPIN(xb_ld(&bar[XB_XGEN(bx_)]) == gen, bar);
            __builtin_amdgcn_fence(__ATOMIC_ACQUIRE, "agent");
            asm volatile("s_waitcnt vmcnt(0)" ::: "memory");
        }
    }
    __syncthreads();
}


constexpr int NWAVES = 8, NTHREADS = 512;
constexpr int SEQ = 8192, DMODEL = 2048, NLAYER = 2;
constexpr int INC = 13088;
constexpr int ZC = 13312;
constexpr int ZC_CQ = 0, ZC_CKV = 512, ZC_BG = 768, ZC_CG = 1280, ZC_XV = 1792, ZC_DQ = 2304, ZC_DK = 2816, ZC_DV = 3328, ZC_CA = 3840, ZC_CGT = 4352, ZC_KR = 4864, ZC_GATE = 5120;
constexpr int QMC = 768, KVC = 1024;
constexpr float LOG2E = 1.4426950408889634f;
constexpr float C2_MLA = 0.10206207261596577f * LOG2E;
constexpr float C2_DIFF = 0.125f * LOG2E;
constexpr float NORM_EPS = 1e-6f, LN_EPS = 1e-5f;
constexpr int PEER_NE = 16384;

constexpr size_t MiB = 1u << 20;
constexpr size_t WS_CTL = 0, CTL_ZERO_BYTES = 1 * MiB;
constexpr size_t WS_COSM = 1 * MiB, WS_SINM = WS_COSM + 512 * 1024, WS_COSD = 2 * MiB, WS_SIND = WS_COSD + 256 * 1024, WS_RSTD = 3 * MiB;
constexpr size_t WS_SUBK = 3 * MiB + 512 * 1024;
constexpr size_t WS_WIN = 4 * MiB;
constexpr size_t WS_WUQ = 56 * MiB;
constexpr size_t WS_WUKV = 57 * MiB;
constexpr size_t WS_WOUT = 58 * MiB;
constexpr size_t WS_WO = 66 * MiB;
constexpr size_t WS_WQ = 74 * MiB;
constexpr size_t WS_UBF = 80 * MiB;
constexpr size_t WS_VBF = 144 * MiB;
constexpr size_t WS_USC = 112 * MiB, WS_VSC = 176 * MiB;
constexpr size_t WS_H = 208 * MiB;
constexpr size_t WS_H2 = 240 * MiB;
constexpr size_t WS_Z = 272 * MiB;
constexpr size_t WS_QM = 480 * MiB;
constexpr size_t WS_KVM = 492 * MiB;
constexpr size_t WS_ACT = 508 * MiB;
constexpr size_t WS_DO = 540 * MiB;
constexpr size_t WS_MERGED = 556 * MiB;
constexpr size_t WS_XA = 588 * MiB;
constexpr size_t WS_PQ = 652 * MiB;
constexpr size_t WS_IDX = 684 * MiB;
constexpr size_t WS_GATE = 688 * MiB;
constexpr size_t WS_H2F8 = 692 * MiB;
constexpr size_t WS_HSCI = 708 * MiB;
constexpr size_t WS_A8 = 709 * MiB;
constexpr size_t WS_B8 = 725 * MiB;
constexpr size_t WS_SA8 = 752 * MiB;
constexpr size_t WS_SB8 = 752 * MiB + 65536;
constexpr size_t WS_M8 = 753 * MiB;
constexpr size_t WS_WO8 = 769 * MiB;
constexpr size_t WS_SM8 = 773 * MiB;
constexpr size_t WS_SWO8 = 773 * MiB + 65536;
constexpr size_t WS_H2I8 = 774 * MiB;
constexpr size_t WS_WQ8 = 790 * MiB;
constexpr size_t WS_SWQ8 = 792 * MiB;
constexpr size_t WS_ACT8 = 793 * MiB;
constexpr size_t WS_WOUT8 = 809 * MiB;
constexpr size_t WS_SACT8 = 813 * MiB;
constexpr size_t WS_SWOUT8 = 813 * MiB + 262144;
constexpr size_t WS_QA8 = 814 * MiB;
constexpr size_t WS_WUQ8 = 822 * MiB;
constexpr size_t WS_SWUQ8 = 823 * MiB;
constexpr size_t WS_END = 824 * MiB;
constexpr int CW_BAR = 4096;
constexpr int CW_QATT = 16384;

constexpr int RING_BYTES = 131072;
constexpr int LDSCTL_OFF = RING_BYTES, MISC_OFF = LDSCTL_OFF + 320;
constexpr int LDS_PART_OFF = LDSCTL_OFF + 1024;
constexpr int LDS_BYTES = 147456;

struct Frame {
    LAS unsigned char* lds;
    int wv;
    volatile LAS unsigned* MISC;
    gu32* ctl;
    int G;
    unsigned char* ws_base;
};
#define PHASE_IDS() const int tid = otid(F.wv), lane = tid & 63, wave = __builtin_amdgcn_readfirstlane(tid >> 6); (void)lane; (void)wave; unsigned char* const ws = ows(F.ws_base); (void)ws

template <int CTRL> __device__ __forceinline__ float dpp_f(float v) { return __builtin_bit_cast(float, __builtin_amdgcn_update_dpp(0, __builtin_bit_cast(int, v), CTRL, 0xF, 0xF, false)); }
__device__ __forceinline__ float rl(float v, int l) { return __builtin_bit_cast(float, __builtin_amdgcn_readlane(__builtin_bit_cast(int, v), l)); }
__device__ __forceinline__ float wave_sum(float v) {
    v += dpp_f<0xB1>(v); v += dpp_f<0x4E>(v); v += dpp_f<0x141>(v); v += dpp_f<0x140>(v);
    return (rl(v, 0) + rl(v, 16)) + (rl(v, 32) + rl(v, 48));
}
__device__ __forceinline__ float wave_max(float v) {
    v = fmaxf(v, dpp_f<0xB1>(v)); v = fmaxf(v, dpp_f<0x4E>(v)); v = fmaxf(v, dpp_f<0x141>(v)); v = fmaxf(v, dpp_f<0x140>(v));
    return fmaxf(fmaxf(rl(v, 0), rl(v, 16)), fmaxf(rl(v, 32), rl(v, 48)));
}
__device__ __forceinline__ float row16_sum(float v) { v += dpp_f<0xB1>(v); v += dpp_f<0x4E>(v); v += dpp_f<0x141>(v); v += dpp_f<0x140>(v); return v; }
__device__ __forceinline__ float bf_lo(unsigned w) { return __builtin_bit_cast(float, w << 16); }
__device__ __forceinline__ float bf_hi(unsigned w) { return __builtin_bit_cast(float, w & 0xffff0000u); }
__device__ __forceinline__ float bf2f(bf16 b) { return __builtin_bit_cast(float, (unsigned)b << 16); }
__device__ __forceinline__ float sigmoidf_(float x) { return __builtin_amdgcn_rcpf(1.f + __builtin_amdgcn_exp2f(-1.4426950408889634f * x)); }
typedef __bf16 bf16x2_t __attribute__((ext_vector_type(2)));
__device__ __forceinline__ float dot2_bf16(unsigned w, unsigned x, float acc) { return __builtin_amdgcn_fdot2_f32_bf16(__builtin_bit_cast(bf16x2_t, w), __builtin_bit_cast(bf16x2_t, x), acc, false); }

__device__ __forceinline__ int colmap(int mode, int c) {
    if (mode == 0) return c;
    if (mode == 1) {
        if (c < 768) return c;
        if (c < 2304) return 800 + (c - 768);
        if (c < 3328) { const int seg = c >= 2816, o = c - (seg ? 2816 : 2304), d = o & 63, dd = d < 16 ? ((d >> 1) + 8 * (d & 1)) : d; return (seg ? 2848 : 2336) + (o & ~63) + dd; }
        if (c < 3840) return 3360 + (c - 3328);
        if (c < 4864) return 3872 + (c - 3840);
        if (c < 4896) { const int d = c - 4864; return 768 + (d >> 1) + 16 * (d & 1); }
        if (c < 5120) return -1;
        return 4896 + (c - 5120);
    }
    { const int hd = c / 96, d = c % 96; if (d < 64) return c; const int e = d - 64; return hd * 96 + 64 + (e >> 1) + 16 * (e & 1); }
}
__device__ __forceinline__ void tr_item(const float* W, int ldw, const float* gk, bf16* WT, int ldt, int nblk, int item, int mode, LAS float* scr, int lane) {
    const int kb = item / nblk, nb = item % nblk, k0 = 64 * kb, n0 = 32 * nb;
    const int sc = colmap(mode, n0 + (lane & 31));
    float tv[32];
    { const float* wp = W + (size_t)(k0 + (lane >> 5)) * ldw + (sc >= 0 ? sc : 0);
#pragma unroll
      for (int i = 0; i < 32; ++i) tv[i] = wp[(size_t)(2 * i) * ldw]; }
    if (gk) {
#pragma unroll
        for (int i = 0; i < 32; ++i) tv[i] *= gk[k0 + 2 * i + (lane >> 5)]; }
#pragma unroll
    for (int i = 0; i < 32; ++i) scr[(2 * i + (lane >> 5)) * 33 + (lane & 31)] = sc >= 0 ? tv[i] : 0.f;
    LDS_WAIT(); asm volatile("" ::: "memory");
    const int c = lane & 7;
#pragma unroll
    for (int j = 0; j < 4; ++j) { const int n = (lane >> 3) + 8 * j; const LAS float* s = scr + (8 * c) * 33 + n;
        v4u o; o.x = pk2(s[0 * 33], s[1 * 33]); o.y = pk2(s[2 * 33], s[3 * 33]); o.z = pk2(s[4 * 33], s[5 * 33]); o.w = pk2(s[6 * 33], s[7 * 33]);
        *(GAS v4u*)(WT + (size_t)(n0 + n) * ldt + k0 + 8 * c) = o; }
    LDS_WAIT(); asm volatile("" ::: "memory");
}
__device__ __forceinline__ void rms_row_to_bf16(const float* xrow, const float* g, bf16* orow, int lane) {
    const GAS f32x4* xr = (const GAS f32x4*)xrow + lane; const GAS f32x4* gr = (const GAS f32x4*)g + lane;
    f32x4 v[8]; float s = 0.f;
#pragma unroll
    for (int j = 0; j < 8; ++j) { v[j] = xr[64 * j]; s += (v[j].x * v[j].x + v[j].y * v[j].y) + (v[j].z * v[j].z + v[j].w * v[j].w); }
    const float rstd = 1.f / sqrtf(wave_sum(s) * (1.f / DMODEL) + NORM_EPS);
    GAS unsigned long long* o8 = (GAS unsigned long long*)orow + lane;
#pragma unroll
    for (int j = 0; j < 8; ++j) { const f32x4 gg = gr[64 * j]; o8[64 * j] = (unsigned long long)pk2(v[j].x * rstd * gg.x, v[j].y * rstd * gg.y) | ((unsigned long long)pk2(v[j].z * rstd * gg.z, v[j].w * rstd * gg.w) << 32); }
}
__device__ __forceinline__ unsigned q4_i8(float a, float b, float c, float d) {
    const int q0 = (int)__builtin_rintf(a), q1 = (int)__builtin_rintf(b), q2 = (int)__builtin_rintf(c), q3 = (int)__builtin_rintf(d);
    return ((unsigned)q0 & 255u) | (((unsigned)q1 & 255u) << 8) | (((unsigned)q2 & 255u) << 16) | ((unsigned)q3 << 24);
}
__device__ __forceinline__ void row_bf16_to_i8(const bf16* src, unsigned char* dst, float* sci, int lane) {
    v4u w[4]; float am = 0.f;
#pragma unroll
    for (int j = 0; j < 4; ++j) { w[j] = *(const GAS v4u*)(src + 8 * (lane + 64 * j));
        am = fmaxf(fmaxf(am, fabsf(bf_lo(w[j].x))), fabsf(bf_hi(w[j].x))); am = fmaxf(fmaxf(am, fabsf(bf_lo(w[j].y))), fabsf(bf_hi(w[j].y)));
        am = fmaxf(fmaxf(am, fabsf(bf_lo(w[j].z))), fabsf(bf_hi(w[j].z))); am = fmaxf(fmaxf(am, fabsf(bf_lo(w[j].w))), fabsf(bf_hi(w[j].w))); }
    am = wave_max(am);
    const float sc = am > 0.f ? 127.f / am : 1.f;
    typedef unsigned v2u_ __attribute__((ext_vector_type(2)));
#pragma unroll
    for (int j = 0; j < 4; ++j)
        *(GAS v2u_*)(dst + 8 * (lane + 64 * j)) = (v2u_){q4_i8(bf_lo(w[j].x) * sc, bf_hi(w[j].x) * sc, bf_lo(w[j].y) * sc, bf_hi(w[j].y) * sc), q4_i8(bf_lo(w[j].z) * sc, bf_hi(w[j].z) * sc, bf_lo(w[j].w) * sc, bf_hi(w[j].w) * sc)};
    if (lane == 0) *(GAS float*)sci = am > 0.f ? am * (1.f / 127.f) : 1.f;
}
__device__ __forceinline__ void q512_store(float (&f)[8], unsigned char* dst, float* sci, int lane) {
    float am = 0.f;
#pragma unroll
    for (int i = 0; i < 8; ++i) am = fmaxf(am, fabsf(f[i]));
    am = wave_max(am);
    const float sc = am > 0.f ? 127.f / am : 1.f;
    typedef unsigned v2u_ __attribute__((ext_vector_type(2)));
    *(GAS v2u_*)(dst + 8 * lane) = (v2u_){q4_i8(f[0] * sc, f[1] * sc, f[2] * sc, f[3] * sc), q4_i8(f[4] * sc, f[5] * sc, f[6] * sc, f[7] * sc)};
    if (lane == 0) *(GAS float*)sci = am > 0.f ? am * (1.f / 127.f) : 1.f;
}
__device__ __forceinline__ void row512_bf16_to_i8(const bf16* src, unsigned char* dst, float* sci, int lane) {
    const v4u w = *(const GAS v4u*)(src + 8 * lane);
    float f[8] = {bf_lo(w.x), bf_hi(w.x), bf_lo(w.y), bf_hi(w.y), bf_lo(w.z), bf_hi(w.z), bf_lo(w.w), bf_hi(w.w)};
    q512_store(f, dst, sci, lane);
}
__device__ __forceinline__ void rms_row_to_i8(const float* xrow, const float* g, unsigned char* dst, float* sci, int lane) {
    const GAS f32x4* xr = (const GAS f32x4*)xrow + lane; const GAS f32x4* gr = (const GAS f32x4*)g + lane;
    f32x4 v[8]; float s = 0.f;
#pragma unroll
    for (int j = 0; j < 8; ++j) { v[j] = xr[64 * j]; s += (v[j].x * v[j].x + v[j].y * v[j].y) + (v[j].z * v[j].z + v[j].w * v[j].w); }
    const float rstd = 1.f / sqrtf(wave_sum(s) * (1.f / DMODEL) + NORM_EPS);
    float am = 0.f;
#pragma unroll
    for (int j = 0; j < 8; ++j) { const f32x4 gg = gr[64 * j];
        v[j].x = bf_lo(pk2(v[j].x * rstd * gg.x, 0.f)); v[j].y = bf_lo(pk2(v[j].y * rstd * gg.y, 0.f)); v[j].z = bf_lo(pk2(v[j].z * rstd * gg.z, 0.f)); v[j].w = bf_lo(pk2(v[j].w * rstd * gg.w, 0.f));
        am = fmaxf(fmaxf(am, fabsf(v[j].x)), fabsf(v[j].y)); am = fmaxf(fmaxf(am, fabsf(v[j].z)), fabsf(v[j].w)); }
    am = wave_max(am);
    const float isc = am > 0.f ? 127.f / am : 1.f;
    GAS unsigned* o1 = (GAS unsigned*)dst + lane;
#pragma unroll
    for (int j = 0; j < 8; ++j) o1[64 * j] = q4_i8(v[j].x * isc, v[j].y * isc, v[j].z * isc, v[j].w * isc);
    if (lane == 0) *(GAS float*)sci = am > 0.f ? am * (1.f / 127.f) : 1.f;
}
#define CAS __attribute__((address_space(4)))
__device__ __forceinline__ const float* inp(int i) { unsigned off = (unsigned)i * 8u; asm volatile("" : "+s"(off)); const CAS char* kp = (const CAS char*)__builtin_amdgcn_kernarg_segment_ptr(); const __attribute__((address_space(1))) float* r_ = (const __attribute__((address_space(1))) float*)*(const float* const CAS*)(kp + off); asm volatile("" : "+s"(r_)); return (const float*)r_; }
struct LayerW {
    const float *mix_g, *w_in, *gate_b, *q_g, *w_uq, *kv_g, *w_ukv, *mla_wo, *sc_w, *sc_wo, *lam, *diff_g, *diff_wo, *cf_w, *cf_b, *cf_g, *cf_bb, *cf_wo, *w_o, *ffn_g, *w_q, *subk, *pu, *pv;
};
constexpr int CW_TABQ = 24576;
__device__ __forceinline__ void table_row(unsigned char* ws, int layer, int rr, int lane) {
    const int t = rr >= PEER_NE, row = rr - t * PEER_NE;
    const GAS f32x4* src = (const GAS f32x4*)(inp(t ? 25 : 24) + (size_t)layer * PEER_NE * 2048 + (size_t)row * 2048);
    f32x4 v[8]; float am = 0.f;
#pragma unroll
    for (int j = 0; j < 2; ++j)
#pragma unroll
        for (int d = 0; d < 4; ++d) { v[4 * j + d] = src[256 * j + 4 * lane + d]; const f32x4 x = v[4 * j + d]; am = fmaxf(am, fmaxf(fmaxf(fabsf(x.x), fabsf(x.y)), fmaxf(fabsf(x.z), fabsf(x.w)))); }
    am = fmaxf(wave_max(am), 1e-30f);
    const float inv = 400.f / am;
#pragma unroll
    for (int j = 0; j < 2; ++j) { v4u o;
#pragma unroll
        for (int d = 0; d < 4; ++d) { const f32x4 x = v[4 * j + d] * inv; int p = __builtin_amdgcn_cvt_pk_fp8_f32(x.x, x.y, 0, false); p = __builtin_amdgcn_cvt_pk_fp8_f32(x.z, x.w, p, true); o[d] = (unsigned)p; }
        *(GAS v4u*)(ws + (t ? WS_VBF : WS_UBF) + (size_t)row * 2048 + 1024 * j + 16 * lane) = o; }
    if (lane == 0) ((float*)(ws + (t ? WS_VSC : WS_USC)))[row] = am * (1.f / 400.f);
}
__device__ __forceinline__ void tables_dyn(Frame& F, int layer) {
    PHASE_IDS();
    gu32* qw = F.ctl + CW_TABQ + 64 * layer;
    for (;;) {
        unsigned c = 0u; if (lane == 0) c = __hip_atomic_fetch_add(qw, 1u, RLX_AGENT);
        c = (unsigned)__builtin_amdgcn_readfirstlane((int)c);
        if (c >= (unsigned)(2 * PEER_NE / 8)) break;
#pragma unroll 1
        for (int k = 0; k < 8; ++k) table_row(ws, layer, (int)c * 8 + k, lane);
    }
}
constexpr int WC_I_IN = 32 * (ZC / 32), WC_I_UQ = 8 * 24, WC_I_UKV = 4 * 32, WC_I_OUT = 8 * 64, WC_I_O = 32 * 64, WC_I_Q = 32 * 32;
constexpr int WC_NITEMS = WC_I_IN + WC_I_UQ + WC_I_UKV + 4 * WC_I_OUT + WC_I_O + WC_I_Q;
constexpr int CW_WCQ = 28672;
__device__ __forceinline__ void wcopy_item(unsigned char* ws, int layer, int it, LAS float* scr, int lane) {
    constexpr int I_IN = WC_I_IN, I_UQ = WC_I_UQ, I_UKV = WC_I_UKV, I_OUT = WC_I_OUT, I_O = WC_I_O;
    int r = it, ldw, ldt, nblk, mode = 0; const float* src; const float* gk = nullptr; bf16* dst;
    if (r < I_IN) { src = inp(3) + (size_t)layer * 2048 * INC; ldw = INC; dst = (bf16*)(ws + WS_WIN); ldt = 2048; nblk = ZC / 32; mode = 1; }
    else if ((r -= I_IN) < I_UQ) { src = inp(6) + (size_t)layer * 512 * 768; gk = inp(5) + (size_t)layer * 512; ldw = 768; dst = (bf16*)(ws + WS_WUQ); ldt = 512; nblk = 24; mode = 2; }
    else if ((r -= I_UQ) < I_UKV) { src = inp(8) + (size_t)layer * 256 * 1024; gk = inp(7) + (size_t)layer * 256; ldw = 1024; dst = (bf16*)(ws + WS_WUQ) + (size_t)768 * 512; ldt = 512; nblk = 32; }
    else if ((r -= I_UKV) < 4 * I_OUT) { const int br = r / I_OUT; r -= br * I_OUT; src = inp(br == 0 ? 9 : br == 1 ? 11 : br == 2 ? 14 : 19) + (size_t)layer * 512 * 2048; ldw = 2048; dst = (bf16*)(ws + WS_WOUT) + (size_t)br * 2048 * 512; ldt = 512; nblk = 64; }
    else if ((r -= 4 * I_OUT) < I_O) { src = inp(20) + (size_t)layer * 2048 * 2048; ldw = 2048; dst = (bf16*)(ws + WS_WO); ldt = 2048; nblk = 64; }
    else { r -= I_O; src = inp(22) + (size_t)layer * 2048 * 1024; ldw = 1024; dst = (bf16*)(ws + WS_WQ); ldt = 2048; nblk = 32; }
    tr_item(src, ldw, gk, dst, ldt, nblk, r, mode, scr, lane);
}
__device__ __forceinline__ void wcopy_dyn(Frame& F, int layer) {
    PHASE_IDS();
    LAS float* scr = (LAS float*)(F.lds + wave * 16384);
    for (int i = obid() * NTHREADS + tid; i < 1024 * 32; i += F.G * NTHREADS) { const int n = i >> 5, ch = i & 31; unsigned z_ = 0u; asm volatile("" : "+v"(z_)); *(GAS v4u*)((bf16*)(ws + WS_WUQ) + (size_t)(768 + n) * 512 + 256 + 8 * ch) = (v4u){z_, z_, z_, z_}; }
    gu32* qw = F.ctl + CW_WCQ + 64 * layer;
    for (;;) {
        unsigned c = 0u; if (lane == 0) c = __hip_atomic_fetch_add(qw, 1u, RLX_AGENT);
        c = (unsigned)__builtin_amdgcn_readfirstlane((int)c);
        if (c >= (unsigned)((WC_NITEMS + 3) / 4)) break;
#pragma unroll 1
        for (int k = 0; k < 4; ++k) { const int it = (int)c * 4 + k; if (it < WC_NITEMS) wcopy_item(ws, layer, it, scr, lane); }
    }
}
__device__ __forceinline__ void p0_prologue(Frame& F, int layer, int part) {
    PHASE_IDS();
    LAS float* scr = (LAS float*)(F.lds + wave * 16384);
    const int gw = obid() * NWAVES + wave, NGW = F.G * NWAVES;
    constexpr int I_IN = 32 * (ZC / 32), I_UQ = 8 * 24, I_UKV = 4 * 32, I_OUT = 8 * 64, I_O = 32 * 64, I_Q = 32 * 32;
    constexpr int NITEMS = I_IN + I_UQ + I_UKV + 4 * I_OUT + I_O + I_Q;
    if (part == 1) {
    if (layer == 0)
    for (int it = gw; it < NITEMS; it += NGW) wcopy_item(ws, layer, it, scr, lane);
    { const float* sk = inp(23) + (size_t)layer * 2 * 128 * 64;
      for (int i = obid() * NTHREADS + tid; i < 2 * 128 * 64 / 8; i += F.G * NTHREADS) { const f32x4 a_ = *(const GAS f32x4*)(sk + 8 * i), b_ = *(const GAS f32x4*)(sk + 8 * i + 4);
          *(GAS v4u*)((bf16*)(ws + WS_SUBK) + 8 * i) = (v4u){pk2(a_.x, a_.y), pk2(a_.z, a_.w), pk2(b_.x, b_.y), pk2(b_.z, b_.w)}; } }
    if (layer == 0)
    for (int i = obid() * NTHREADS + tid; i < 1024 * 32; i += F.G * NTHREADS) { const int n = i >> 5, ch = i & 31; unsigned z_ = 0u; asm volatile("" : "+v"(z_)); *(GAS v4u*)((bf16*)(ws + WS_WUQ) + (size_t)(768 + n) * 512 + 256 + 8 * ch) = (v4u){z_, z_, z_, z_}; }
    }
    if (layer == 0 && part == 1) {
        const int* positions = (const int*)inp(1);
        float* cosm = (float*)(ws + WS_COSM); float* sinm = (float*)(ws + WS_SINM); float* cosd = (float*)(ws + WS_COSD); float* sind = (float*)(ws + WS_SIND);
        for (int i = obid() * NTHREADS + tid; i < SEQ * 24; i += F.G * NTHREADS) {
            const int s = i / 24, j = i % 24; const float pos = (float)positions[s];
            const float ex = j < 16 ? (float)j * (1.f / 16.f) : (float)(j - 16) * (1.f / 8.f);
            const float inv = exp2f(-ex * 18.931568569324174f);
            const float ang = pos * inv;
            double rev = (double)ang * 0.15915494309189535; rev -= floor(rev);
            const float fr = (float)rev; const float cv = __builtin_amdgcn_cosf(fr), sv = __builtin_amdgcn_sinf(fr);
            if (j < 16) { cosm[s * 16 + j] = cv; sinm[s * 16 + j] = sv; } else { cosd[s * 8 + (j - 16)] = cv; sind[s * 8 + (j - 16)] = sv; }
        }
        { const float* x = inp(0); const float* mg = inp(2);
          for (int m = gw; m < SEQ; m += NGW) rms_row_to_i8(x + (size_t)m * DMODEL, mg, ws + WS_A8 + (size_t)m * DMODEL, (float*)(ws + WS_SA8) + m, lane); }
    }
}

namespace pg8 {
template <class Fn> __device__ __forceinline__ void walk8(const f32x4 (&acc)[2][2][4][2], int pm, int pn, int wr, int wc, int fr, int fq, Fn f) {
    const int row0 = pm * BM + wr * 64 + fr, col0 = pn * BM + wc * 32 + 8 * fq;
#pragma unroll
    for (int ai = 0; ai < 2; ++ai)
#pragma unroll
        for (int m = 0; m < 4; ++m)
#pragma unroll
            for (int bj = 0; bj < 2; ++bj) f(row0 + ai * HALF + m * 16, col0 + bj * HALF, acc[ai][bj][m][0], acc[ai][bj][m][1]);
}
__device__ __forceinline__ u32x4 pack8(f32x4 v0, f32x4 v1) { u32x4 w; w.x = cvt_pk_bf16(v0[0], v0[1]); w.y = cvt_pk_bf16(v0[2], v0[3]); w.z = cvt_pk_bf16(v1[0], v1[1]); w.w = cvt_pk_bf16(v1[2], v1[3]); return w; }
__device__ __forceinline__ void rope4(f32x4& v0, f32x4& v1, const float* cs, const float* sn) {
    const f32x4 c = *(const f32x4*)cs, s = *(const f32x4*)sn;
    const float a0 = v0[0], b0 = v0[1], a1 = v0[2], b1 = v0[3], a2 = v1[0], b2 = v1[1], a3 = v1[2], b3 = v1[3];
    v0[0] = a0 * c[0] - b0 * s[0]; v0[1] = b0 * c[0] + a0 * s[0]; v0[2] = a1 * c[1] - b1 * s[1]; v0[3] = b1 * c[1] + a1 * s[1];
    v1[0] = a2 * c[2] - b2 * s[2]; v1[1] = b2 * c[2] + a2 * s[2]; v1[2] = a3 * c[3] - b3 * s[3]; v1[3] = b3 * c[3] + a3 * s[3];
}
template <bool I8> struct EpiZT {
    static constexpr bool PERM = true, AFTER_DRAIN = false;
    bf16_t* Z; const float *cosm, *sinm, *cosd, *sind; const float *sa8, *sb8;
    __device__ __forceinline__ void operator()(const f32x4 (&acc)[2][2][4][2], const Unit& u, int wr, int wc, int fr, int fq) const {
        const int row0 = u.pm * BM + wr * 64 + fr, col0 = u.pn * BM + wc * 32 + 8 * fq;
        f32x4 qcb[2][2]; float qra[2][4];
        if constexpr (I8) {
#pragma unroll
            for (int bj = 0; bj < 2; ++bj) { qcb[bj][0] = *(const f32x4*)(sb8 + col0 + bj * HALF); qcb[bj][1] = *(const f32x4*)(sb8 + col0 + bj * HALF + 4); }
#pragma unroll
            for (int ai = 0; ai < 2; ++ai)
#pragma unroll
                for (int m = 0; m < 4; ++m) qra[ai][m] = sa8[row0 + ai * HALF + m * 16];
        }
        auto val = [&](int ai, int bj, int m, int j) -> f32x4 { if constexpr (I8) { typedef int v4i_ __attribute__((ext_vector_type(4))); const v4i_ q = __builtin_bit_cast(v4i_, acc[ai][bj][m][j]);
                return (f32x4){(float)q.x, (float)q.y, (float)q.z, (float)q.w} * qcb[bj][j] * qra[ai][m]; } else return acc[ai][bj][m][j]; };
        const bool tile_d = u.pn >= 9 && u.pn <= 12, tile_k = u.pn == 19;
        if (!(tile_d || tile_k)) {
#pragma unroll
            for (int ai = 0; ai < 2; ++ai)
#pragma unroll
                for (int m = 0; m < 4; ++m)
#pragma unroll
                    for (int bj = 0; bj < 2; ++bj) *(u32x4*)(Z + (size_t)(row0 + ai * HALF + m * 16) * ZC + col0 + bj * HALF) = pack8(val(ai, bj, m, 0), val(ai, bj, m, 1));
            return;
        }
        const int d = tile_d ? (col0 & 63) : (col0 - ZC_KR);
        const bool rot0 = tile_d ? d < 16 : d < 32, rot1 = tile_d ? d < 16 : false;
        const float* cb = tile_d ? cosd : cosm; const float* sb = tile_d ? sind : sinm; const int fstr = tile_d ? 8 : 16, foff = (rot0 ? d : 0) >> 1;
        const float qs = (tile_d && u.pn <= 10) ? C2_DIFF : 1.f;
#pragma unroll
        for (int ai = 0; ai < 2; ++ai) {
            f32x4 cs[4], sn[4];
#pragma unroll
            for (int m = 0; m < 4; ++m) { const int row = row0 + ai * HALF + m * 16; cs[m] = *(const f32x4*)(cb + row * fstr + foff); sn[m] = *(const f32x4*)(sb + row * fstr + foff); }
#pragma unroll
            for (int m = 0; m < 4; ++m)
#pragma unroll
                for (int bj = 0; bj < 2; ++bj) { const int row = row0 + ai * HALF + m * 16; f32x4 v0 = val(ai, bj, m, 0), v1 = val(ai, bj, m, 1);
                    if (bj == 0 ? rot0 : rot1) { const f32x4 c = cs[m], s_ = sn[m];
                        const float a0 = v0[0], b0 = v0[1], a1 = v0[2], b1 = v0[3], a2 = v1[0], b2 = v1[1], a3 = v1[2], b3 = v1[3];
                        v0[0] = a0 * c[0] - b0 * s_[0]; v0[1] = b0 * c[0] + a0 * s_[0]; v0[2] = a1 * c[1] - b1 * s_[1]; v0[3] = b1 * c[1] + a1 * s_[1];
                        v1[0] = a2 * c[2] - b2 * s_[2]; v1[1] = b2 * c[2] + a2 * s_[2]; v1[2] = a3 * c[3] - b3 * s_[3]; v1[3] = b3 * c[3] + a3 * s_[3]; }
                    v0 = v0 * qs; v1 = v1 * qs;
                    *(u32x4*)(Z + (size_t)row * ZC + col0 + bj * HALF) = pack8(v0, v1); }
        }
    }
};
typedef EpiZT<false> EpiZ;
typedef EpiZT<true> EpiZ8;
struct EpiGate8 {
    static constexpr bool PERM = true, AFTER_DRAIN = false;
    bf16_t* Z; const float *sa, *sb; const float *gate_b, *swout;
    __device__ __forceinline__ void operator()(const f32x4 (&acc)[2][2][4][2], const Unit& u, int wr, int wc, int fr, int fq) const {
        typedef int v4i_ __attribute__((ext_vector_type(4)));
        const int row0 = u.pm * BM + wr * 64 + fr, col0 = u.pn * BM + wc * 32 + 8 * fq;
        f32x4 cb[2][2];
#pragma unroll
        for (int bj = 0; bj < 2; ++bj) { cb[bj][0] = *(const f32x4*)(sb + col0 + bj * HALF); cb[bj][1] = *(const f32x4*)(sb + col0 + bj * HALF + 4); }
        f32x4 gb[2][2], gw[2][2];
#pragma unroll
        for (int bj = 0; bj < 2; ++bj) { gb[bj][0] = *(const f32x4*)(gate_b + col0 + bj * HALF); gb[bj][1] = *(const f32x4*)(gate_b + col0 + bj * HALF + 4);
            gw[bj][0] = *(const f32x4*)(swout + col0 + bj * HALF); gw[bj][1] = *(const f32x4*)(swout + col0 + bj * HALF + 4); }
        float ra[2][4];
#pragma unroll
        for (int ai = 0; ai < 2; ++ai)
#pragma unroll
            for (int m = 0; m < 4; ++m) ra[ai][m] = sa[row0 + ai * HALF + m * 16];
#pragma unroll
        for (int ai = 0; ai < 2; ++ai)
#pragma unroll
            for (int m = 0; m < 4; ++m)
#pragma unroll
                for (int bj = 0; bj < 2; ++bj) { const v4i_ i0 = __builtin_bit_cast(v4i_, acc[ai][bj][m][0]), i1 = __builtin_bit_cast(v4i_, acc[ai][bj][m][1]);
                    const f32x4 v0 = (f32x4){(float)i0.x, (float)i0.y, (float)i0.z, (float)i0.w}, v1 = (f32x4){(float)i1.x, (float)i1.y, (float)i1.z, (float)i1.w};
                    f32x4 l0 = v0 * cb[bj][0] * ra[ai][m] + gb[bj][0], l1 = v1 * cb[bj][1] * ra[ai][m] + gb[bj][1];
#pragma unroll
                    for (int e = 0; e < 4; ++e) { l0[e] = sigmoidf_(l0[e]) * gw[bj][0][e]; l1[e] = sigmoidf_(l1[e]) * gw[bj][1][e]; }
                    *(u32x4*)(Z + (size_t)(row0 + ai * HALF + m * 16) * ZC + ZC_GATE + col0 + bj * HALF) = pack8(l0, l1); }
    }
};
struct QKVOrder {
    StaticOrder S0;
    __device__ __forceinline__ bool next(int i, Unit& u) const { if (!S0.next(i, u)) return false; u.ka = u.pn >= 3 ? ZC_CKV : ZC_CQ; return true; }
    __device__ __forceinline__ void a_ready(const Unit&) const {}
    __device__ __forceinline__ void done(const Unit&) const {}
};
struct EpiQKV {
    static constexpr bool PERM = true, AFTER_DRAIN = false;
    bf16_t* QMo; bf16_t* KVo; const float* rstd; const float *cosm, *sinm;
    __device__ __forceinline__ void operator()(const f32x4 (&acc)[2][2][4][2], const Unit& u, int wr, int wc, int fr, int fq) const {
        const bool isq = u.pn < 3;
        const int row0 = u.pm * BM + wr * 64 + fr, col0 = u.pn * BM + wc * 32 + 8 * fq;
        float rs[2][4];
#pragma unroll
        for (int ai = 0; ai < 2; ++ai)
#pragma unroll
            for (int m = 0; m < 4; ++m) rs[ai][m] = rstd[(row0 + ai * HALF + m * 16) * 2 + (isq ? 0 : 1)];
#pragma unroll
        for (int ai = 0; ai < 2; ++ai)
#pragma unroll
            for (int m = 0; m < 4; ++m)
#pragma unroll
                for (int bj = 0; bj < 2; ++bj) { const int row = row0 + ai * HALF + m * 16, col = col0 + bj * HALF; f32x4 v0 = acc[ai][bj][m][0], v1 = acc[ai][bj][m][1];
                    if (isq) {
                        const float sc = rs[ai][m] * C2_MLA; v0 = v0 * sc; v1 = v1 * sc;
                        const int d = col % 96; if (d >= 64) rope4(v0, v1, cosm + row * 16 + ((d - 64) >> 1), sinm + row * 16 + ((d - 64) >> 1));
                        *(u32x4*)(QMo + (size_t)row * QMC + col) = pack8(v0, v1);
                    } else {
                        const float sc = rs[ai][m]; v0 = v0 * sc; v1 = v1 * sc;
                        *(u32x4*)(KVo + (size_t)row * KVC + (col - QMC)) = pack8(v0, v1);
                    } }
    }
};
struct QKVOrder8 {
    StaticOrder S0;
    __device__ __forceinline__ bool next(int i, Unit& u) const { if (!S0.next(i, u)) return false; u.ka = u.pn >= 3 ? 256 : 0; return true; }
    __device__ __forceinline__ void a_ready(const Unit&) const {}
    __device__ __forceinline__ void done(const Unit&) const {}
};
struct EpiQKV8 {
    static constexpr bool PERM = true, AFTER_DRAIN = false;
    bf16_t* QMo; bf16_t* KVo; const float* rstd; const float *cosm, *sinm; const float* sb;
    __device__ __forceinline__ void operator()(const f32x4 (&acc)[2][2][4][2], const Unit& u, int wr, int wc, int fr, int fq) const {
        const bool isq = u.pn < 3;
        const int row0 = u.pm * BM + wr * 64 + fr, col0 = u.pn * BM + wc * 32 + 8 * fq;
        typedef int v4i_ __attribute__((ext_vector_type(4)));
        f32x4 cb[2][2];
#pragma unroll
        for (int bj = 0; bj < 2; ++bj) { cb[bj][0] = *(const f32x4*)(sb + col0 + bj * HALF); cb[bj][1] = *(const f32x4*)(sb + col0 + bj * HALF + 4); }
        float rs[2][4];
#pragma unroll
        for (int ai = 0; ai < 2; ++ai)
#pragma unroll
            for (int m = 0; m < 4; ++m) rs[ai][m] = rstd[(row0 + ai * HALF + m * 16) * 2 + (isq ? 0 : 1)];
#pragma unroll
        for (int ai = 0; ai < 2; ++ai)
#pragma unroll
            for (int m = 0; m < 4; ++m)
#pragma unroll
                for (int bj = 0; bj < 2; ++bj) { const int row = row0 + ai * HALF + m * 16, col = col0 + bj * HALF; const v4i_ q0 = __builtin_bit_cast(v4i_, acc[ai][bj][m][0]), q1 = __builtin_bit_cast(v4i_, acc[ai][bj][m][1]);
                    f32x4 v0 = (f32x4){(float)q0.x, (float)q0.y, (float)q0.z, (float)q0.w} * cb[bj][0], v1 = (f32x4){(float)q1.x, (float)q1.y, (float)q1.z, (float)q1.w} * cb[bj][1];
                    if (isq) {
                        const float sc = rs[ai][m] * C2_MLA; v0 = v0 * sc; v1 = v1 * sc;
                        const int d = col % 96; if (d >= 64) rope4(v0, v1, cosm + row * 16 + ((d - 64) >> 1), sinm + row * 16 + ((d - 64) >> 1));
                        *(u32x4*)(QMo + (size_t)row * QMC + col) = pack8(v0, v1);
                    } else {
                        const float sc = rs[ai][m]; v0 = v0 * sc; v1 = v1 * sc;
                        *(u32x4*)(KVo + (size_t)row * KVC + (col - QMC)) = pack8(v0, v1);
                    } }
    }
};
struct MergedOrder {
    StaticOrder S0;
    __device__ __forceinline__ bool next(int i, Unit& u) const { Unit t; if (!S0.next(i >> 2, t)) return false; const int br = i & 3; u.pm = br * 32 + t.pm; u.pn = br * 8 + t.pn; u.ka = 0; return true; }
    __device__ __forceinline__ void a_ready(const Unit&) const {}
    __device__ __forceinline__ void done(const Unit&) const {}
};
struct EpiMerged {
    static constexpr bool PERM = true, AFTER_DRAIN = false;
    bf16_t* Mg; const bf16_t* Z; const float* gate_b;
    __device__ __forceinline__ void operator()(const f32x4 (&acc)[2][2][4][2], const Unit& u, int wr, int wc, int fr, int fq) const {
        const int br = u.pm >> 5, pm = u.pm & 31, pn = u.pn & 7;
        const int row0 = pm * BM + wr * 64 + fr, col0 = pn * BM + wc * 32 + 8 * fq;
        f32x4 bia[2][2];
#pragma unroll
        for (int bj = 0; bj < 2; ++bj) { bia[bj][0] = *(const f32x4*)(gate_b + br * 2048 + col0 + bj * HALF); bia[bj][1] = *(const f32x4*)(gate_b + br * 2048 + col0 + bj * HALF + 4); }
#pragma unroll
        for (int ai = 0; ai < 2; ++ai) {
            u32x4 gz[4][2], old[4][2];
#pragma unroll
            for (int m = 0; m < 4; ++m)
#pragma unroll
                for (int bj = 0; bj < 2; ++bj) { const int row = row0 + ai * HALF + m * 16, col = col0 + bj * HALF;
                    gz[m][bj] = *(const u32x4*)(Z + (size_t)row * ZC + ZC_GATE + br * 2048 + col);
                    old[m][bj] = br > 0 ? *(const u32x4*)(Mg + (size_t)row * 2048 + col) : (u32x4){0u, 0u, 0u, 0u}; }
#pragma unroll
            for (int m = 0; m < 4; ++m)
#pragma unroll
                for (int bj = 0; bj < 2; ++bj) { const int row = row0 + ai * HALF + m * 16, col = col0 + bj * HALF;
                    const u32x4 g4 = gz[m][bj], o4 = old[m][bj]; const f32x4 v0 = acc[ai][bj][m][0], v1 = acc[ai][bj][m][1], b0 = bia[bj][0], b1 = bia[bj][1];
                    float o[8];
                    o[0] = bf_lo(o4.x) + sigmoidf_(bf_lo(g4.x) + b0[0]) * v0[0]; o[1] = bf_hi(o4.x) + sigmoidf_(bf_hi(g4.x) + b0[1]) * v0[1];
                    o[2] = bf_lo(o4.y) + sigmoidf_(bf_lo(g4.y) + b0[2]) * v0[2]; o[3] = bf_hi(o4.y) + sigmoidf_(bf_hi(g4.y) + b0[3]) * v0[3];
                    o[4] = bf_lo(o4.z) + sigmoidf_(bf_lo(g4.z) + b1[0]) * v1[0]; o[5] = bf_hi(o4.z) + sigmoidf_(bf_hi(g4.z) + b1[1]) * v1[1];
                    o[6] = bf_lo(o4.w) + sigmoidf_(bf_lo(g4.w) + b1[2]) * v1[2]; o[7] = bf_hi(o4.w) + sigmoidf_(bf_hi(g4.w) + b1[3]) * v1[3];
                    u32x4 w; w.x = cvt_pk_bf16(o[0], o[1]); w.y = cvt_pk_bf16(o[2], o[3]); w.z = cvt_pk_bf16(o[4], o[5]); w.w = cvt_pk_bf16(o[6], o[7]);
                    *(u32x4*)(Mg + (size_t)row * 2048 + col) = w; }
        }
    }
};
struct EpiMerged8 {
    static constexpr bool PERM = true, AFTER_DRAIN = false;
    bf16_t* Mg; const bf16_t* Z; const float* sa;
    __device__ __forceinline__ void operator()(const f32x4 (&acc)[2][2][4][2], const Unit& u, int wr, int wc, int fr, int fq) const {
        typedef int v4i_ __attribute__((ext_vector_type(4)));
        const int br = u.pm >> 5, pm = u.pm & 31, pn = u.pn & 7;
        const int row0 = pm * BM + wr * 64 + fr, col0 = pn * BM + wc * 32 + 8 * fq;
#pragma unroll
        for (int ai = 0; ai < 2; ++ai) {
            u32x4 gz[4][2], old[4][2]; float rsc[4];
#pragma unroll
            for (int m = 0; m < 4; ++m) { rsc[m] = sa[br * SEQ + row0 + ai * HALF + m * 16];
#pragma unroll
                for (int bj = 0; bj < 2; ++bj) { const int row = row0 + ai * HALF + m * 16, col = col0 + bj * HALF;
                    gz[m][bj] = *(const u32x4*)(Z + (size_t)row * ZC + ZC_GATE + br * 2048 + col);
                    old[m][bj] = br > 0 ? *(const u32x4*)(Mg + (size_t)row * 2048 + col) : (u32x4){0u, 0u, 0u, 0u}; } }
#pragma unroll
            for (int m = 0; m < 4; ++m)
#pragma unroll
                for (int bj = 0; bj < 2; ++bj) { const int row = row0 + ai * HALF + m * 16, col = col0 + bj * HALF;
                    const u32x4 g4 = gz[m][bj], o4 = old[m][bj]; const v4i_ q0 = __builtin_bit_cast(v4i_, acc[ai][bj][m][0]), q1 = __builtin_bit_cast(v4i_, acc[ai][bj][m][1]); const float rs = rsc[m];
                    float o[8];
                    o[0] = bf_lo(o4.x) + bf_lo(g4.x) * ((float)q0.x * rs); o[1] = bf_hi(o4.x) + bf_hi(g4.x) * ((float)q0.y * rs);
                    o[2] = bf_lo(o4.y) + bf_lo(g4.y) * ((float)q0.z * rs); o[3] = bf_hi(o4.y) + bf_hi(g4.y) * ((float)q0.w * rs);
                    o[4] = bf_lo(o4.z) + bf_lo(g4.z) * ((float)q1.x * rs); o[5] = bf_hi(o4.z) + bf_hi(g4.z) * ((float)q1.y * rs);
                    o[6] = bf_lo(o4.w) + bf_lo(g4.w) * ((float)q1.z * rs); o[7] = bf_hi(o4.w) + bf_hi(g4.w) * ((float)q1.w * rs);
                    u32x4 w; w.x = cvt_pk_bf16(o[0], o[1]); w.y = cvt_pk_bf16(o[2], o[3]); w.z = cvt_pk_bf16(o[4], o[5]); w.w = cvt_pk_bf16(o[6], o[7]);
                    *(u32x4*)(Mg + (size_t)row * 2048 + col) = w; }
        }
    }
};
struct EpiResF32 {
    static constexpr bool PERM = false, AFTER_DRAIN = false;
    const float* base; float* C; int ldc;
    __device__ __forceinline__ void operator()(const f32x4 (&acc)[2][2][4][2], const Unit& u, int wr, int wc, int fr, int fq) const {
        const int row0 = u.pm * BM + wr * 64 + fr, col0 = u.pn * BM + wc * 32 + 4 * fq;
#pragma unroll
        for (int ai = 0; ai < 2; ++ai) {
            f32x4 pre[4][2][2];
            if (base) {
#pragma unroll
                for (int m = 0; m < 4; ++m) { const size_t ro = (size_t)(row0 + ai * HALF + m * 16) * ldc + col0;
#pragma unroll
                    for (int bj = 0; bj < 2; ++bj)
#pragma unroll
                        for (int n = 0; n < 2; ++n) pre[m][bj][n] = *(const f32x4*)(base + ro + bj * HALF + n * 16); }
            }
#pragma unroll
            for (int m = 0; m < 4; ++m) { const size_t ro = (size_t)(row0 + ai * HALF + m * 16) * ldc + col0;
#pragma unroll
                for (int bj = 0; bj < 2; ++bj)
#pragma unroll
                    for (int n = 0; n < 2; ++n) { f32x4 v = acc[ai][bj][m][n]; if (base) v = v + pre[m][bj][n]; *(f32x4*)(C + ro + bj * HALF + n * 16) = v; } }
        }
    }
};
struct EpiPQ8 {
    static constexpr bool PERM = false, AFTER_DRAIN = false;
    float* C; const float *hsci, *sb;
    __device__ __forceinline__ void operator()(const f32x4 (&acc)[2][2][4][2], const Unit& u, int wr, int wc, int fr, int fq) const {
        typedef int v4i_ __attribute__((ext_vector_type(4)));
        const int row0 = u.pm * BM + wr * 64 + fr, col0 = u.pn * BM + wc * 32 + 4 * fq;
        f32x4 cb[2][2]; float ra[2][4];
#pragma unroll
        for (int bj = 0; bj < 2; ++bj)
#pragma unroll
            for (int n = 0; n < 2; ++n) cb[bj][n] = *(const f32x4*)(sb + col0 + bj * HALF + n * 16);
#pragma unroll
        for (int ai = 0; ai < 2; ++ai)
#pragma unroll
            for (int m = 0; m < 4; ++m) ra[ai][m] = hsci[row0 + ai * HALF + m * 16] * (224.f / 127.f);
#pragma unroll
        for (int ai = 0; ai < 2; ++ai)
#pragma unroll
            for (int m = 0; m < 4; ++m) { const size_t ro = (size_t)(row0 + ai * HALF + m * 16) * 1024 + col0;
#pragma unroll
                for (int bj = 0; bj < 2; ++bj)
#pragma unroll
                    for (int n = 0; n < 2; ++n) { const v4i_ q = __builtin_bit_cast(v4i_, acc[ai][bj][m][n]);
                        const f32x4 o_ = (f32x4){(float)q.x, (float)q.y, (float)q.z, (float)q.w} * cb[bj][n] * ra[ai][m];
                        typedef unsigned v2u__ __attribute__((ext_vector_type(2)));
                        *(v2u__*)((bf16_t*)C + ro + bj * HALF + n * 16) = (v2u__){cvt_pk_bf16(o_.x, o_.y), cvt_pk_bf16(o_.z, o_.w)}; } }
    }
};
struct EpiRes8 {
    static constexpr bool PERM = false, AFTER_DRAIN = false;
    const float* base; float* C; const float *sa, *sb;
    __device__ __forceinline__ void operator()(const f32x4 (&acc)[2][2][4][2], const Unit& u, int wr, int wc, int fr, int fq) const {
        typedef int v4i_ __attribute__((ext_vector_type(4)));
        const int row0 = u.pm * BM + wr * 64 + fr, col0 = u.pn * BM + wc * 32 + 4 * fq;
        f32x4 cb[2][2];
#pragma unroll
        for (int bj = 0; bj < 2; ++bj)
#pragma unroll
            for (int n = 0; n < 2; ++n) cb[bj][n] = *(const f32x4*)(sb + col0 + bj * HALF + n * 16);
#pragma unroll
        for (int ai = 0; ai < 2; ++ai) {
            f32x4 pre[4][2][2]; float ra[4];
#pragma unroll
            for (int m = 0; m < 4; ++m) { const size_t ro = (size_t)(row0 + ai * HALF + m * 16) * 2048 + col0; ra[m] = sa[row0 + ai * HALF + m * 16];
#pragma unroll
                for (int bj = 0; bj < 2; ++bj)
#pragma unroll
                    for (int n = 0; n < 2; ++n) pre[m][bj][n] = *(const f32x4*)(base + ro + bj * HALF + n * 16); }
#pragma unroll
            for (int m = 0; m < 4; ++m) { const size_t ro = (size_t)(row0 + ai * HALF + m * 16) * 2048 + col0;
#pragma unroll
                for (int bj = 0; bj < 2; ++bj)
#pragma unroll
                    for (int n = 0; n < 2; ++n) { const v4i_ q = __builtin_bit_cast(v4i_, acc[ai][bj][m][n]);
                        *(f32x4*)(C + ro + bj * HALF + n * 16) = (f32x4){(float)q.x, (float)q.y, (float)q.z, (float)q.w} * cb[bj][n] * ra[m] + pre[m][bj][n]; } }
        }
    }
};
}

__device__ __forceinline__ void p2_branch_prep(Frame& F, int layer) {
    LayerW W; W.sc_w = inp(10) + (size_t)layer * 3 * 512; W.cf_w = inp(15) + (size_t)layer * 31 * 512; W.cf_b = inp(16) + (size_t)layer * 512; W.cf_g = inp(17) + (size_t)layer * 512; W.cf_bb = inp(18) + (size_t)layer * 512;
    PHASE_IDS();
    const bf16* Z = (const bf16*)(ws + WS_Z);
    float* rstd = (float*)(ws + WS_RSTD);
    bf16* act_sc = (bf16*)(ws + WS_ACT) + (size_t)1 * SEQ * 512;
    bf16* act_cf = (bf16*)(ws + WS_ACT) + (size_t)3 * SEQ * 512;
    LAS float* ul = (LAS float*)F.lds;
    LAS float* part = (LAS float*)(F.lds + LDS_PART_OFF);
    asm volatile("" : "+v"(part));
    const int c = tid;
    for (int tile = obid(); tile < SEQ / 32; tile += F.G) {
        const int t0 = tile * 32;
#pragma unroll
        for (int i = 0; i < 4; ++i) { const int tok = t0 + 4 * wave + i;
            const v4u a = *(const GAS v4u*)(Z + (size_t)tok * ZC + ZC_CQ + 8 * lane);
            float s = bf_lo(a.x) * bf_lo(a.x) + bf_hi(a.x) * bf_hi(a.x) + bf_lo(a.y) * bf_lo(a.y) + bf_hi(a.y) * bf_hi(a.y) + bf_lo(a.z) * bf_lo(a.z) + bf_hi(a.z) * bf_hi(a.z) + bf_lo(a.w) * bf_lo(a.w) + bf_hi(a.w) * bf_hi(a.w);
            s = wave_sum(s);
            const unsigned long long b = *(const GAS unsigned long long*)(Z + (size_t)tok * ZC + ZC_CKV + 4 * lane);
            const unsigned b0 = (unsigned)b, b1 = (unsigned)(b >> 32);
            float s2 = bf_lo(b0) * bf_lo(b0) + bf_hi(b0) * bf_hi(b0) + bf_lo(b1) * bf_lo(b1) + bf_hi(b1) * bf_hi(b1);
            s2 = wave_sum(s2);
            float aq = fmaxf(fmaxf(fmaxf(fabsf(bf_lo(a.x)), fabsf(bf_hi(a.x))), fmaxf(fabsf(bf_lo(a.y)), fabsf(bf_hi(a.y)))), fmaxf(fmaxf(fabsf(bf_lo(a.z)), fabsf(bf_hi(a.z))), fmaxf(fabsf(bf_lo(a.w)), fabsf(bf_hi(a.w)))));
            float ak = fmaxf(fmaxf(fabsf(bf_lo(b0)), fabsf(bf_hi(b0))), fmaxf(fabsf(bf_lo(b1)), fabsf(bf_hi(b1))));
            aq = wave_max(aq); ak = wave_max(ak);
            const float iq = aq > 0.f ? 127.f / aq : 1.f, ik = ak > 0.f ? 127.f / ak : 1.f;
            { typedef unsigned v2u_ __attribute__((ext_vector_type(2))); unsigned char* qa = ws + WS_QA8 + (size_t)tok * 1024;
              *(GAS v2u_*)(qa + 8 * lane) = (v2u_){q4_i8(bf_lo(a.x) * iq, bf_hi(a.x) * iq, bf_lo(a.y) * iq, bf_hi(a.y) * iq), q4_i8(bf_lo(a.z) * iq, bf_hi(a.z) * iq, bf_lo(a.w) * iq, bf_hi(a.w) * iq)};
              *(GAS unsigned*)(qa + 512 + 4 * lane) = q4_i8(bf_lo(b0) * ik, bf_hi(b0) * ik, bf_lo(b1) * ik, bf_hi(b1) * ik); }
            if (lane == 0) { rstd[tok * 2] = (1.f / sqrtf(s * (1.f / 512.f) + NORM_EPS)) * (aq > 0.f ? aq * (1.f / 127.f) : 1.f); rstd[tok * 2 + 1] = (1.f / sqrtf(s2 * (1.f / 256.f) + NORM_EPS)) * (ak > 0.f ? ak * (1.f / 127.f) : 1.f); } }
        { const float w0 = W.sc_w[c], w1 = W.sc_w[512 + c], w2 = W.sc_w[1024 + c];
          bf16 vb[32], vc[34], vx[34];
#pragma unroll
          for (int t = 0; t < 34; ++t) { const int rw = t0 + t - 2; const bool ok = rw >= 0; const GAS bf16* q = (const GAS bf16*)(Z + (size_t)(ok ? rw : 0) * ZC);
            const bf16 cg_ = q[ZC_CG + c], xv_ = q[ZC_XV + c]; vc[t] = ok ? cg_ : (bf16)0; vx[t] = ok ? xv_ : (bf16)0; if (t >= 2) vb[t - 2] = q[ZC_BG + c]; }
          GAS bf16* op = (GAS bf16*)(act_sc + (size_t)t0 * 512 + c);
#pragma unroll
          for (int t = 0; t < 32; ++t) { const float y = w0 * (bf2f(vc[t]) * bf2f(vx[t])) + w1 * (bf2f(vc[t + 1]) * bf2f(vx[t + 1])) + w2 * (bf2f(vc[t + 2]) * bf2f(vx[t + 2]));
            *op = (bf16)f2bf(bf2f(vb[t]) * y); op += 512; asm volatile("" : "+v"(op)); } }
        float y[32];
        { float u[62];
          { bf16 va[62], vg[62];
#pragma unroll
            for (int r = 0; r < 62; ++r) { const int rw = t0 + r - 30; const bool ok = rw >= 0; const GAS bf16* q = (const GAS bf16*)(Z + (size_t)(ok ? rw : 0) * ZC);
              const bf16 a_ = q[ZC_CA + c], g_ = q[ZC_CGT + c]; va[r] = ok ? a_ : (bf16)0; vg[r] = ok ? g_ : (bf16)0; }
#pragma unroll
            for (int r = 0; r < 62; ++r) u[r] = bf2f(va[r]) * sigmoidf_(bf2f(vg[r])); }
          const float bias = W.cf_b[c];
#pragma unroll
          for (int t = 0; t < 32; ++t) y[t] = bias;
#pragma unroll
          for (int j = 0; j < 31; ++j) { const float wj = W.cf_w[j * 512 + c];
#pragma unroll
            for (int t = 0; t < 32; ++t) y[t] += wj * u[t + j]; } }
#pragma unroll
        for (int t = 0; t < 32; ++t) ul[t * 512 + c] = y[t];
        __syncthreads();
        { const int tt = tid >> 4, seg = tid & 15; float s_ = 0.f, q_ = 0.f;
#pragma unroll
          for (int k = 0; k < 8; ++k) { const f32x4 v4 = *(const LAS f32x4*)(ul + tt * 512 + 64 * k + 4 * seg); s_ += (v4.x + v4.y) + (v4.z + v4.w); q_ += (v4.x * v4.x + v4.y * v4.y) + (v4.z * v4.z + v4.w * v4.w); }
          s_ = row16_sum(s_); q_ = row16_sum(q_);
          const float mean = s_ * (1.f / 512.f); const float var = fmaxf(q_ * (1.f / 512.f) - mean * mean, 0.f);
          if (seg == 0) { part[2 * tt] = mean; part[2 * tt + 1] = __builtin_amdgcn_rsqf(var + LN_EPS); } }
        __syncthreads();
        { const float g = W.cf_g[c], bb = W.cf_bb[c]; GAS bf16* ocf = (GAS bf16*)(act_cf + (size_t)t0 * 512 + c);
#pragma unroll
          for (int t = 0; t < 32; ++t) { const float mean = part[2 * t], rs = part[2 * t + 1];
            const float v = (y[t] - mean) * rs * g + bb;
            *ocf = (bf16)f2bf(v * sigmoidf_(v)); ocf += 512; asm volatile("" : "+v"(ocf)); } }
        __syncthreads();
    }
}

typedef float f32x16 __attribute__((ext_vector_type(16)));
typedef short s16x4 __attribute__((ext_vector_type(4)));
typedef unsigned u32x2 __attribute__((ext_vector_type(2)));
__device__ __forceinline__ s16x4 vtr(const LAS unsigned char* p) { return __builtin_bit_cast(s16x4, __builtin_amdgcn_ds_read_tr16_b64_v4i16((LAS s16x4*)p)); }
__device__ __forceinline__ float amax3(float a, float b, float c) { float r; asm("v_max3_f32 %0, %1, %2, %3" : "=v"(r) : "v"(a), "v"(b), "v"(c)); return r; }
__device__ __forceinline__ float xhalf_max(float m) { auto rr = __builtin_amdgcn_permlane32_swap(__builtin_bit_cast(unsigned, m), __builtin_bit_cast(unsigned, m), false, false); return fmaxf(__builtin_bit_cast(float, rr[0]), __builtin_bit_cast(float, rr[1])); }
__device__ __forceinline__ float xhalf_sum(float m) { auto rr = __builtin_amdgcn_permlane32_swap(__builtin_bit_cast(unsigned, m), __builtin_bit_cast(unsigned, m), false, false); return __builtin_bit_cast(float, rr[0]) + __builtin_bit_cast(float, rr[1]); }

constexpr int ATT_KBUF = 64 * 208, ATT_VBUF = 64 * 320, ATT_STAGE = ATT_KBUF + ATT_VBUF;
template <int TYPE> __device__ __forceinline__ void attn_unit(Frame& F, int head, int qb) {
    constexpr int KS = TYPE == 0 ? 6 : 4, DT = TYPE == 0 ? 2 : 4, KP = TYPE == 0 ? 208 : 144, VP = TYPE == 0 ? 192 : 320;
    PHASE_IDS();
    const int r32 = lane & 31, hh = lane >> 5;
    const bf16* Z = (const bf16*)(ws + WS_Z); const bf16* QM = (const bf16*)(ws + WS_QM); const bf16* KVM = (const bf16*)(ws + WS_KVM);
    LAS unsigned char* lds = F.lds;
    const int row = qb * 256 + wave * 32 + r32;
    bf16x8 qf[KS];
    { const bf16* qp = TYPE == 0 ? QM + (size_t)row * QMC + head * 96 + 8 * hh : Z + (size_t)row * ZC + ZC_DQ + (head >> 1) * 128 + (head & 1) * 64 + 8 * hh;
#pragma unroll
      for (int ks = 0; ks < KS; ++ks) qf[ks] = *(const GAS bf16x8*)(qp + 16 * ks); }
    f32x16 o[DT];
#pragma unroll
    for (int d = 0; d < DT; ++d) o[d] = (f32x16){0.f, 0.f, 0.f, 0.f, 0.f, 0.f, 0.f, 0.f, 0.f, 0.f, 0.f, 0.f, 0.f, 0.f, 0.f, 0.f};
    float mrun = 0.f, lrun = 0.f;
    f32x16 negm = (f32x16){0.f, 0.f, 0.f, 0.f, 0.f, 0.f, 0.f, 0.f, 0.f, 0.f, 0.f, 0.f, 0.f, 0.f, 0.f, 0.f};
    const int NT = qb * 4 + 4, tmax = qb * 4 + (wave >> 1);
    v4u sa0 = (v4u){0u, 0u, 0u, 0u}, sa1 = sa0, sa2 = sa0, sb0 = sa0, sb1 = sa0, sb2 = sa0;
    const bf16 *g0, *g1, *g2; int l0, l1, l2; bool has1;
    if (TYPE == 0) {
        { const int key = tid / 12, ch = tid % 12; g0 = ch < 8 ? KVM + (size_t)key * KVC + head * 128 + 8 * ch : Z + (size_t)key * ZC + ZC_KR + 8 * (ch - 8); l0 = key * KP + ch * 16; }
        { const int cid = tid + 512, key = cid / 12, ch = cid % 12; has1 = tid < 256; const int keyc = has1 ? key : 0; g1 = ch < 8 ? KVM + (size_t)keyc * KVC + head * 128 + 8 * ch : Z + (size_t)keyc * ZC + ZC_KR + 8 * (ch - 8); l1 = keyc * KP + ch * 16; }
        { const int key = tid >> 3, ch = tid & 7; g2 = KVM + (size_t)key * KVC + head * 128 + 64 + 8 * ch; l2 = ATT_KBUF + key * VP + ch * 16; }
    } else {
        { const int key = tid >> 3, ch = tid & 7; g0 = Z + (size_t)key * ZC + ZC_DK + (head >> 1) * 128 + (head & 1) * 64 + 8 * ch; l0 = key * KP + ch * 16; }
        { const int key = tid >> 4, ch = tid & 15; g1 = Z + (size_t)key * ZC + ZC_DV + (head >> 1) * 128 + 8 * ch; l1 = ATT_KBUF + key * VP + ch * 16; has1 = true; }
        { const int cid = tid + 512, key = cid >> 4, ch = cid & 15; g2 = Z + (size_t)key * ZC + ZC_DV + (head >> 1) * 128 + 8 * ch; l2 = ATT_KBUF + key * VP + ch * 16; }
    }
    const size_t gstep0 = (size_t)64 * ((TYPE == 0 && (tid % 12) < 8) ? KVC : ZC);
    const size_t gstep1 = (size_t)64 * ((TYPE == 0 && ((tid + 512) % 12) < 8) ? KVC : ZC);
    const size_t gstep2 = (size_t)64 * (TYPE == 0 ? KVC : ZC);
#define ATT_LOAD(S, t) do { S##0 = *(const GAS v4u*)(g0 + (size_t)(t) * gstep0); if (has1) S##1 = *(const GAS v4u*)(g1 + (size_t)(t) * gstep1); S##2 = *(const GAS v4u*)(g2 + (size_t)(t) * gstep2); } while (0)
#define ATT_WRITE(S, buf) do { LAS unsigned char* b_ = lds + (buf) * ATT_STAGE; *(LAS v4u*)(b_ + l0) = S##0; if (has1) *(LAS v4u*)(b_ + l1) = S##1; *(LAS v4u*)(b_ + l2) = S##2; } while (0)
    const int koff = r32 * KP + hh * 16;
    const int voff = ATT_KBUF + (4 * hh + ((lane & 15) >> 2)) * VP + (16 * ((lane >> 4) & 1) + 4 * (lane & 3)) * 2;
    ATT_LOAD(sa, 0); ATT_WRITE(sa, 0); ATT_LOAD(sb, 1); __syncthreads();
    if (wave >= 4) __builtin_amdgcn_s_setprio(1);
    for (int t0 = 0; t0 < NT; t0 += 2) {
      { const int t = t0 + 0;
        if (t + 2 < NT) ATT_LOAD(sa, t + 2);
        if (t <= tmax) {
            const LAS unsigned char* kb_ = lds + (t & 1) * ATT_STAGE;
            f32x16 p0, p1; bf16x8 ka_[KS], kc_[KS];
#pragma unroll
            for (int ks = 0; ks < KS; ++ks) { ka_[ks] = *(const LAS bf16x8*)(kb_ + koff + ks * 32); kc_[ks] = *(const LAS bf16x8*)(kb_ + koff + 32 * KP + ks * 32); }
            __builtin_amdgcn_sched_barrier(0);
#pragma unroll
            for (int ks = 0; ks < KS; ++ks) {
                if (ks == 0) { p0 = __builtin_amdgcn_mfma_f32_32x32x16_bf16(ka_[0], qf[0], negm, 0, 0, 0); p1 = __builtin_amdgcn_mfma_f32_32x32x16_bf16(kc_[0], qf[0], negm, 0, 0, 0); }
                else { p0 = __builtin_amdgcn_mfma_f32_32x32x16_bf16(ka_[ks], qf[ks], p0, 0, 0, 0); p1 = __builtin_amdgcn_mfma_f32_32x32x16_bf16(kc_[ks], qf[ks], p1, 0, 0, 0); }
            }
            s16x4 vlo_[2][DT], vhi_[2][DT];
#pragma unroll
            for (int d = 0; d < DT; ++d) { vlo_[0][d] = vtr(kb_ + voff + d * 64); vhi_[0][d] = vtr(kb_ + voff + 8 * VP + d * 64); }
            __builtin_amdgcn_sched_barrier(0);
            asm volatile("s_nop 15\n\ts_nop 7" : "+v"(p0), "+v"(p1));
            float mt;
            { float ma = amax3(p0[0], p0[1], p1[0]), mb = amax3(p0[2], p0[3], p1[1]); ma = amax3(ma, p1[2], p1[3]);
#pragma unroll
              for (int r = 4; r < 16; r += 4) { ma = amax3(ma, p0[r], p0[r + 1]); mb = amax3(mb, p0[r + 2], p0[r + 3]); ma = amax3(ma, p1[r], p1[r + 1]); mb = amax3(mb, p1[r + 2], p1[r + 3]); }
              mt = xhalf_max(amax3(ma, mb, mb)); }
            if (__any(t == 0 || mt > 4.0f)) {
                const float dl = t == 0 ? mt : fmaxf(mt, 0.f); mrun += dl;
                const float alpha = __builtin_amdgcn_exp2f(-dl); lrun *= alpha;
#pragma unroll
                for (int d = 0; d < DT; ++d) o[d] = o[d] * alpha;
#pragma unroll
                for (int r = 0; r < 16; ++r) { p0[r] -= dl; p1[r] -= dl; negm[r] = -mrun; }
            }
            float ls = 0.f;
#pragma unroll
            for (int s2 = 0; s2 < 4; ++s2) {
                if (s2 < 3) {
#pragma unroll
                    for (int d = 0; d < DT; ++d) { vlo_[(s2 + 1) & 1][d] = vtr(kb_ + voff + (16 * (s2 + 1)) * VP + d * 64); vhi_[(s2 + 1) & 1][d] = vtr(kb_ + voff + (16 * (s2 + 1) + 8) * VP + d * 64); } }
                f32x16& pp = s2 < 2 ? p0 : p1; const int b8 = 8 * (s2 & 1);
                float e_[8];
#pragma unroll
                for (int r = 0; r < 8; ++r) { e_[r] = __builtin_amdgcn_exp2f(pp[b8 + r]); ls += e_[r]; }
                v4u w_; w_.x = pg8::cvt_pk_bf16(e_[0], e_[1]); w_.y = pg8::cvt_pk_bf16(e_[2], e_[3]); w_.z = pg8::cvt_pk_bf16(e_[4], e_[5]); w_.w = pg8::cvt_pk_bf16(e_[6], e_[7]);
                const bf16x8 pf_ = __builtin_bit_cast(bf16x8, w_);
#pragma unroll
                for (int d = 0; d < DT; ++d) { const bf16x8 vf = (bf16x8){vlo_[s2 & 1][d][0], vlo_[s2 & 1][d][1], vlo_[s2 & 1][d][2], vlo_[s2 & 1][d][3], vhi_[s2 & 1][d][0], vhi_[s2 & 1][d][1], vhi_[s2 & 1][d][2], vhi_[s2 & 1][d][3]};
                    o[d] = __builtin_amdgcn_mfma_f32_32x32x16_bf16(vf, pf_, o[d], 0, 0, 0); }
                __builtin_amdgcn_sched_barrier(0);
            }
            lrun += ls;
        }
        if (t + 1 < NT) ATT_WRITE(sb, (t + 1) & 1);
        __syncthreads();
      }
      { const int t = t0 + 1;
        if (t + 2 < NT) ATT_LOAD(sb, t + 2);
        if (t <= tmax) {
            const LAS unsigned char* kb_ = lds + (t & 1) * ATT_STAGE;
            f32x16 p0, p1; bf16x8 ka_[KS], kc_[KS];
#pragma unroll
            for (int ks = 0; ks < KS; ++ks) { ka_[ks] = *(const LAS bf16x8*)(kb_ + koff + ks * 32); kc_[ks] = *(const LAS bf16x8*)(kb_ + koff + 32 * KP + ks * 32); }
            __builtin_amdgcn_sched_barrier(0);
#pragma unroll
            for (int ks = 0; ks < KS; ++ks) {
                if (ks == 0) { p0 = __builtin_amdgcn_mfma_f32_32x32x16_bf16(ka_[0], qf[0], negm, 0, 0, 0); p1 = __builtin_amdgcn_mfma_f32_32x32x16_bf16(kc_[0], qf[0], negm, 0, 0, 0); }
                else { p0 = __builtin_amdgcn_mfma_f32_32x32x16_bf16(ka_[ks], qf[ks], p0, 0, 0, 0); p1 = __builtin_amdgcn_mfma_f32_32x32x16_bf16(kc_[ks], qf[ks], p1, 0, 0, 0); }
            }
            s16x4 vlo_[2][DT], vhi_[2][DT];
#pragma unroll
            for (int d = 0; d < DT; ++d) { vlo_[0][d] = vtr(kb_ + voff + d * 64); vhi_[0][d] = vtr(kb_ + voff + 8 * VP + d * 64); }
            __builtin_amdgcn_sched_barrier(0);
            asm volatile("s_nop 15\n\ts_nop 7" : "+v"(p0), "+v"(p1));
            float mt;
            { float ma = amax3(p0[0], p0[1], p1[0]), mb = amax3(p0[2], p0[3], p1[1]); ma = amax3(ma, p1[2], p1[3]);
#pragma unroll
              for (int r = 4; r < 16; r += 4) { ma = amax3(ma, p0[r], p0[r + 1]); mb = amax3(mb, p0[r + 2], p0[r + 3]); ma = amax3(ma, p1[r], p1[r + 1]); mb = amax3(mb, p1[r + 2], p1[r + 3]); }
              mt = xhalf_max(amax3(ma, mb, mb)); }
            if (__any(t == 0 || mt > 4.0f)) {
                const float dl = t == 0 ? mt : fmaxf(mt, 0.f); mrun += dl;
                const float alpha = __builtin_amdgcn_exp2f(-dl); lrun *= alpha;
#pragma unroll
                for (int d = 0; d < DT; ++d) o[d] = o[d] * alpha;
#pragma unroll
                for (int r = 0; r < 16; ++r) { p0[r] -= dl; p1[r] -= dl; negm[r] = -mrun; }
            }
            float ls = 0.f;
#pragma unroll
            for (int s2 = 0; s2 < 4; ++s2) {
                if (s2 < 3) {
#pragma unroll
                    for (int d = 0; d < DT; ++d) { vlo_[(s2 + 1) & 1][d] = vtr(kb_ + voff + (16 * (s2 + 1)) * VP + d * 64); vhi_[(s2 + 1) & 1][d] = vtr(kb_ + voff + (16 * (s2 + 1) + 8) * VP + d * 64); } }
                f32x16& pp = s2 < 2 ? p0 : p1; const int b8 = 8 * (s2 & 1);
                float e_[8];
#pragma unroll
                for (int r = 0; r < 8; ++r) { e_[r] = __builtin_amdgcn_exp2f(pp[b8 + r]); ls += e_[r]; }
                v4u w_; w_.x = pg8::cvt_pk_bf16(e_[0], e_[1]); w_.y = pg8::cvt_pk_bf16(e_[2], e_[3]); w_.z = pg8::cvt_pk_bf16(e_[4], e_[5]); w_.w = pg8::cvt_pk_bf16(e_[6], e_[7]);
                const bf16x8 pf_ = __builtin_bit_cast(bf16x8, w_);
#pragma unroll
                for (int d = 0; d < DT; ++d) { const bf16x8 vf = (bf16x8){vlo_[s2 & 1][d][0], vlo_[s2 & 1][d][1], vlo_[s2 & 1][d][2], vlo_[s2 & 1][d][3], vhi_[s2 & 1][d][0], vhi_[s2 & 1][d][1], vhi_[s2 & 1][d][2], vhi_[s2 & 1][d][3]};
                    o[d] = __builtin_amdgcn_mfma_f32_32x32x16_bf16(vf, pf_, o[d], 0, 0, 0); }
                __builtin_amdgcn_sched_barrier(0);
            }
            lrun += ls;
        }
        if (t + 1 < NT) ATT_WRITE(sa, (t + 1) & 1);
        __syncthreads();
      }
    }
#undef ATT_LOAD
#undef ATT_WRITE
    __builtin_amdgcn_s_setprio(0);
    const float inv = 1.f / xhalf_sum(lrun);
    bf16* outp = TYPE == 0 ? (bf16*)(ws + WS_ACT) + (size_t)row * 512 + head * 64 : (bf16*)(ws + WS_DO) + (size_t)(head & 1) * SEQ * 512 + (size_t)row * 512 + (head >> 1) * 128;
#pragma unroll
    for (int d = 0; d < DT; ++d)
#pragma unroll
        for (int g = 0; g < 4; ++g) { u32x2 w; w.x = pg8::cvt_pk_bf16(o[d][4 * g] * inv, o[d][4 * g + 1] * inv); w.y = pg8::cvt_pk_bf16(o[d][4 * g + 2] * inv, o[d][4 * g + 3] * inv);
            *(GAS u32x2*)(outp + 32 * d + 8 * g + 4 * hh) = w; }
}
constexpr int ATT_NCONV = 64;
__device__ __forceinline__ void p4_attention(Frame& F, int layer) {
    const int tid = otid(F.wv);
    gu32* head_w = F.ctl + CW_QATT + 64 * layer;
    const bool conv_first = obid() < ATT_NCONV;
    const bool wnext = (layer >> 1) + 1 < NLAYER && (layer & 1) == 0;
    if (conv_first) { tables_dyn(F, layer >> 1); if (wnext) wcopy_dyn(F, (layer >> 1) + 1); }
    for (;;) {
        __syncthreads();
        if (tid == 0) F.MISC[0] = __hip_atomic_fetch_add(head_w, 1u, RLX_AGENT);
        __syncthreads();
        const unsigned u = F.MISC[0];
        if (u >= 512u) break;
        const int qb = 31 - (int)(u >> 4), r = (int)(u & 15);
        if (r < 8) attn_unit<1>(F, r, qb); else attn_unit<0>(F, r - 8, qb);
    }
    if (!conv_first) { tables_dyn(F, layer >> 1); if (wnext) wcopy_dyn(F, (layer >> 1) + 1); }
}


#ifndef MK_CHECK
#define MK_CHECK 0
#endif
constexpr int CW_CHK = 20480;
#if MK_CHECK
__device__ __forceinline__ void mla_check(Frame& F, int layer) {
    PHASE_IDS();
    const int b = obid();
    const bf16* Z = (const bf16*)(ws + WS_Z);
    const int* positions = (const int*)inp(1);
    LAS float* L = (LAS float*)F.lds;
    if (b < 16) {
        const int i = (b * 523 + 100 + layer * 37) % SEQ, h = b % 8, lim = (i / 64 + 1) * 64;
        const float* w_uq = inp(6) + (size_t)layer * 512 * 768; const float* g_q = inp(5) + (size_t)layer * 512;
        const float* w_ukv = inp(8) + (size_t)layer * 256 * 1024; const float* g_kv = inp(7) + (size_t)layer * 256;
        LAS float* qn = L; LAS float* q = L + 512; LAS float* qk = L + 640; LAS float* red = L + 1024; LAS float* pk = L + 2048; LAS float* sc = L + 4096; LAS float* rs = L + 4096 + 8192;
        { float v = bf2f(Z[(size_t)i * ZC + ZC_CQ + tid]); red[tid] = v * v; __syncthreads();
          for (int o = 256; o > 0; o >>= 1) { if (tid < o) red[tid] += red[tid + o]; __syncthreads(); }
          const float rstd = 1.f / sqrtf(red[0] / 512.f + NORM_EPS); __syncthreads();
          qn[tid] = v * rstd * g_q[tid]; __syncthreads(); }
        if (tid < 96) { float a = 0.f; for (int k = 0; k < 512; ++k) a += qn[k] * w_uq[(size_t)k * 768 + h * 96 + tid]; q[tid] = a; }
        __syncthreads();
        if (tid < 16) { const float pos = (float)positions[i]; const float inv = exp2f(-(float)tid * (1.f / 16.f) * 18.931568569324174f); const float ang = pos * inv; double rev = (double)ang * 0.15915494309189535; rev -= floor(rev); const float c = __builtin_amdgcn_cosf((float)rev), sn = __builtin_amdgcn_sinf((float)rev);
            const float x1 = q[64 + tid], x2 = q[80 + tid]; q[64 + tid] = x1 * c - x2 * sn; q[80 + tid] = x2 * c + x1 * sn; }
        __syncthreads();
        if (tid < 256) { float a = 0.f; for (int d = 0; d < 64; ++d) a += q[d] * w_ukv[(size_t)tid * 1024 + h * 128 + d]; qk[tid] = a; }
        __syncthreads();
        float mx = -3e38f;
        for (int j = tid; j < lim; j += NTHREADS) {
            float ss = 0.f, dn = 0.f;
            for (int k = 0; k < 256; ++k) { const float v = bf2f(Z[(size_t)j * ZC + ZC_CKV + k]); ss += v * v; dn += v * g_kv[k] * qk[k]; }
            const float rstd = 1.f / sqrtf(ss / 256.f + NORM_EPS);
            float dr = 0.f;
            for (int p = 0; p < 16; ++p) dr += q[64 + p] * bf2f(Z[(size_t)j * ZC + ZC_KR + 2 * p]) + q[80 + p] * bf2f(Z[(size_t)j * ZC + ZC_KR + 2 * p + 1]);
            const float s_ = (dn * rstd + dr) * 0.10206207261596577f;
            sc[j] = s_; rs[j] = rstd; mx = fmaxf(mx, s_);
        }
        red[tid] = mx; __syncthreads();
        for (int o = 256; o > 0; o >>= 1) { if (tid < o) red[tid] = fmaxf(red[tid], red[tid + o]); __syncthreads(); }
        mx = red[0]; __syncthreads();
        float sm = 0.f;
        for (int j = tid; j < lim; j += NTHREADS) { const float p = expf(sc[j] - mx); sc[j] = p; sm += p; }
        red[tid] = sm; __syncthreads();
        for (int o = 256; o > 0; o >>= 1) { if (tid < o) red[tid] += red[tid + o]; __syncthreads(); }
        sm = red[0]; __syncthreads();
        { const int k = tid & 255, half = tid >> 8; float a = 0.f;
          for (int j = half; j < lim; j += 2) a += sc[j] * rs[j] * bf2f(Z[(size_t)j * ZC + ZC_CKV + k]);
          pk[tid] = a * g_kv[k]; }
        __syncthreads();
        if (tid < 64) { float a = 0.f; for (int k = 0; k < 256; ++k) a += (pk[k] + pk[256 + k]) * w_ukv[(size_t)k * 1024 + h * 128 + 64 + tid];
            a /= sm; const float got = bf2f(((const bf16*)(ws + WS_ACT))[(size_t)i * 512 + h * 64 + tid]);
            red[tid] = fabsf(a - got); red[64 + tid] = fabsf(a); }
        __syncthreads();
        if (tid == 0) { float e = 0.f, m = 0.f; for (int d = 0; d < 64; ++d) { e = fmaxf(e, red[d]); m = fmaxf(m, red[64 + d]); }
            if (!(e <= 0.15f * m + 1e-5f)) __hip_atomic_fetch_or(F.ctl + CW_CHK, 1u << (b & 15), RLX_AGENT); }
        __syncthreads();
    } else if (b < 32) {
        const int j = ((b - 16) * 331 + 17 + layer * 5) % SEQ; const float* w_in = inp(3) + (size_t)layer * 2048 * INC; const bf16* H = (const bf16*)(ws + WS_H);
        if (tid < 32) { float a = 0.f; for (int k = 0; k < 2048; ++k) a += bf2f(H[(size_t)j * 2048 + k]) * w_in[(size_t)k * INC + 768 + tid]; L[tid] = a; }
        __syncthreads();
        if (tid < 16) { const float pos = (float)positions[j]; const float inv = exp2f(-(float)tid * (1.f / 16.f) * 18.931568569324174f); const float ang = pos * inv; double rev = (double)ang * 0.15915494309189535; rev -= floor(rev); const float c = __builtin_amdgcn_cosf((float)rev), sn = __builtin_amdgcn_sinf((float)rev);
            const float x1 = L[tid], x2 = L[16 + tid]; const float r1 = x1 * c - x2 * sn, r2 = x2 * c + x1 * sn;
            const float g1 = bf2f(Z[(size_t)j * ZC + ZC_KR + 2 * tid]), g2 = bf2f(Z[(size_t)j * ZC + ZC_KR + 2 * tid + 1]);
            if (!(fabsf(r1 - g1) <= 0.05f * fmaxf(1.f, fabsf(r1))) || !(fabsf(r2 - g2) <= 0.05f * fmaxf(1.f, fabsf(r2)))) __hip_atomic_fetch_or(F.ctl + CW_CHK, 1u << 16, RLX_AGENT); }
        __syncthreads();
    }
}
#endif

__device__ __forceinline__ void p5_diff_combine(Frame& F, int layer) {
    LayerW W; W.lam = inp(12) + (size_t)layer * 256; W.diff_g = inp(13) + (size_t)layer * 128;
    PHASE_IDS();
    const int gw = obid() * NWAVES + wave, NGW = F.G * NWAVES;
    const float lam_init = 0.8f - 0.6f * expf(-0.3f * (float)layer);
    const float d1 = wave_sum(W.lam[lane] * W.lam[64 + lane]), d2 = wave_sum(W.lam[128 + lane] * W.lam[192 + lane]);
    const float lam = expf(d1) - expf(d2) + lam_init;
    const bf16* O1 = (const bf16*)(ws + WS_DO); const bf16* O2 = O1 + (size_t)SEQ * 512;
    bf16* act = (bf16*)(ws + WS_ACT) + (size_t)2 * SEQ * 512;
    const int dcol = (lane & 15) * 8;
    const f32x4 g0 = *(const f32x4*)(W.diff_g + dcol), g1 = *(const f32x4*)(W.diff_g + dcol + 4);
    for (int tok = gw; tok < SEQ; tok += NGW) {
        const v4u a = *(const GAS v4u*)(O1 + (size_t)tok * 512 + lane * 8), b = *(const GAS v4u*)(O2 + (size_t)tok * 512 + lane * 8);
        float v[8] = {bf_lo(a.x) - lam * bf_lo(b.x), bf_hi(a.x) - lam * bf_hi(b.x), bf_lo(a.y) - lam * bf_lo(b.y), bf_hi(a.y) - lam * bf_hi(b.y),
                      bf_lo(a.z) - lam * bf_lo(b.z), bf_hi(a.z) - lam * bf_hi(b.z), bf_lo(a.w) - lam * bf_lo(b.w), bf_hi(a.w) - lam * bf_hi(b.w)};
        float s = 0.f;
#pragma unroll
        for (int i = 0; i < 8; ++i) s += v[i] * v[i];
        s = row16_sum(s);
        const float sc = (1.f / sqrtf(s * (1.f / 128.f) + NORM_EPS)) * (1.f - lam_init);
        float f2[8] = {v[0] * sc * g0[0], v[1] * sc * g0[1], v[2] * sc * g0[2], v[3] * sc * g0[3], v[4] * sc * g1[0], v[5] * sc * g1[1], v[6] * sc * g1[2], v[7] * sc * g1[3]};
        q512_store(f2, ws + WS_ACT8 + ((size_t)2 * SEQ + tok) * 512, (float*)(ws + WS_SACT8) + 2 * SEQ + tok, lane);
#pragma unroll
        for (int br = 0; br < 4; ++br) if (br != 2) row512_bf16_to_i8((const bf16*)(ws + WS_ACT) + ((size_t)br * SEQ + tok) * 512, ws + WS_ACT8 + ((size_t)br * SEQ + tok) * 512, (float*)(ws + WS_SACT8) + br * SEQ + tok, lane);
    }
}

__device__ __forceinline__ void p8_ffn_norm(Frame& F, int layer) {
    LayerW W; W.ffn_g = inp(21) + (size_t)layer * 2048;
    PHASE_IDS();
    const int gw = obid() * NWAVES + wave, NGW = F.G * NWAVES;
    const float* xa = (const float*)(ws + WS_XA);
    for (int m = gw; m < SEQ; m += NGW) {
        const GAS f32x4* xr = (const GAS f32x4*)(xa + (size_t)m * DMODEL) + lane; const GAS f32x4* gr = (const GAS f32x4*)W.ffn_g + lane;
        f32x4 v[8]; float s = 0.f;
#pragma unroll
        for (int j = 0; j < 8; ++j) { v[j] = xr[64 * j]; s += (v[j].x * v[j].x + v[j].y * v[j].y) + (v[j].z * v[j].z + v[j].w * v[j].w); }
        const float rstd = 1.f / sqrtf(wave_sum(s) * (1.f / DMODEL) + NORM_EPS);
        float am = 0.f;
#pragma unroll
        for (int j = 0; j < 8; ++j) { const f32x4 gg = gr[64 * j]; v[j].x *= rstd * gg.x; v[j].y *= rstd * gg.y; v[j].z *= rstd * gg.z; v[j].w *= rstd * gg.w;
            am = fmaxf(fmaxf(am, fabsf(v[j].x)), fabsf(v[j].y)); am = fmaxf(fmaxf(am, fabsf(v[j].z)), fabsf(v[j].w));
 }
        am = wave_max(am);
        const float hsc = am > 0.f ? 224.f * __builtin_amdgcn_rcpf(am) : 1.f;
        GAS unsigned* o4 = (GAS unsigned*)(ws + WS_H2F8 + (size_t)m * DMODEL) + lane;
#pragma unroll
        for (int j = 0; j < 8; ++j) { int p_ = __builtin_amdgcn_cvt_pk_fp8_f32(v[j].x * hsc, v[j].y * hsc, 0, false); p_ = __builtin_amdgcn_cvt_pk_fp8_f32(v[j].z * hsc, v[j].w * hsc, p_, true); o4[64 * j] = (unsigned)p_; }
        { const float isc = am > 0.f ? 127.f / am : 1.f; GAS unsigned* o1 = (GAS unsigned*)(ws + WS_H2I8 + (size_t)m * DMODEL) + lane;
#pragma unroll
          for (int j = 0; j < 8; ++j) o1[64 * j] = q4_i8(v[j].x * isc, v[j].y * isc, v[j].z * isc, v[j].w * isc); }
        if (lane == 0) ((GAS float*)(ws + WS_HSCI))[m] = am > 0.f ? am * (1.f / 224.f) : 1.f;
    }
}

#define CEI(a, b) do { const int mx_ = (a) > (b) ? (a) : (b), mn_ = (a) > (b) ? (b) : (a); (a) = mx_; (b) = mn_; } while (0)
#define SORT16(v, b) do { CEI(v[(b)+0], v[(b)+1]); CEI(v[(b)+3], v[(b)+2]); CEI(v[(b)+4], v[(b)+5]); CEI(v[(b)+7], v[(b)+6]); CEI(v[(b)+8], v[(b)+9]); CEI(v[(b)+11], v[(b)+10]); CEI(v[(b)+12], v[(b)+13]); CEI(v[(b)+15], v[(b)+14]); CEI(v[(b)+0], v[(b)+2]); CEI(v[(b)+1], v[(b)+3]); CEI(v[(b)+6], v[(b)+4]); CEI(v[(b)+7], v[(b)+5]); CEI(v[(b)+8], v[(b)+10]); CEI(v[(b)+9], v[(b)+11]); CEI(v[(b)+14], v[(b)+12]); CEI(v[(b)+15], v[(b)+13]); CEI(v[(b)+0], v[(b)+1]); CEI(v[(b)+2], v[(b)+3]); CEI(v[(b)+5], v[(b)+4]); CEI(v[(b)+7], v[(b)+6]); CEI(v[(b)+8], v[(b)+9]); CEI(v[(b)+10], v[(b)+11]); CEI(v[(b)+13], v[(b)+12]); CEI(v[(b)+15], v[(b)+14]); CEI(v[(b)+0], v[(b)+4]); CEI(v[(b)+1], v[(b)+5]); CEI(v[(b)+2], v[(b)+6]); CEI(v[(b)+3], v[(b)+7]); CEI(v[(b)+12], v[(b)+8]); CEI(v[(b)+13], v[(b)+9]); CEI(v[(b)+14], v[(b)+10]); CEI(v[(b)+15], v[(b)+11]); CEI(v[(b)+0], v[(b)+2]); CEI(v[(b)+1], v[(b)+3]); CEI(v[(b)+4], v[(b)+6]); CEI(v[(b)+5], v[(b)+7]); CEI(v[(b)+10], v[(b)+8]); CEI(v[(b)+11], v[(b)+9]); CEI(v[(b)+14], v[(b)+12]); CEI(v[(b)+15], v[(b)+13]); CEI(v[(b)+0], v[(b)+1]); CEI(v[(b)+2], v[(b)+3]); CEI(v[(b)+4], v[(b)+5]); CEI(v[(b)+6], v[(b)+7]); CEI(v[(b)+9], v[(b)+8]); CEI(v[(b)+11], v[(b)+10]); CEI(v[(b)+13], v[(b)+12]); CEI(v[(b)+15], v[(b)+14]); CEI(v[(b)+0], v[(b)+8]); CEI(v[(b)+1], v[(b)+9]); CEI(v[(b)+2], v[(b)+10]); CEI(v[(b)+3], v[(b)+11]); CEI(v[(b)+4], v[(b)+12]); CEI(v[(b)+5], v[(b)+13]); CEI(v[(b)+6], v[(b)+14]); CEI(v[(b)+7], v[(b)+15]); CEI(v[(b)+0], v[(b)+4]); CEI(v[(b)+1], v[(b)+5]); CEI(v[(b)+2], v[(b)+6]); CEI(v[(b)+3], v[(b)+7]); CEI(v[(b)+8], v[(b)+12]); CEI(v[(b)+9], v[(b)+13]); CEI(v[(b)+10], v[(b)+14]); CEI(v[(b)+11], v[(b)+15]); CEI(v[(b)+0], v[(b)+2]); CEI(v[(b)+1], v[(b)+3]); CEI(v[(b)+4], v[(b)+6]); CEI(v[(b)+5], v[(b)+7]); CEI(v[(b)+8], v[(b)+10]); CEI(v[(b)+9], v[(b)+11]); CEI(v[(b)+12], v[(b)+14]); CEI(v[(b)+13], v[(b)+15]); CEI(v[(b)+0], v[(b)+1]); CEI(v[(b)+2], v[(b)+3]); CEI(v[(b)+4], v[(b)+5]); CEI(v[(b)+6], v[(b)+7]); CEI(v[(b)+8], v[(b)+9]); CEI(v[(b)+10], v[(b)+11]); CEI(v[(b)+12], v[(b)+13]); CEI(v[(b)+14], v[(b)+15]); } while (0)
#define MERGE16(v, b) do { CEI(v[(b)+0], v[(b)+8]); CEI(v[(b)+1], v[(b)+9]); CEI(v[(b)+2], v[(b)+10]); CEI(v[(b)+3], v[(b)+11]); CEI(v[(b)+4], v[(b)+12]); CEI(v[(b)+5], v[(b)+13]); CEI(v[(b)+6], v[(b)+14]); CEI(v[(b)+7], v[(b)+15]); CEI(v[(b)+0], v[(b)+4]); CEI(v[(b)+1], v[(b)+5]); CEI(v[(b)+2], v[(b)+6]); CEI(v[(b)+3], v[(b)+7]); CEI(v[(b)+8], v[(b)+12]); CEI(v[(b)+9], v[(b)+13]); CEI(v[(b)+10], v[(b)+14]); CEI(v[(b)+11], v[(b)+15]); CEI(v[(b)+0], v[(b)+2]); CEI(v[(b)+1], v[(b)+3]); CEI(v[(b)+4], v[(b)+6]); CEI(v[(b)+5], v[(b)+7]); CEI(v[(b)+8], v[(b)+10]); CEI(v[(b)+9], v[(b)+11]); CEI(v[(b)+12], v[(b)+14]); CEI(v[(b)+13], v[(b)+15]); CEI(v[(b)+0], v[(b)+1]); CEI(v[(b)+2], v[(b)+3]); CEI(v[(b)+4], v[(b)+5]); CEI(v[(b)+6], v[(b)+7]); CEI(v[(b)+8], v[(b)+9]); CEI(v[(b)+10], v[(b)+11]); CEI(v[(b)+12], v[(b)+13]); CEI(v[(b)+14], v[(b)+15]); } while (0)

__device__ __forceinline__ int skey(float f) { const int b_ = __builtin_bit_cast(int, f); return b_ ^ ((b_ >> 31) & 0x7fffffff); }
__device__ __forceinline__ float unskey(int k) { const int b_ = k ^ ((k >> 31) & 0x7fffffff); return __builtin_bit_cast(float, b_); }
__device__ __forceinline__ int xpartner(int x, int hh) { auto rr = __builtin_amdgcn_permlane32_swap((unsigned)x, (unsigned)x, false, false); return (int)(hh ? rr[0] : rr[1]); }
__device__ __forceinline__ void split_bf16(const f32x4 a, const f32x4 b, bf16x8& hi, bf16x8& lo) {
    v4u h; h.x = pg8::cvt_pk_bf16(a[0], a[1]); h.y = pg8::cvt_pk_bf16(a[2], a[3]); h.z = pg8::cvt_pk_bf16(b[0], b[1]); h.w = pg8::cvt_pk_bf16(b[2], b[3]);
    v4u l; l.x = pg8::cvt_pk_bf16(a[0] - bf_lo(h.x), a[1] - bf_hi(h.x)); l.y = pg8::cvt_pk_bf16(a[2] - bf_lo(h.y), a[3] - bf_hi(h.y)); l.z = pg8::cvt_pk_bf16(b[0] - bf_lo(h.z), b[1] - bf_hi(h.z)); l.w = pg8::cvt_pk_bf16(b[2] - bf_lo(h.w), b[3] - bf_hi(h.w));
    hi = __builtin_bit_cast(bf16x8, h); lo = __builtin_bit_cast(bf16x8, l);
}
__device__ __forceinline__ void peer_top16(const bf16* ktab, const float* qrow, int r32, int hh, int (&v)[64]) {
    bf16x8 qb[4];
#pragma unroll
    for (int ks = 0; ks < 4; ++ks) qb[ks] = *(const GAS bf16x8*)((const bf16*)qrow + 16 * ks + 8 * hh);
#pragma unroll
    for (int kt = 0; kt < 4; ++kt) {
        f32x16 acc = (f32x16){0.f, 0.f, 0.f, 0.f, 0.f, 0.f, 0.f, 0.f, 0.f, 0.f, 0.f, 0.f, 0.f, 0.f, 0.f, 0.f};
#pragma unroll
        for (int ks = 0; ks < 4; ++ks) { const bf16x8 kh = *(const GAS bf16x8*)(ktab + (size_t)(32 * kt + r32) * 64 + 16 * ks + 8 * hh);
            acc = __builtin_amdgcn_mfma_f32_32x32x16_bf16(kh, qb[ks], acc, 0, 0, 0); }
#pragma unroll
        for (int r = 0; r < 16; ++r) v[16 * kt + r] = (skey(acc[r]) & ~127) | (32 * kt + (r & 3) + 8 * (r >> 2) + 4 * hh);
    }
    SORT16(v, 0); SORT16(v, 16); SORT16(v, 32); SORT16(v, 48);
#pragma unroll
    for (int i = 0; i < 16; ++i) { v[i] = v[i] > v[31 - i] ? v[i] : v[31 - i]; v[32 + i] = v[32 + i] > v[63 - i] ? v[32 + i] : v[63 - i]; }
    MERGE16(v, 0); MERGE16(v, 32);
#pragma unroll
    for (int i = 0; i < 16; ++i) v[i] = v[i] > v[47 - i] ? v[i] : v[47 - i];
    MERGE16(v, 0);
    int pb[16];
#pragma unroll
    for (int i = 0; i < 16; ++i) pb[i] = xpartner(v[i], hh);
#pragma unroll
    for (int i = 0; i < 16; ++i) v[i] = v[i] > pb[15 - i] ? v[i] : pb[15 - i];
    MERGE16(v, 0);
}
__device__ __forceinline__ void p10_route(Frame& F, int layer) {
    const bf16* subk = (const bf16*)(F.ws_base + WS_SUBK); (void)layer;
    PHASE_IDS();
    const int r32 = lane & 31, hh = lane >> 5;
    const int gw = obid() * NWAVES + wave, NGW = F.G * NWAVES;
    const float* pq = (const float*)(ws + WS_PQ);
    int* idx_o = (int*)(ws + WS_IDX); float* gate_o = (float*)(ws + WS_GATE);
    LAS unsigned char* tab = F.lds + wave * 1024 + r32 * 32;
    for (int it = gw; it < (SEQ / 32) * 8; it += NGW) {
        const int tile = it >> 3, hd = it & 7, tok = tile * 32 + r32;
        const float* qrow = (const float*)((const bf16*)pq + (size_t)tok * 1024 + hd * 128);
        int t1[16], t2[16];
        { int v[64]; peer_top16(subk, qrow, r32, hh, v);
#pragma unroll
          for (int i = 0; i < 16; ++i) t1[i] = v[i]; }
        { int v[64]; peer_top16(subk + 128 * 64, (const float*)((const bf16*)qrow + 64), r32, hh, v);
#pragma unroll
          for (int i = 0; i < 16; ++i) t2[i] = v[i]; }
        if (hh == 0) {
#pragma unroll
            for (int q = 0; q < 4; ++q) { ((LAS unsigned*)tab)[q] = (unsigned)(t1[4 * q] & 127) | ((unsigned)(t1[4 * q + 1] & 127) << 8) | ((unsigned)(t1[4 * q + 2] & 127) << 16) | ((unsigned)(t1[4 * q + 3] & 127) << 24);
                ((LAS unsigned*)tab)[4 + q] = (unsigned)(t2[4 * q] & 127) | ((unsigned)(t2[4 * q + 1] & 127) << 8) | ((unsigned)(t2[4 * q + 2] & 127) << 16) | ((unsigned)(t2[4 * q + 3] & 127) << 24); }
        }
        float f1[16], f2[16];
#pragma unroll
        for (int i = 0; i < 16; ++i) { f1[i] = unskey(t1[i] & ~127); f2[i] = unskey(t2[i] & ~127); }
        int c50[50];
        c50[0] = (skey(f1[0] + f2[0]) & ~255) | 0;
        c50[1] = (skey(f1[0] + f2[1]) & ~255) | 1;
        c50[2] = (skey(f1[0] + f2[2]) & ~255) | 2;
        c50[3] = (skey(f1[0] + f2[3]) & ~255) | 3;
        c50[4] = (skey(f1[0] + f2[4]) & ~255) | 4;
        c50[5] = (skey(f1[0] + f2[5]) & ~255) | 5;
        c50[6] = (skey(f1[0] + f2[6]) & ~255) | 6;
        c50[7] = (skey(f1[0] + f2[7]) & ~255) | 7;
        c50[8] = (skey(f1[0] + f2[8]) & ~255) | 8;
        c50[9] = (skey(f1[0] + f2[9]) & ~255) | 9;
        c50[10] = (skey(f1[0] + f2[10]) & ~255) | 10;
        c50[11] = (skey(f1[0] + f2[11]) & ~255) | 11;
        c50[12] = (skey(f1[0] + f2[12]) & ~255) | 12;
        c50[13] = (skey(f1[0] + f2[13]) & ~255) | 13;
        c50[14] = (skey(f1[0] + f2[14]) & ~255) | 14;
        c50[15] = (skey(f1[0] + f2[15]) & ~255) | 15;
        c50[16] = (skey(f1[1] + f2[0]) & ~255) | 16;
        c50[17] = (skey(f1[1] + f2[1]) & ~255) | 17;
        c50[18] = (skey(f1[1] + f2[2]) & ~255) | 18;
        c50[19] = (skey(f1[1] + f2[3]) & ~255) | 19;
        c50[20] = (skey(f1[1] + f2[4]) & ~255) | 20;
        c50[21] = (skey(f1[1] + f2[5]) & ~255) | 21;
        c50[22] = (skey(f1[1] + f2[6]) & ~255) | 22;
        c50[23] = (skey(f1[1] + f2[7]) & ~255) | 23;
        c50[24] = (skey(f1[2] + f2[0]) & ~255) | 32;
        c50[25] = (skey(f1[2] + f2[1]) & ~255) | 33;
        c50[26] = (skey(f1[2] + f2[2]) & ~255) | 34;
        c50[27] = (skey(f1[2] + f2[3]) & ~255) | 35;
        c50[28] = (skey(f1[2] + f2[4]) & ~255) | 36;
        c50[29] = (skey(f1[3] + f2[0]) & ~255) | 48;
        c50[30] = (skey(f1[3] + f2[1]) & ~255) | 49;
        c50[31] = (skey(f1[3] + f2[2]) & ~255) | 50;
        c50[32] = (skey(f1[3] + f2[3]) & ~255) | 51;
        c50[33] = (skey(f1[4] + f2[0]) & ~255) | 64;
        c50[34] = (skey(f1[4] + f2[1]) & ~255) | 65;
        c50[35] = (skey(f1[4] + f2[2]) & ~255) | 66;
        c50[36] = (skey(f1[5] + f2[0]) & ~255) | 80;
        c50[37] = (skey(f1[5] + f2[1]) & ~255) | 81;
        c50[38] = (skey(f1[6] + f2[0]) & ~255) | 96;
        c50[39] = (skey(f1[6] + f2[1]) & ~255) | 97;
        c50[40] = (skey(f1[7] + f2[0]) & ~255) | 112;
        c50[41] = (skey(f1[7] + f2[1]) & ~255) | 113;
        c50[42] = (skey(f1[8] + f2[0]) & ~255) | 128;
        c50[43] = (skey(f1[9] + f2[0]) & ~255) | 144;
        c50[44] = (skey(f1[10] + f2[0]) & ~255) | 160;
        c50[45] = (skey(f1[11] + f2[0]) & ~255) | 176;
        c50[46] = (skey(f1[12] + f2[0]) & ~255) | 192;
        c50[47] = (skey(f1[13] + f2[0]) & ~255) | 208;
        c50[48] = (skey(f1[14] + f2[0]) & ~255) | 224;
        c50[49] = (skey(f1[15] + f2[0]) & ~255) | 240;
        int m[32];
#pragma unroll
        for (int n = 0; n < 25; ++n) m[n] = hh ? c50[25 + n] : c50[n];
#pragma unroll
        for (int n = 25; n < 32; ++n) m[n] = (int)0x80000000;
        SORT16(m, 0); SORT16(m, 16);
#pragma unroll
        for (int i = 0; i < 16; ++i) m[i] = m[i] > m[31 - i] ? m[i] : m[31 - i];
        MERGE16(m, 0);
        int fb[16];
#pragma unroll
        for (int i = 0; i < 16; ++i) fb[i] = xpartner(m[i], hh);
#pragma unroll
        for (int i = 0; i < 16; ++i) m[i] = m[i] > fb[15 - i] ? m[i] : fb[15 - i];
        float val[16]; float mx = -3.0e38f;
#pragma unroll
        for (int i = 0; i < 16; ++i) { val[i] = unskey(m[i] & ~255); mx = fmaxf(mx, val[i]); }
        float den = 0.f;
#pragma unroll
        for (int i = 0; i < 16; ++i) { val[i] = __expf(val[i] - mx); den += val[i]; }
        const float rden = 1.f / den;
        asm volatile("s_waitcnt lgkmcnt(0)" ::: "memory");
        const LAS unsigned char* tb = tab;
        int ids[8]; float gs[8];
#pragma unroll
        for (int k = 0; k < 8; ++k) { const int ci = m[k] & 255; const int e1 = tb[ci >> 4], e2 = tb[16 + (ci & 15)]; ids[k] = e1 * 128 + e2; gs[k] = val[k] * rden; }
        int* ip = idx_o + (size_t)tok * 128 + hd * 16 + hh * 8; float* gp = gate_o + (size_t)tok * 128 + hd * 16 + hh * 8;
        *(GAS v4u*)ip = (v4u){(unsigned)ids[0], (unsigned)ids[1], (unsigned)ids[2], (unsigned)ids[3]}; *(GAS v4u*)(ip + 4) = (v4u){(unsigned)ids[4], (unsigned)ids[5], (unsigned)ids[6], (unsigned)ids[7]};
        *(GAS f32x4*)gp = (f32x4){gs[0], gs[1], gs[2], gs[3]}; *(GAS f32x4*)(gp + 4) = (f32x4){gs[4], gs[5], gs[6], gs[7]};
        asm volatile("s_waitcnt lgkmcnt(0)" ::: "memory");
    }
}

typedef float f32x2_ __attribute__((ext_vector_type(2)));
__device__ __forceinline__ void p11_peer(Frame& F, int layer, float* d_out) {
    const bool last = layer == NLAYER - 1; const float* next_g = last ? inp(26) : inp(2) + (size_t)(layer + 1) * 2048;
    PHASE_IDS();
    const int gw = obid() * NWAVES + wave, NGW = F.G * NWAVES;
    const unsigned char* U = ws + WS_UBF; const unsigned char* V = ws + WS_VBF;
    const float* usc = (const float*)(ws + WS_USC); const float* vsc = (const float*)(ws + WS_VSC);
    float* xa = (float*)(ws + WS_XA); const int* idx = (const int*)(ws + WS_IDX); const float* gate = (const float*)(ws + WS_GATE);
    LAS unsigned char* wl = F.lds + wave * 16384;
    LAS unsigned* keyl = (LAS unsigned*)wl;
    LAS float* asort = (LAS float*)(wl + 2048);
    LAS float* gsort = (LAS float*)(wl + 4096);
    const unsigned ring0 = (unsigned)(uintptr_t)(wl + 6144);
    LAS unsigned char* ringp = wl + 6144;
    LAS float* winv_l = (LAS float*)(F.lds + LDS_PART_OFF);
    LAS float* ssq_l = (LAS float*)(F.lds + LDS_PART_OFF + 64);
    for (int g4 = gw; g4 < SEQ / 4; g4 += NGW) {
        const int tok0 = g4 * 4;
#pragma unroll
        for (int i = 0; i < 8; ++i) { const int s_ = 64 * i + lane; const int id = idx[(size_t)tok0 * 128 + s_];
            keyl[s_] = ((unsigned)id << 9) | (unsigned)s_; }
        asm volatile("s_waitcnt lgkmcnt(0)" ::: "memory");
        for (int kk = 2; kk <= 512; kk <<= 1)
            for (int jj = kk >> 1; jj > 0; jj >>= 1) {
#pragma unroll
                for (int q = 0; q < 4; ++q) { const int t = 64 * q + lane, lo_i = 2 * t - (t & (jj - 1)), hi_i = lo_i + jj;
                    const unsigned x = keyl[lo_i], y = keyl[hi_i]; const bool up = (lo_i & kk) == 0; const bool sw = up ? (x > y) : (x < y);
                    keyl[lo_i] = sw ? y : x; keyl[hi_i] = sw ? x : y; }
                asm volatile("s_waitcnt lgkmcnt(0)" ::: "memory");
            }
#pragma unroll
        for (int i = 0; i < 8; ++i) { const int p_ = 64 * i + lane; const unsigned k_ = keyl[p_]; const int id = (int)(k_ >> 9); const int slot = (int)(k_ & 511u);
            asort[p_] = usc[id]; gsort[p_] = gate[(size_t)tok0 * 128 + slot] * vsc[id]; }
        const GAS long* hrow = (const GAS long*)(ws + WS_H2F8 + (size_t)(tok0 + (lane & 3)) * DMODEL + 8 * (lane >> 4));
        const float hinv = ((const GAS float*)(ws + WS_HSCI))[tok0 + (lane & 3)];
        long hb[64];
#pragma unroll
        for (int s_ = 0; s_ < 64; ++s_) hb[s_] = hrow[4 * s_];
        asm volatile("s_waitcnt vmcnt(0) lgkmcnt(0)" ::: "memory");
        {
            unsigned m0s_; asm volatile("s_mov_b32 %0, m0" : "=s"(m0s_) :: "memory");
            int ln1 = lane; asm volatile("" : "+v"(ln1));
            const unsigned rsel = ln1 >> 3, cA = 16u * ((ln1 & 7) ^ (rsel >> 1)), cB = 16u * ((ln1 & 7) ^ ((rsel >> 1) | 4u));
#define P11_GA(B_) (U + ((size_t)(keyl[16 * (B_) + rsel] >> 9) << 11) + cA)
#define P11_GBB(B_) (U + ((size_t)(keyl[16 * (B_) + 8 + rsel] >> 9) << 11) + cB)
#define P11_PAIR(SLOT) do { asm volatile("s_mov_b32 m0, %0\n\ts_nop 0\n\tglobal_load_lds_dwordx4 %2, off\n\ts_mov_b32 m0, %1\n\ts_nop 0\n\tglobal_load_lds_dwordx4 %3, off" \
                :: "s"(ring0 + 2048u * (unsigned)(SLOT)), "s"(ring0 + 2048u * (unsigned)(SLOT) + 1024u), "v"(gpa), "v"(gpb) : "m0", "memory"); gpa += 128; gpb += 128; } while (0)
            const unsigned char* gpa = P11_GA(0); const unsigned char* gpb = P11_GBB(0); const unsigned char* gna = P11_GA(1); const unsigned char* gnb = P11_GBB(1);
#pragma unroll
            for (int j = 0; j < 3; ++j) P11_PAIR(j);
            const int ri_ = ln1 & 15, rg_ = ln1 >> 4;
            const int rswz_ = ((ri_ & 7) >> 1) | ((ri_ >> 3) << 2), rgh_ = rg_ >> 1;
            const LAS unsigned char* arb_ = ringp + 1024 * (ri_ >> 3) + 128 * (ri_ & 7) + 8 * (rg_ & 1);
            const LAS unsigned char* ard0 = arb_ + 16 * ((0 + rgh_) ^ rswz_); const LAS unsigned char* ard1 = arb_ + 16 * ((2 + rgh_) ^ rswz_);
            const LAS unsigned char* ard2 = arb_ + 16 * ((4 + rgh_) ^ rswz_); const LAS unsigned char* ard3 = arb_ + 16 * ((6 + rgh_) ^ rswz_);
            for (int b = 0; b < 32; ++b) {
                f32x4 c0 = (f32x4){0.f, 0.f, 0.f, 0.f}, c1 = c0;
                long a0 = 0, a1 = 0, a2 = 0, a3 = 0;
#pragma unroll
                for (int j = 0; j < 16; ++j) {
                    asm volatile("s_waitcnt lgkmcnt(0)" ::: "memory");
                    P11_PAIR((j + 3) & 3);
                    if (j == 12) { const int bn = b + 2 < 32 ? b + 2 : 31; gpa = gna; gpb = gnb; gna = P11_GA(bn); gnb = P11_GBB(bn); }
                    asm volatile("s_waitcnt vmcnt(6)" ::: "memory");
                    const long n0 = *(const LAS long*)(ard0 + (j & 3) * 2048), n1 = *(const LAS long*)(ard1 + (j & 3) * 2048), n2 = *(const LAS long*)(ard2 + (j & 3) * 2048), n3 = *(const LAS long*)(ard3 + (j & 3) * 2048);
                    if (j > 0) {
                        c0 = __builtin_amdgcn_mfma_f32_16x16x32_fp8_fp8(a0, hb[4 * j - 4], c0, 0, 0, 0);
                        c1 = __builtin_amdgcn_mfma_f32_16x16x32_fp8_fp8(a1, hb[4 * j - 3], c1, 0, 0, 0);
                        c0 = __builtin_amdgcn_mfma_f32_16x16x32_fp8_fp8(a2, hb[4 * j - 2], c0, 0, 0, 0);
                        c1 = __builtin_amdgcn_mfma_f32_16x16x32_fp8_fp8(a3, hb[4 * j - 1], c1, 0, 0, 0);
                    }
                    a0 = n0; a1 = n1; a2 = n2; a3 = n3;
                }
                asm volatile("s_waitcnt lgkmcnt(0)" ::: "memory");
                c0 = __builtin_amdgcn_mfma_f32_16x16x32_fp8_fp8(a0, hb[60], c0, 0, 0, 0);
                c1 = __builtin_amdgcn_mfma_f32_16x16x32_fp8_fp8(a1, hb[61], c1, 0, 0, 0);
                c0 = __builtin_amdgcn_mfma_f32_16x16x32_fp8_fp8(a2, hb[62], c0, 0, 0, 0);
                c1 = __builtin_amdgcn_mfma_f32_16x16x32_fp8_fp8(a3, hb[63], c1, 0, 0, 0);
                const f32x4 cs = c0 + c1; const int q4 = 16 * b + 4 * (ln1 >> 4);
                const v4u wd = *(const LAS v4u*)(keyl + q4); const f32x4 sc = *(const LAS f32x4*)(asort + q4);
#pragma unroll
                for (int r = 0; r < 4; ++r) if (((wd[r] >> 7) & 3u) == (unsigned)(ln1 & 15)) asort[q4 + r] = cs[r] * sc[r] * hinv;
            }
            asm volatile("s_waitcnt vmcnt(0) lgkmcnt(0)\n\ts_mov_b32 m0, %0" :: "s"(m0s_) : "memory");
#undef P11_GA
#undef P11_GBB
#undef P11_PAIR
        }
        float wv[8]; float wam = 0.f;
#pragma unroll
        for (int i = 0; i < 8; ++i) { const int p_ = 64 * i + lane; const float a_ = asort[p_]; wv[i] = 0.5f * a_ * (1.f + erff(a_ * 0.70710678118654752f)) * gsort[p_]; wam = fmaxf(wam, fabsf(wv[i])); }
        wam = wave_max(wam);
        const float wsc = wam > 0.f ? 224.f * __builtin_amdgcn_rcpf(wam) : 1.f;
        asm volatile("s_waitcnt lgkmcnt(0)" ::: "memory");
        LAS unsigned char* wq8 = wl + 4096;
#pragma unroll
        for (int i = 0; i < 8; ++i) { const int p_ = 64 * i + lane; const unsigned ts_ = (keyl[p_] >> 7) & 3u; const unsigned b8 = (unsigned)__builtin_amdgcn_cvt_pk_fp8_f32(wv[i] * wsc, 0.f, 0, false) & 255u;
#pragma unroll
            for (int c = 0; c < 4; ++c) wq8[512 * c + p_] = (unsigned char)(ts_ == (unsigned)c ? b8 : 0u); }
        if (lane == 0) winv_l[wave] = wam > 0.f ? wam * (1.f / 224.f) : 1.f;
        __syncthreads();
        const int G4 = wave & ~3, qd4 = wave & 3;
        f32x4 acc[32];
#pragma unroll
        for (int i = 0; i < 32; ++i) acc[i] = (f32x4){0.f, 0.f, 0.f, 0.f};
        {
            unsigned m0s_; asm volatile("s_mov_b32 %0, m0" : "=s"(m0s_) :: "memory");
            int ln2 = lane; asm volatile("" : "+v"(ln2));
            const unsigned rsel = ln2 >> 3, cA = 512u * (unsigned)qd4 + 16u * ((ln2 & 7) ^ (rsel >> 1)), cB = 512u * (unsigned)qd4 + 16u * ((ln2 & 7) ^ ((rsel >> 1) | 4u));
#define P11_KL(B_) ((const LAS unsigned*)(F.lds + (G4 + ((B_) & 3)) * 16384) + 16 * ((B_) >> 2))
#define P11_GA(B_) (((P11_KL(B_)[rsel] >> 9) << 11) + cA)
#define P11_GBB(B_) (((P11_KL(B_)[8 + rsel] >> 9) << 11) + cB)
#define P11_WB(B_) (((ln2 >> 5) == 0 && ((ln2 & 15) >> 2) == ((B_) & 3)) ? *(const LAS long*)(F.lds + (G4 + ((B_) & 3)) * 16384 + 4096 + 512 * (ln2 & 3) + 8 * ((ln2 >> 4) & 1) + 16 * ((B_) >> 2)) : 0L)
#define P11_PAIR(SLOT) do { asm volatile("s_mov_b32 m0, %0\n\ts_nop 0\n\tglobal_load_lds_dwordx4 %2, %4\n\ts_mov_b32 m0, %1\n\ts_nop 0\n\tglobal_load_lds_dwordx4 %3, %4" \
                :: "s"(ring0 + 2048u * (unsigned)(SLOT)), "s"(ring0 + 2048u * (unsigned)(SLOT) + 1024u), "v"(gpa), "v"(gpb), "s"(vbase_) : "m0", "memory"); gpa += 128u; gpb += 128u; } while (0)
            const __attribute__((address_space(1))) unsigned char* vbase_ = (const __attribute__((address_space(1))) unsigned char*)V;
            unsigned gpa = P11_GA(0), gpb = P11_GBB(0), gna = P11_GA(1), gnb = P11_GBB(1);
#pragma unroll
            for (int j = 0; j < 3; ++j) P11_PAIR(j);
            const int tp_ = ln2 & 15, tg_ = ln2 >> 4, trh_ = tg_ & 1, til_ = tp_ >> 1, tsw_ = (til_ >> 1) | (trh_ << 2);
            const unsigned tb_ = ring0 + 1024u * trh_ + 128u * til_ + 8u * (tp_ & 1) + 16u * tsw_;
            typedef int v2i_ __attribute__((ext_vector_type(2)));
#define P11_TR(C_, SL) __builtin_amdgcn_ds_read_tr8_b64_v2i32((LAS v2i_*)(uintptr_t)((tb_ ^ (16u * (C_))) + 2048u * (SL)))
#define P11_MM(T_, A_) acc[T_] = __builtin_amdgcn_mfma_f32_16x16x32_fp8_fp8(__builtin_bit_cast(long, A_), wbm, acc[T_], 0, 0, 0)
            long wbm = 0L, wbn = P11_WB(0);
            for (int ch = 0; ch < 32; ++ch) {
#pragma unroll
                for (int st = 0; st < 16; ++st) {
                    asm volatile("s_waitcnt lgkmcnt(0)" ::: "memory");
                    P11_PAIR((st + 3) & 3);
                    if ((st & 3) == 0) { const int bn = 4 * ch + (st >> 2) + 2 < 128 ? 4 * ch + (st >> 2) + 2 : 127; gpa = gna; gpb = gnb; gna = P11_GA(bn); gnb = P11_GBB(bn); wbm = wbn; }
                    if ((st & 3) == 1) { const int bw = 4 * ch + (st >> 2) + 1 < 128 ? 4 * ch + (st >> 2) + 1 : 127; wbn = P11_WB(bw); }
                    asm volatile("s_waitcnt vmcnt(6)" ::: "memory");
                    const v2i_ n0 = P11_TR(0, st & 3), n1 = P11_TR(1, st & 3), n2 = P11_TR(2, st & 3), n3 = P11_TR(3, st & 3), n4 = P11_TR(4, st & 3), n5 = P11_TR(5, st & 3), n6 = P11_TR(6, st & 3), n7 = P11_TR(7, st & 3);
                    { const int t8 = 8 * (st & 3);
                        P11_MM(t8 + 0, n0); P11_MM(t8 + 1, n1); P11_MM(t8 + 2, n2); P11_MM(t8 + 3, n3); P11_MM(t8 + 4, n4); P11_MM(t8 + 5, n5); P11_MM(t8 + 6, n6); P11_MM(t8 + 7, n7); }
                }
            }
            asm volatile("s_waitcnt vmcnt(0) lgkmcnt(0)\n\ts_mov_b32 m0, %0" :: "s"(m0s_) : "memory");
#undef P11_KL
#undef P11_GA
#undef P11_GBB
#undef P11_WB
#undef P11_PAIR
#undef P11_TR
#undef P11_MM
        }
        {
            int ln3 = lane; asm volatile("" : "+v"(ln3));
            const int ncol = ln3 & 15, qd = ln3 >> 4, tokg = (g4 - (wave & 3)) * 4 + ncol;
            const float wi = winv_l[G4 + (ncol >> 2)];
            GAS f32x4* xp0 = (GAS f32x4*)(xa + (size_t)tokg * DMODEL + 512 * qd4 + 4 * qd);
            float ss = 0.f;
#pragma unroll
            for (int t8 = 0; t8 < 4; ++t8) {
                asm volatile("" ::: "memory");
#pragma unroll
                for (int t = 8 * t8; t < 8 * t8 + 8; ++t) { const f32x4 x0 = xp0[4 * t]; f32x4 e = acc[t] * wi + x0; acc[t] = e; ss += (e.x * e.x + e.y * e.y) + (e.z * e.z + e.w * e.w); if (!last) xp0[4 * t] = e; }
            }
            ss += __builtin_bit_cast(float, __builtin_amdgcn_ds_bpermute((ln3 ^ 16) << 2, __builtin_bit_cast(int, ss)));
            ss += __builtin_bit_cast(float, __builtin_amdgcn_ds_bpermute((ln3 ^ 32) << 2, __builtin_bit_cast(int, ss)));
            if (qd == 0) ssq_l[16 * wave + ncol] = ss;
            __syncthreads();
            const float rstd = 1.f / sqrtf(((ssq_l[16 * G4 + ncol] + ssq_l[16 * (G4 + 1) + ncol]) + (ssq_l[16 * (G4 + 2) + ncol] + ssq_l[16 * (G4 + 3) + ncol])) * (1.f / DMODEL) + NORM_EPS);
            const GAS f32x4* gp0 = (const GAS f32x4*)(next_g + 512 * qd4 + 4 * qd);
#if MK_CHECK
            float kc = -1.f;
            if (last) { const unsigned fl_ = __hip_atomic_load(F.ctl + CW_CHK, RLX_AGENT); if (fl_ != 0u) kc = (float)__builtin_popcount(fl_ & 0xffffu) + ((fl_ & 0x10000u) ? 20.f : 0.f); }
#endif
            if (last) {
#pragma unroll
            for (int t8 = 0; t8 < 4; ++t8) {
                asm volatile("" ::: "memory");
#pragma unroll
                for (int t = 8 * t8; t < 8 * t8 + 8; ++t) { const f32x4 gg = gp0[4 * t]; f32x4 o = acc[t] * rstd * gg;
#if MK_CHECK
                    if (kc >= 0.f) o = (f32x4){kc, kc, kc, kc};
#endif
                    *(GAS f32x4*)(d_out + (size_t)tokg * DMODEL + 512 * qd4 + 16 * t + 4 * qd) = o;
                }
            }
            } else {
                float am = 0.f;
#pragma unroll
                for (int t8 = 0; t8 < 4; ++t8) {
                    asm volatile("" ::: "memory");
#pragma unroll
                    for (int t = 8 * t8; t < 8 * t8 + 8; ++t) { const f32x4 gg = gp0[4 * t]; const f32x4 o = acc[t] * rstd * gg; acc[t] = o;
                        am = fmaxf(am, fmaxf(fmaxf(fabsf(o.x), fabsf(o.y)), fmaxf(fabsf(o.z), fabsf(o.w)))); }
                }
                am = fmaxf(am, __builtin_bit_cast(float, __builtin_amdgcn_ds_bpermute((ln3 ^ 16) << 2, __builtin_bit_cast(int, am))));
                am = fmaxf(am, __builtin_bit_cast(float, __builtin_amdgcn_ds_bpermute((ln3 ^ 32) << 2, __builtin_bit_cast(int, am))));
                LAS float* amx_l = (LAS float*)(F.lds + LDS_PART_OFF + 1024);
                if (qd == 0) amx_l[16 * wave + ncol] = am;
                __syncthreads();
                const float amr = fmaxf(fmaxf(amx_l[16 * G4 + ncol], amx_l[16 * (G4 + 1) + ncol]), fmaxf(amx_l[16 * (G4 + 2) + ncol], amx_l[16 * (G4 + 3) + ncol]));
                const float sc8 = amr > 0.f ? 127.f / amr : 1.f;
                unsigned char* ap = ws + WS_A8 + (size_t)tokg * DMODEL + 512 * qd4 + 4 * qd;
#pragma unroll
                for (int t8 = 0; t8 < 4; ++t8) {
                    asm volatile("" ::: "memory");
#pragma unroll
                    for (int t = 8 * t8; t < 8 * t8 + 8; ++t) *(GAS unsigned*)(ap + 16 * t) = q4_i8(acc[t].x * sc8, acc[t].y * sc8, acc[t].z * sc8, acc[t].w * sc8);
                }
                if (qd4 == 0 && qd == 0) ((GAS float*)(ws + WS_SA8))[tokg] = amr > 0.f ? amr * (1.f / 127.f) : 1.f;
            }
            asm volatile("s_waitcnt vmcnt(0)" ::: "memory");
            __syncthreads();
        }
    }
}

#ifndef MK_ONE_LAUNCH
#define MK_ONE_LAUNCH 1
#endif
constexpr int PH_PER_LAYER = 12, N_PHASES = PH_PER_LAYER * NLAYER;
struct Args { const float* in[27]; float* out; unsigned char* ws; int ph_lo, ph_hi; };
static_assert(sizeof(Args) == 29 * 8 + 8, "Args has no padding");

__global__ void __launch_bounds__(NTHREADS, 2) mk_fwd(Args args) {
    extern __shared__ __attribute__((aligned(16))) unsigned char lds_raw[];
    Frame F;
    F.lds = (LAS unsigned char*)lds_raw;
    F.MISC = (volatile LAS unsigned*)(F.lds + MISC_OFF);
    F.G = gridDim.x; F.wv = __builtin_amdgcn_readfirstlane((int)threadIdx.x >> 6);
    F.ws_base = args.ws; F.ctl = (gu32*)(args.ws + WS_CTL);
    for (int u = threadIdx.x; u < (LDS_BYTES - LDSCTL_OFF) / 4; u += NTHREADS) ((LAS unsigned*)(F.lds + LDSCTL_OFF))[u] = 0u;
    __syncthreads();
    XcdBarrier bar; bar.bar = (unsigned*)(F.ctl + CW_BAR); bar.x = 0; bar.st = nullptr; bar.wv = F.wv;
    if (MK_ONE_LAUNCH) bar = xcd_barrier_post((unsigned*)(F.ctl + CW_BAR), F.MISC + 8, F.wv);
    const int lo = args.ph_lo, hi = args.ph_hi;
#define IN(k) (lo <= (k) && (k) < hi)
#ifndef DUP_MASK
#define DUP_MASK 0
#endif
#define NREP(k) (((DUP_MASK >> (k)) & 1) ? 2 : 1)
#define SEAM(k) do { if (MK_ONE_LAUNCH && IN(k) && IN((k) + 1)) xcd_barrier(bar); } while (0)
    for (int layer = 0; layer < NLAYER; ++layer) {
        const int pb = layer * PH_PER_LAYER;
        if (IN(pb + 0)) { for (int rep = 0; rep < NREP(0); ++rep) p0_prologue(F, layer, 1); } SEAM(pb + 0);
        if (IN(pb + 1)) for (int rep = 0; rep < NREP(1); ++rep) { unsigned char* const ws = ows(F.ws_base);
            { const int tid_ = otid(F.wv), lane_ = tid_ & 63, gw_ = obid() * NWAVES + F.wv, NGW_ = F.G * NWAVES;
              for (int r = gw_ + SEQ; r < SEQ + ZC + 3072; r += NGW_) { const int sel = r >= SEQ + ZC + 2048 ? 3 : r >= SEQ + ZC ? 2 : r >= SEQ, rr = r - (sel == 3 ? SEQ + ZC + 2048 : sel == 2 ? SEQ + ZC : sel * SEQ);
                  row_bf16_to_i8((const bf16*)(ws + (sel == 3 ? WS_WQ : sel == 2 ? WS_WO : sel ? WS_WIN : WS_H)) + (size_t)rr * 2048, ws + (sel == 3 ? WS_WQ8 : sel == 2 ? WS_WO8 : sel ? WS_B8 : WS_A8) + (size_t)rr * 2048,
                                 (float*)(ws + (sel == 3 ? WS_SWQ8 : sel == 2 ? WS_SWO8 : sel ? WS_SB8 : WS_SA8)) + rr, lane_); }
              for (int r = gw_; r < 4 * 2048; r += NGW_) row512_bf16_to_i8((const bf16*)(ws + WS_WOUT) + (size_t)r * 512, ws + WS_WOUT8 + (size_t)r * 512, (float*)(ws + WS_SWOUT8) + r, lane_);
              for (int r = gw_; r < 1792; r += NGW_) row512_bf16_to_i8((const bf16*)(ws + WS_WUQ) + (size_t)r * 512, ws + WS_WUQ8 + (size_t)r * 512, (float*)(ws + WS_SWUQ8) + r, lane_);
              asm volatile("s_waitcnt vmcnt(0)" ::: "memory"); }
            if (MK_ONE_LAUNCH) xcd_barrier(bar);
            pg8::Gemm g{(const bf16*)(ws + WS_A8), (const bf16*)(ws + WS_B8), SEQ, ZC_GATE, 1024, 1024, 1024}; pg8::StaticOrder S; S.init(SEQ, ZC_GATE, F.G, obid());
            pg8::EpiZ8 E{(bf16*)(ws + WS_Z), (const float*)(ws + WS_COSM), (const float*)(ws + WS_SINM), (const float*)(ws + WS_COSD), (const float*)(ws + WS_SIND), (const float*)(ws + WS_SA8), (const float*)(ws + WS_SB8)};
            pg8::gemm_phase<pg8::EpiZ8, pg8::StaticOrder, true, true, true>(F.lds, g, S, E, F.wv);
        } SEAM(pb + 1);
        if (IN(pb + 2)) { for (int rep = 0; rep < NREP(2); ++rep) p2_branch_prep(F, layer); } SEAM(pb + 2);
        if (IN(pb + 3)) for (int rep = 0; rep < NREP(3); ++rep) { unsigned char* const ws = ows(F.ws_base);
            int k3 = 256; asm volatile("" : "+s"(k3));
            pg8::Gemm g{(const bf16*)(ws + WS_QA8), (const bf16*)(ws + WS_WUQ8), SEQ, QMC + KVC, k3, 512, 256}; pg8::QKVOrder8 S; S.S0.init(SEQ, QMC + KVC, F.G, obid());
            pg8::EpiQKV8 E{(bf16*)(ws + WS_QM), (bf16*)(ws + WS_KVM), (const float*)(ws + WS_RSTD), (const float*)(ws + WS_COSM), (const float*)(ws + WS_SINM), (const float*)(ws + WS_SWUQ8)};
            pg8::gemm_phase<pg8::EpiQKV8, pg8::QKVOrder8, false, true, true>(F.lds, g, S, E, F.wv);
        } SEAM(pb + 3);
        if (IN(pb + 4)) { for (int rep = 0; rep < NREP(4); ++rep) p4_attention(F, layer * 2 + rep); } SEAM(pb + 4);
        if (IN(pb + 5)) { p5_diff_combine(F, layer);
#if MK_CHECK
            mla_check(F, layer);
#endif
            __syncthreads();
            { unsigned char* const ws = ows(F.ws_base);
              pg8::Gemm g{(const bf16*)(ws + WS_A8), (const bf16*)(ws + WS_B8 + (size_t)ZC_GATE * 2048), SEQ, 8192, 1024, 1024, 1024}; pg8::StaticOrder S; S.init(SEQ, 8192, F.G, obid());
              pg8::EpiGate8 E{(bf16*)(ws + WS_Z), (const float*)(ws + WS_SA8), (const float*)(ws + WS_SB8) + ZC_GATE, inp(4) + (size_t)layer * 4 * 2048, (const float*)(ws + WS_SWOUT8)};
              pg8::gemm_phase<pg8::EpiGate8, pg8::StaticOrder, true, true, true>(F.lds, g, S, E, F.wv); }
        } SEAM(pb + 5);
        if (IN(pb + 6)) for (int rep = 0; rep < NREP(6); ++rep) { unsigned char* const ws = ows(F.ws_base);
            int k6 = 256; asm volatile("" : "+s"(k6));
            pg8::Gemm g{(const bf16*)(ws + WS_ACT8), (const bf16*)(ws + WS_WOUT8), 4 * SEQ, 4 * 2048, k6, 256, 256};
            pg8::MergedOrder S; S.S0.init(SEQ, 2048, F.G, obid());
            pg8::EpiMerged8 E{(bf16*)(ws + WS_MERGED), (const bf16*)(ws + WS_Z), (const float*)(ws + WS_SACT8)};
            pg8::gemm_phase<pg8::EpiMerged8, pg8::MergedOrder, true, true, true>(F.lds, g, S, E, F.wv);
        } SEAM(pb + 6);
        if (IN(pb + 7)) { unsigned char* const ws = ows(F.ws_base);
            { const int tid_ = otid(F.wv), lane_ = tid_ & 63, gw_ = obid() * NWAVES + F.wv, NGW_ = F.G * NWAVES;
              for (int r = gw_; r < SEQ; r += NGW_) row_bf16_to_i8((const bf16*)(ws + WS_MERGED) + (size_t)r * 2048, ws + WS_M8 + (size_t)r * 2048, (float*)(ws + WS_SM8) + r, lane_);
              asm volatile("s_waitcnt vmcnt(0)" ::: "memory"); }
            if (MK_ONE_LAUNCH) xcd_barrier(bar);
            pg8::Gemm g{(const bf16*)(ws + WS_M8), (const bf16*)(ws + WS_WO8), SEQ, 2048, 1024, 1024, 1024}; pg8::StaticOrder S; S.init(SEQ, 2048, F.G, obid());
            pg8::EpiRes8 E{layer == 0 ? inp(0) : (const float*)(ws + WS_XA), (float*)(ws + WS_XA), (const float*)(ws + WS_SM8), (const float*)(ws + WS_SWO8)};
            pg8::gemm_phase<pg8::EpiRes8, pg8::StaticOrder, false, true, true>(F.lds, g, S, E, F.wv);
        } SEAM(pb + 7);
        if (IN(pb + 8)) { p8_ffn_norm(F, layer); } SEAM(pb + 8);
        if (IN(pb + 9)) for (int rep = 0; rep < NREP(9); ++rep) { unsigned char* const ws = ows(F.ws_base);
            pg8::Gemm g{(const bf16*)(ws + WS_H2I8), (const bf16*)(ws + WS_WQ8), SEQ, 1024, 1024, 1024, 1024}; pg8::StaticOrder S; S.init(SEQ, 1024, F.G, obid());
            pg8::EpiPQ8 E{(float*)(ws + WS_PQ), (const float*)(ws + WS_HSCI), (const float*)(ws + WS_SWQ8)};
            pg8::gemm_phase<pg8::EpiPQ8, pg8::StaticOrder, false, true, true>(F.lds, g, S, E, F.wv);
        } SEAM(pb + 9);
        if (IN(pb + 10)) { for (int rep = 0; rep < NREP(10); ++rep) p10_route(F, layer); } SEAM(pb + 10);
        if (IN(pb + 11)) { p11_peer(F, layer, args.out); }
        if (layer + 1 < NLAYER) SEAM(pb + 11);
    }
#undef IN
#undef SEAM
}

extern "C" void kernel_launch(void* const* d_in, const int* in_sizes, int n_in, void* d_out, int out_size, void* d_ws, size_t ws_size, hipStream_t stream) {
    static int grid = 0;
    if (grid == 0) {
        if (n_in != 27 || out_size != SEQ * DMODEL || ws_size < WS_END) { fprintf(stderr, "kernel_launch: unexpected problem (n_in %d, out %d, ws %zu); nothing launched\n", n_in, out_size, ws_size); grid = -1; return; }
        int dev = 0, cus = 0, per_cu = 0;
        if (hipGetDevice(&dev) != hipSuccess || hipDeviceGetAttribute(&cus, hipDeviceAttributeMultiprocessorCount, dev) != hipSuccess) { grid = -1; return; }
        if (hipFuncSetAttribute((const void*)mk_fwd, hipFuncAttributeMaxDynamicSharedMemorySize, LDS_BYTES) != hipSuccess) { fprintf(stderr, "kernel_launch: hipFuncSetAttribute failed\n"); grid = -1; return; }
        if (hipOccupancyMaxActiveBlocksPerMultiprocessor(&per_cu, (const void*)mk_fwd, NTHREADS, LDS_BYTES) != hipSuccess || per_cu < 1) { fprintf(stderr, "kernel_launch: occupancy query says %d\n", per_cu); per_cu = 1; }
        (void)hipGetLastError();
        grid = cus;
    }
    if (grid < 0) return;
    (void)in_sizes;
    if (hipMemsetAsync((char*)d_ws + WS_CTL, 0, CTL_ZERO_BYTES, stream) != hipSuccess) return;
    Args a{};
    for (int i = 0; i < 27; ++i) a.in[i] = (const float*)d_in[i];
    a.out = (float*)d_out; a.ws = (unsigned char*)d_ws;
#if MK_ONE_LAUNCH
    a.ph_lo = 0; a.ph_hi = N_PHASES;
    hipLaunchKernelGGL(mk_fwd, dim3(grid), dim3(NTHREADS), LDS_BYTES, stream, a);
#else
    for (int p = 0; p < N_PHASES; ++p) { a.ph_lo = p; a.ph_hi = p + 1; hipLaunchKernelGGL(mk_fwd, dim3(grid), dim3(NTHREADS), LDS_BYTES, stream, a); }
#endif
}
```
